# Optimizing an MI355X kernel written in HIP

```python
import math
import numpy as np
import jax
import jax.numpy as jnp
from jax import lax

D_MODEL = 1024
BATCH = 2
SEQ = 16384
DEPTH = 4

CTX_LEN = 256
GRID_W = 64
DA_HEADS = 6
DA_DIM = 32
DA_VDIM = 2 * DA_DIM
MLA_HEADS = 6
MLA_NOPE = 64
MLA_ROPE = 32
MLA_VDIM = 64
MLA_Q_RANK = 256
MLA_KV_RANK = 128
RET_HEADS = 4
RET_DIM = 64
RET_CHUNK = 128
DA_WIDTH = DA_HEADS * DA_VDIM
MLA_WIDTH = MLA_HEADS * MLA_VDIM
RET_WIDTH = RET_HEADS * RET_DIM
MIX_WIDTH = DA_WIDTH + MLA_WIDTH + RET_WIDTH
IN_SPLIT_SIZES = (DA_HEADS * 2 * DA_DIM, DA_HEADS * 2 * DA_DIM, DA_HEADS * DA_VDIM,
                  MLA_Q_RANK, MLA_KV_RANK, MLA_ROPE,
                  RET_WIDTH, RET_WIDTH, RET_WIDTH, RET_WIDTH)
IN_COLS = sum(IN_SPLIT_SIZES)
ATTN_ROT_DIM = 32
ROPE_BASE = 10000.0
Q_BLOCK = 128
N_EXPERTS = 16
N_GROUPS = 4
EXPERTS_PER_GROUP = N_EXPERTS // N_GROUPS
TOPK_GROUP = 1
TOP_K = 2
D_EXPERT = 512
ROUTED_SCALE = 1.0
N_MOD = 6
ALPHA = (2 * DEPTH) ** 0.25
BETA = (8 * DEPTH) ** -0.25
LN_EPS = 1e-5
RMS_EPS = 1e-6

kernel_name = 'hybrid_diffattn_mla_retention_grouped_moe'


def layer_norm(x, g, b):
    xf = x.astype(jnp.float32)
    mu = jnp.mean(xf, -1, keepdims=True)
    var = jnp.mean(jnp.square(xf - mu), -1, keepdims=True)
    return ((xf - mu) * lax.rsqrt(var + LN_EPS)).astype(x.dtype) * g + b


def rms_norm(x, g=None):
    xf = x.astype(jnp.float32)
    y = (xf * lax.rsqrt(jnp.mean(jnp.square(xf), -1, keepdims=True) + RMS_EPS)).astype(x.dtype)
    return y if g is None else y * g


def axial_rope(rows, rot_dim):
    r = jnp.repeat(jnp.arange(rows, dtype=jnp.float32), GRID_W)
    col = jnp.tile(jnp.arange(GRID_W, dtype=jnp.float32), rows)
    n_freq = rot_dim // 4
    freqs = ROPE_BASE ** (-jnp.arange(n_freq, dtype=jnp.float32) / n_freq)
    ang = jnp.concatenate([r[:, None] * freqs, col[:, None] * freqs], -1)
    return jnp.cos(ang), jnp.sin(ang)


def apply_rope(x, rope):
    cos, sin = rope
    cos = cos.astype(x.dtype)
    sin = sin.astype(x.dtype)
    x1, x2 = x[..., 0::2], x[..., 1::2]
    return jnp.stack([x1 * cos - x2 * sin, x1 * sin + x2 * cos], -1).reshape(x.shape)


def split_cols(z):
    return jnp.split(z, np.cumsum(IN_SPLIT_SIZES)[:-1].tolist(), axis=-1)


def split_heads(t, n_heads):
    B, L, _ = t.shape
    return t.reshape(B, L, n_heads, -1).transpose(0, 2, 1, 3)


def merge_heads(t):
    B, H, L, d = t.shape
    return t.transpose(0, 2, 1, 3).reshape(B, L, H * d)


def attend_plain(q, k, v, scale):
    s = jnp.einsum('bhmqd,bhmkd->bhmqk', q, k).astype(jnp.float32) * scale
    p = jax.nn.softmax(s, -1).astype(v.dtype)
    return jnp.einsum('bhmqk,bhkd->bhmqd', p, v)


def attend_latent(q_rot, q_free, k_lat, k_ctx, v_lat, v_ctx, scale):
    B, H, M, S, _ = q_rot.shape
    n_lat = k_lat.shape[3]

    def block(i):
        start = i * Q_BLOCK
        qr = lax.dynamic_slice_in_dim(q_rot, start, Q_BLOCK, axis=3)
        qf = lax.dynamic_slice_in_dim(q_free, start, Q_BLOCK, axis=3)
        s = jnp.concatenate([jnp.einsum('bhmqd,bhmkd->bhmqk', qr, k_lat),
                             jnp.einsum('bhmqd,bhmkd->bhmqk', qf, k_ctx)], -1)
        p = jax.nn.softmax(s.astype(jnp.float32) * scale, -1).astype(v_lat.dtype)
        return (jnp.einsum('bhmqk,bhkd->bhmqd', p[..., :n_lat], v_lat)
                + jnp.einsum('bhmqk,bhkd->bhmqd', p[..., n_lat:], v_ctx))

    out = lax.map(block, jnp.arange(S // Q_BLOCK))
    return jnp.moveaxis(out, 0, 3).reshape(B, H, M, S, v_lat.shape[-1])


def diff_attention(lat, ctx_in, lam_vecs, subln_g, layer_idx, rope, last):
    def shape_qk(z):
        B, L, _ = z.shape
        return z.reshape(B, L, DA_HEADS, 2, DA_DIM).transpose(0, 2, 3, 1, 4)
    q, k, v = shape_qk(lat[0]), shape_qk(lat[1]), split_heads(lat[2], DA_HEADS)
    qc, kc, vc = shape_qk(ctx_in[0]), shape_qk(ctx_in[1]), split_heads(ctx_in[2], DA_HEADS)
    lam_init = 0.8 - 0.6 * math.exp(-0.3 * layer_idx)
    lf = lam_vecs.astype(jnp.float32)
    lam = jnp.exp(jnp.sum(lf[0] * lf[1])) - jnp.exp(jnp.sum(lf[2] * lf[3])) + lam_init
    scale = DA_DIM ** -0.5

    def combine(o):
        o = o[:, :, 0] - lam.astype(o.dtype) * o[:, :, 1]
        return merge_heads(rms_norm(o, subln_g) * (1.0 - lam_init))

    y = combine(attend_latent(apply_rope(q, rope), q, apply_rope(k, rope), kc, v, vc, scale))
    yc = None if last else combine(attend_plain(qc, kc, vc, scale))
    return y, yc


def mla_attention(lat, ctx_in, q_norm_g, w_uq, kv_norm_g, w_ukv, rope, last):
    def project(cq, ckv, kpe):
        B, L, _ = cq.shape
        q = (rms_norm(cq, q_norm_g) @ w_uq).reshape(B, L, MLA_HEADS, MLA_NOPE + MLA_ROPE)
        q = q.transpose(0, 2, 1, 3)[:, :, None]
        kv = (rms_norm(ckv, kv_norm_g) @ w_ukv).reshape(B, L, MLA_HEADS, MLA_NOPE + MLA_VDIM)
        kv = kv.transpose(0, 2, 1, 3)
        return q, kv[:, :, None, :, :MLA_NOPE], kpe[:, None, None], kv[..., MLA_NOPE:]
    q, k_nope, k_pe, v = project(*lat)
    qc, kc_nope, kc_pe, vc = project(*ctx_in)

    def full_k(kn, kp):
        return jnp.concatenate([kn, jnp.broadcast_to(kp, kn.shape[:-1] + (MLA_ROPE,))], -1)
    q_rot = jnp.concatenate([q[..., :MLA_NOPE], apply_rope(q[..., MLA_NOPE:], rope)], -1)
    k_lat = full_k(k_nope, apply_rope(k_pe, rope))
    k_ctx = full_k(kc_nope, kc_pe)
    scale = (MLA_NOPE + MLA_ROPE) ** -0.5
    y = merge_heads(attend_latent(q_rot, q, k_lat, k_ctx, v, vc, scale)[:, :, 0])
    yc = None if last else merge_heads(attend_plain(qc, k_ctx, vc, scale)[:, :, 0])
    return y, yc


def chunk_retention(q, k, v, log_gamma, state0, strict, with_output=True):
    B, H, L, dk = q.shape
    dv = v.shape[-1]
    n_chunks = L // RET_CHUNK
    qb = q.reshape(B, H, n_chunks, RET_CHUNK, dk)
    kb = k.reshape(B, H, n_chunks, RET_CHUNK, dk)
    vb = v.reshape(B, H, n_chunks, RET_CHUNK, dv)
    pos = jnp.arange(RET_CHUNK, dtype=jnp.float32)
    lg = log_gamma[:, None]
    zeta = jnp.exp(lg * (RET_CHUNK - 1 - pos)).astype(q.dtype)
    chunk_decay = jnp.exp(log_gamma * RET_CHUNK).astype(q.dtype)[None, :, None, None]
    upd = jnp.einsum('bhncd,bhnce->bhnde', kb * zeta[None, :, None, :, None], vb)

    def step(state, u):
        return state * chunk_decay + u, state
    final, prev = lax.scan(step, state0, jnp.moveaxis(upd, 2, 0))
    if not with_output:
        return None, final
    diff = pos[:, None] - pos[None, :]
    mask = diff > 0 if strict else diff >= 0
    dmask = jnp.where(mask[None], jnp.exp(lg[..., None] * jnp.where(mask, diff, 0.0)[None]), 0.0).astype(q.dtype)
    xi = jnp.exp(lg * (pos + 1)).astype(q.dtype)
    a = jnp.einsum('bhncd,bhnmd->bhncm', qb, kb) * dmask[None, :, None]
    inner = jnp.einsum('bhncm,bhnme->bhnce', a, vb)
    cross = jnp.einsum('bhncd,nbhde->bhnce', qb * xi[None, :, None, :, None], prev)
    return (inner + cross).reshape(B, H, L, dv), final


def retention(lat, ctx_in, decay_f, decay_b, rope, last):
    zq, zk, zv, zg = lat
    zqc, zkc, zvc, zgc = ctx_in
    kscale = RET_DIM ** -0.5
    q = apply_rope(split_heads(zq, RET_HEADS), rope)
    k = apply_rope(split_heads(zk, RET_HEADS), rope) * kscale
    v = split_heads(zv, RET_HEADS)
    qc = split_heads(zqc, RET_HEADS)
    kc = split_heads(zkc, RET_HEADS) * kscale
    vc = split_heads(zvc, RET_HEADS)
    lg_f = jax.nn.log_sigmoid(decay_f.astype(jnp.float32))
    lg_b = jax.nn.log_sigmoid(decay_b.astype(jnp.float32))
    zero = jnp.zeros((q.shape[0], RET_HEADS, RET_DIM, RET_DIM), q.dtype)

    def flip(t):
        return jnp.flip(t, axis=2)
    oc_f, st_f = chunk_retention(qc, kc, vc, lg_f, zero, False, with_output=not last)
    oc_b, st_b = chunk_retention(flip(qc), flip(kc), flip(vc), lg_b, zero, True, with_output=not last)
    o_f, _ = chunk_retention(q, k, v, lg_f, st_f, False)
    o_b, _ = chunk_retention(flip(q), flip(k), flip(v), lg_b, st_b, True)

    def finish(o, zgate):
        return jax.nn.silu(zgate) * merge_heads(rms_norm(o))
    y = finish(o_f + flip(o_b), zg)
    yc = None if last else finish(oc_f + flip(oc_b), zgc)
    return y, yc


def moe(tokens, router_w, router_b, w1, w3, w2):
    T = tokens.shape[0]
    scores = jax.nn.sigmoid((tokens @ router_w).astype(jnp.float32))
    choice = scores + router_b.astype(jnp.float32)
    group_score = lax.top_k(choice.reshape(T, N_GROUPS, EXPERTS_PER_GROUP), 2)[0].sum(-1)
    _, gidx = lax.top_k(group_score, TOPK_GROUP)
    gmask = jax.nn.one_hot(gidx, N_GROUPS, dtype=jnp.float32).sum(1)
    emask = jnp.repeat(gmask, EXPERTS_PER_GROUP, axis=-1)
    _, eidx = lax.top_k(jnp.where(emask > 0, choice, -jnp.inf), TOP_K)
    wsel = jnp.take_along_axis(scores, eidx, -1)
    wsel = wsel / jnp.sum(wsel, -1, keepdims=True) * ROUTED_SCALE
    gates = jnp.sum(jax.nn.one_hot(eidx, N_EXPERTS, dtype=jnp.float32) * wsel[..., None], 1).astype(tokens.dtype)

    def expert_step(acc, p):
        w1e, w3e, w2e, ge = p
        y = (jax.nn.silu(tokens @ w1e) * (tokens @ w3e)) @ w2e
        return acc + ge[:, None] * y, None
    out, _ = lax.scan(expert_step, jnp.zeros_like(tokens), (w1, w3, w2, gates.T))
    return out


def setup_inputs(seed: int = 0) -> dict:
    key = jax.random.key(seed)
    ks = jax.random.split(key, 25)
    f32 = jnp.float32

    def nrm(k, shape, s):
        return jax.random.normal(k, shape, f32) * s

    def gain(k, shape):
        return 1.0 + nrm(k, shape, 0.02)
    decay_init = jnp.log(2.0 ** (5.0 + jnp.arange(RET_HEADS, dtype=f32)) - 1.0)
    return {
        'x': nrm(ks[0], (BATCH, SEQ, D_MODEL), 1.0),
        'c': nrm(ks[1], (BATCH, D_MODEL), 1.0),
        'ctx': nrm(ks[2], (BATCH, CTX_LEN, D_MODEL), 1.0),
        'c_ctx': nrm(ks[3], (D_MODEL,), 1.0),
        'w_ada': nrm(ks[4], (DEPTH, D_MODEL, N_MOD * D_MODEL), 0.5 * D_MODEL ** -0.5),
        'b_ada': nrm(ks[5], (DEPTH, N_MOD * D_MODEL), 0.02),
        'w_in': nrm(ks[6], (DEPTH, D_MODEL, IN_COLS), D_MODEL ** -0.5),
        'da_lambda': nrm(ks[7], (DEPTH, 4, DA_DIM), 0.1),
        'da_subln': gain(ks[8], (DEPTH, DA_VDIM)),
        'mla_q_norm': gain(ks[9], (DEPTH, MLA_Q_RANK)),
        'mla_w_uq': nrm(ks[10], (DEPTH, MLA_Q_RANK, MLA_HEADS * (MLA_NOPE + MLA_ROPE)), MLA_Q_RANK ** -0.5),
        'mla_kv_norm': gain(ks[11], (DEPTH, MLA_KV_RANK)),
        'mla_w_ukv': nrm(ks[12], (DEPTH, MLA_KV_RANK, MLA_HEADS * (MLA_NOPE + MLA_VDIM)), MLA_KV_RANK ** -0.5),
        'ret_decay_f': decay_init + nrm(ks[13], (DEPTH, RET_HEADS), 0.1),
        'ret_decay_b': decay_init + nrm(ks[14], (DEPTH, RET_HEADS), 0.1),
        'w_out': nrm(ks[15], (DEPTH, MIX_WIDTH, D_MODEL), BETA * MIX_WIDTH ** -0.5),
        'ln1_g': gain(ks[16], (DEPTH, D_MODEL)),
        'ln1_b': nrm(ks[17], (DEPTH, D_MODEL), 0.02),
        'router_w': nrm(ks[18], (D_MODEL, N_EXPERTS), D_MODEL ** -0.5),
        'router_b': nrm(ks[19], (N_EXPERTS,), 0.01),
        'exp_w1': nrm(ks[20], (DEPTH, N_EXPERTS, D_MODEL, D_EXPERT), D_MODEL ** -0.5),
        'exp_w3': nrm(ks[21], (DEPTH, N_EXPERTS, D_MODEL, D_EXPERT), D_MODEL ** -0.5),
        'exp_w2': nrm(ks[22], (DEPTH, N_EXPERTS, D_EXPERT, D_MODEL), BETA * D_EXPERT ** -0.5),
        'ln2_g': gain(ks[23], (DEPTH, D_MODEL)),
        'ln2_b': nrm(ks[24], (DEPTH, D_MODEL), 0.02),
    }


def reference(x, c, ctx, c_ctx, w_ada, b_ada, w_in, da_lambda, da_subln, mla_q_norm, mla_w_uq,
              mla_kv_norm, mla_w_ukv, ret_decay_f, ret_decay_b, w_out, ln1_g, ln1_b,
              router_w, router_b, exp_w1, exp_w3, exp_w2, ln2_g, ln2_b):
    B, S, D = x.shape
    C = ctx.shape[1]
    ROWS = S // GRID_W
    rope_attn = axial_rope(ROWS, ATTN_ROT_DIM)
    rope_ret = axial_rope(ROWS, RET_DIM)
    silu_c = jax.nn.silu(c)
    silu_cc = jax.nn.silu(c_ctx)
    for l in range(DEPTH):
        last = l == DEPTH - 1
        mod = (silu_c @ w_ada[l] + b_ada[l]).reshape(B, N_MOD, 1, D)
        modc = (silu_cc @ w_ada[l] + b_ada[l]).reshape(N_MOD, D)
        h = x * (1 + mod[:, 1]) + mod[:, 0]
        hc = ctx * (1 + modc[1]) + modc[0]
        parts = split_cols(h @ w_in[l])
        parts_c = split_cols(hc @ w_in[l])
        y_da, yc_da = diff_attention(parts[0:3], parts_c[0:3], da_lambda[l], da_subln[l], l, rope_attn, last)
        y_mla, yc_mla = mla_attention(parts[3:6], parts_c[3:6], mla_q_norm[l], mla_w_uq[l],
                                      mla_kv_norm[l], mla_w_ukv[l], rope_attn, last)
        y_ret, yc_ret = retention(parts[6:10], parts_c[6:10], ret_decay_f[l], ret_decay_b[l], rope_ret, last)
        y = jnp.concatenate([y_da, y_mla, y_ret], -1) @ w_out[l]
        x = layer_norm(ALPHA * x + mod[:, 2] * y, ln1_g[l], ln1_b[l])
        if not last:
            yc = jnp.concatenate([yc_da, yc_mla, yc_ret], -1) @ w_out[l]
            ctx = layer_norm(ALPHA * ctx + modc[2] * yc, ln1_g[l], ln1_b[l])
        h = x * (1 + mod[:, 4]) + mod[:, 3]
        tokens = h.reshape(B * S, D)
        if not last:
            hc = ctx * (1 + modc[4]) + modc[3]
            tokens = jnp.concatenate([tokens, hc.reshape(B * C, D)], 0)
        f = moe(tokens, router_w, router_b, exp_w1[l], exp_w3[l], exp_w2[l])
        x = layer_norm(ALPHA * x + mod[:, 5] * f[:B * S].reshape(B, S, D), ln2_g[l], ln2_b[l])
        if not last:
            ctx = layer_norm(ALPHA * ctx + modc[5] * f[B * S:].reshape(B, C, D), ln2_g[l], ln2_b[l])
    return x
```

```cpp
#include <hip/hip_runtime.h>
#include <cstdio>
#include <cstdint>

#define LAS __attribute__((address_space(3)))
typedef unsigned short bf16_t;
typedef short bf16x8 __attribute__((ext_vector_type(8)));
typedef float f32x4 __attribute__((ext_vector_type(4)));
typedef float f32x16 __attribute__((ext_vector_type(16)));
typedef unsigned u32x4 __attribute__((ext_vector_type(4)));
typedef unsigned u32x2 __attribute__((ext_vector_type(2)));

#ifndef MK_ONE_LAUNCH
#define MK_ONE_LAUNCH 1
#endif

constexpr int DM = 1024, NB = 2, SEQ = 16384, DEPTH = 4, CTXL = 256;
constexpr int TL = NB * SEQ, TC = NB * CTXL, TT = TL + TC;
constexpr int SK = SEQ + CTXL;
constexpr int NIN = 2592, NINP = 2816;
constexpr int N2P = 1536, K2 = 384, KVC0 = 768;
constexpr int ZC_DAQ = 0, ZC_DAK = 384, ZC_DAV = 768, ZC_CQ = 1152, ZC_CKV = 1408, ZC_KPE = 1536, ZC_RQ = 1568, ZC_RK = 1824, ZC_RV = 2080, ZC_RG = 2336;
constexpr int NEXP = 16, DEXP = 512, MAXPAN = 276;
constexpr int NCH = SK / 128;
constexpr float ALPHA = 1.681792830507429f;
constexpr float LOG2E = 1.4426950408889634f;
constexpr float C2_DA = 0.17677669529663687f * LOG2E;
constexpr float C2_MLA = 0.10206207261596575f * LOG2E;

constexpr size_t al256(size_t x) { return (x + 255) & ~(size_t)255; }
constexpr size_t XCD_BAR_BYTES = 16384;
constexpr size_t WS_BAR = 0;
constexpr size_t WS_CTL = WS_BAR + XCD_BAR_BYTES;
constexpr size_t CTL_BYTES = 4096;
constexpr size_t WS_ZERO_BYTES = WS_CTL + CTL_BYTES;
constexpr size_t WS_MISC = WS_ZERO_BYTES;
constexpr size_t WS_MODP = WS_MISC + 4096;
constexpr size_t WS_MODS = WS_MODP + al256((size_t)DEPTH * 8 * 3 * 6144 * 4);
constexpr size_t WS_ROPE = WS_MODS + al256((size_t)DEPTH * 3 * 6144 * 4);
constexpr size_t WS_XC = WS_ROPE + al256((size_t)256 * 48 * 4);
constexpr size_t WS_ROUTE = WS_XC + al256((size_t)TC * DM * 4);
constexpr size_t WS_GIDX = WS_ROUTE + al256((size_t)TT * 8 * 4);
constexpr size_t WS_QN = WS_GIDX + al256((size_t)MAXPAN * 256 * 4);
constexpr size_t WS_WIN = WS_QN + al256((size_t)NB * 18 * SK * 4);
constexpr size_t WS_W2M = WS_WIN + al256((size_t)NINP * DM * 2);
constexpr size_t WS_WOUT = WS_W2M + al256((size_t)N2P * K2 * 2);
constexpr size_t WS_H = WS_WOUT + al256((size_t)DM * DM * 2);
constexpr size_t WS_RETQ = WS_H + al256((size_t)TT * DM * 2);
constexpr size_t WS_RETK = WS_RETQ + al256((size_t)NB * 4 * SK * 64 * 2);
constexpr size_t WS_UST = WS_RETK + al256((size_t)NB * 4 * SK * 64 * 2);
constexpr size_t WS_A = WS_UST + al256((size_t)NB * 4 * NCH * 2 * 4096 * 4);
constexpr size_t WS_B = WS_A + al256((size_t)TT * NINP * 2);
constexpr size_t WS_C = WS_B + al256((size_t)TT * N2P * 2);
constexpr size_t SZ_QDA = (size_t)NB * 12 * SK * 32 * 2, SZ_VT = (size_t)NB * 6 * 64 * SK * 2, SZ_QMLA = (size_t)NB * 6 * SK * 96 * 2, SZ_QPE = (size_t)NB * 6 * SK * 32 * 2;
constexpr size_t WC_QRDA = 0, WC_QFDA = WC_QRDA + SZ_QDA, WC_KDA = WC_QFDA + SZ_QDA, WC_VTDA = WC_KDA + SZ_QDA, WC_QRMLA = WC_VTDA + SZ_VT,
                 WC_QPE = WC_QRMLA + SZ_QMLA, WC_KMLA = WC_QPE + SZ_QPE, WC_VTMLA = WC_KMLA + SZ_QMLA, WC_END = WC_VTMLA + SZ_VT;
constexpr size_t WC_FS = 0, WC_W13 = (size_t)144 << 20, WC_W2E = WC_W13 + (size_t)NEXP * 1024 * 1024 * 2, WC_MOE_END = WC_W2E + (size_t)NEXP * 1024 * 512 * 2;
static_assert((size_t)MAXPAN * 256 * 1024 * 2 <= WC_W13 && WC_MOE_END <= WC_END, "region C aliasing");
static_assert((size_t)MAXPAN * 256 * 1024 * 2 <= (size_t)TT * NINP * 2 && (size_t)MAXPAN * 256 * 512 * 2 <= (size_t)TT * N2P * 2, "regions A/B aliasing");
constexpr size_t WS_W13 = WS_C + al256(WC_END);
constexpr size_t WS_W2E = WS_B + al256((size_t)MAXPAN * 256 * DEXP * 2);
static_assert(WS_W2E + (size_t)NEXP * 1024 * 512 * 2 <= WS_C, "W2e fits behind Uact in region B");
constexpr size_t WS_END = WS_W13 + al256((size_t)NEXP * 1024 * 1024 * 2);

typedef __bf16 bf16v2_t __attribute__((ext_vector_type(2)));
__device__ __forceinline__ unsigned cvt_pk(float lo, float hi) { bf16v2_t v; v[0] = (__bf16)lo; v[1] = (__bf16)hi; return __builtin_bit_cast(unsigned, v); }
__device__ __forceinline__ bf16_t f2bf(float f) { return (bf16_t)(cvt_pk(f, f) & 0xffffu); }
__device__ __forceinline__ float bf2f(bf16_t b) { return __uint_as_float(((unsigned)b) << 16); }
__device__ __forceinline__ float bflo(unsigned w) { return __uint_as_float(w << 16); }
__device__ __forceinline__ float bfhi(unsigned w) { return __uint_as_float(w & 0xffff0000u); }
template <int CTRL> __device__ __forceinline__ float dppf(float v) { return __builtin_bit_cast(float, __builtin_amdgcn_update_dpp(0, __builtin_bit_cast(int, v), CTRL, 0xF, 0xF, true)); }
__device__ __forceinline__ float rdlane(float v, int l) { return __builtin_bit_cast(float, __builtin_amdgcn_readlane(__builtin_bit_cast(int, v), l)); }
__device__ __forceinline__ float rsum16(float v) { v += dppf<0xB1>(v); v += dppf<0x4E>(v); v += dppf<0x141>(v); v += dppf<0x140>(v); return v; }
__device__ __forceinline__ float add_xor16(float v) { const auto r2 = __builtin_amdgcn_permlane16_swap(__float_as_uint(v), __float_as_uint(v), false, false); return __uint_as_float(r2[0]) + __uint_as_float(r2[1]); }
__device__ __forceinline__ float add_xor32(float v) { const auto r2 = __builtin_amdgcn_permlane32_swap(__float_as_uint(v), __float_as_uint(v), false, false); return __uint_as_float(r2[0]) + __uint_as_float(r2[1]); }
__device__ __forceinline__ float wsum(float v) {
    v += dppf<0xB1>(v);
    v += dppf<0x4E>(v);
    v += dppf<0x141>(v);
    v += dppf<0x140>(v);
    return ((rdlane(v, 0) + rdlane(v, 16)) + rdlane(v, 32)) + rdlane(v, 48); }
__device__ __forceinline__ float siluf(float v) { return v / (1.0f + __expf(-v)); }
__device__ __forceinline__ u32x4 ldg16(const void* p) { return *(const __attribute__((address_space(1))) u32x4*)p; }
__device__ __forceinline__ float ldgf(const float* p) { return *(const __attribute__((address_space(1))) float*)p; }
template <class T> __device__ __forceinline__ T ldg(const void* p) { return *(const __attribute__((address_space(1))) T*)p; }
template <class T> __device__ __forceinline__ void stg(void* p, T v) { *(__attribute__((address_space(1))) T*)p = v; }
__device__ __forceinline__ int pi32(int r) { return (r & ~12) | ((r & 4) << 1) | ((r & 8) >> 1); }

#define XB_TMO      128
#define XB_XCNT(j)  (256  + 64 * (j))
#define XB_XSUB(j)  (1280 + 64 * (j))
#define XB_XGEN(j)  (2304 + 64 * (j))
#define XB_TOP      3328
#define XB_TOPGEN   3392
#define XCD_BAR_WORDS 3456
#define XB_SPIN_CAP (1u << 22)
static_assert(XCD_BAR_WORDS * 4 <= XCD_BAR_BYTES, "barrier words");

__device__ __forceinline__ unsigned xb_ld(unsigned* p)              { return __hip_atomic_load(p, __ATOMIC_RELAXED, __HIP_MEMORY_SCOPE_AGENT); }
__device__ __forceinline__ unsigned xb_add(unsigned* p, unsigned v) { return __hip_atomic_fetch_add(p, v, __ATOMIC_RELAXED, __HIP_MEMORY_SCOPE_AGENT); }
__device__ __forceinline__ unsigned xb_xcc_id() { return (unsigned)__builtin_amdgcn_s_getreg((3 << 11) | 20) & 0xFu; }
#define XB_SPIN(cond, bar) do { unsigned _sp = 0; while (cond) { __builtin_amdgcn_s_sleep(1); \
    if ((++_sp & 255u) == 0u) { if (xb_ld(&(bar)[XB_TMO])) break; if (_sp > XB_SPIN_CAP) { atomicAdd(&(bar)[XB_TMO], 1u); break; } } } } while (0)

struct XcdBarrier { unsigned* bar; unsigned x; volatile LAS unsigned* st; };

__device__ __forceinline__ XcdBarrier xcd_barrier_post(unsigned* bar, volatile LAS unsigned* st, bool is_t0) {
    XcdBarrier b; b.bar = bar; b.x = xb_xcc_id(); b.st = st;
    if (is_t0) (void)xb_add(&bar[XB_XCNT(b.x)], 1u);
    return b;
}
__device__ __forceinline__ void xcd_barrier_complete(unsigned* bar, unsigned x, unsigned& nloc, unsigned& nx) {
    const unsigned G = gridDim.x * gridDim.y * gridDim.z;
    unsigned sum, cnt, mine, sp = 0u;
    for (;;) {
        sum = 0u; cnt = 0u; mine = 0u;
#pragma unroll
        for (unsigned j = 0; j < 16; ++j) { const unsigned c = xb_ld(&bar[XB_XCNT(j)]); sum += c; cnt += (c > 0u) ? 1u : 0u; }
        if (sum == G) { mine = xb_ld(&bar[XB_XCNT(x)]); break; }
        __builtin_amdgcn_s_sleep(1);
        if ((++sp & 255u) == 0u) { if (xb_ld(&bar[XB_TMO])) break; if (sp > XB_SPIN_CAP) { atomicAdd(&bar[XB_TMO], 1u); break; } }
    }
    nloc = mine > 0u ? mine : 1u; nx = cnt > 0u ? cnt : 1u;
}
__device__ __forceinline__ void xcd_barrier(const XcdBarrier& b, bool is_t0) {
    asm volatile("s_waitcnt vmcnt(0)" ::: "memory");
    __syncthreads();
    if (is_t0) {
        unsigned* bar = b.bar; asm volatile("" : "+s"(bar));
        __builtin_amdgcn_s_waitcnt(0);
        unsigned nloc = b.st[0], nx = b.st[1];
        if (nloc == 0u) { xcd_barrier_complete(bar, b.x, nloc, nx); b.st[0] = nloc; b.st[1] = nx; }
        const unsigned old = xb_add(&bar[XB_XSUB(b.x)], 1u);
        const unsigned gen = old / nloc;
        if (old + 1u == (gen + 1u) * nloc) {
            __builtin_amdgcn_fence(__ATOMIC_RELEASE, "agent");
            asm volatile("s_waitcnt vmcnt(0)" ::: "memory");
            const unsigned og = xb_add(&bar[XB_TOP], 1u);
            const unsigned tg = og / nx;
            if (og + 1u == (tg + 1u) * nx) xb_add(&bar[XB_TOPGEN], 1u);
            else XB_SPIN(xb_ld(&bar[XB_TOPGEN]) == tg, bar);
            __builtin_amdgcn_fence(__ATOMIC_ACQUIRE, "agent");
            xb_add(&bar[XB_XGEN(b.x)], 1u);
            asm volatile("s_waitcnt vmcnt(0)" ::: "memory");
        } else {
            XB_SPIN(xb_ld(&bar[XB_XGEN(b.x)]) == gen, bar);
            __builtin_amdgcn_fence(__ATOMIC_ACQUIRE, "agent");
            asm volatile("s_waitcnt vmcnt(0)" ::: "memory");
        }
    }
    __syncthreads();
}

namespace pg8 {
constexpr int BM = 256, BK = 64, HALF = 128, HTB = HALF * BK * 2, STAGE_BYTES = 8 * HTB, NXCD = 8, WGM = 8;
__host__ __device__ __forceinline__ int lds_byte(int r, int c) { const int st = (r >> 4) * 2 + (c >> 5), rr = r & 15, cc = c & 31, ob = rr * 64 + cc * 2; return st * 1024 + (ob ^ (((ob >> 9) & 1) << 5)); }
__host__ __device__ __forceinline__ void stage_rc(int b, int& R, int& C) { const int st = b / 1024, sb = b % 1024, swz = sb ^ (((sb >> 9) & 1) << 5); R = (st >> 1) * 16 + swz / 64; C = (st & 1) * 32 + (swz % 64) / 2; }
__host__ __device__ __forceinline__ int perm32(int rho) { const int n = rho >> 4, i = rho & 15; return 8 * (i >> 2) + 4 * n + (i & 3); }

struct Unit { int pm, pn; };
struct Gemm { const bf16_t* A; const bf16_t* Bt; int M, N, K, lda, ldb; const int* bsel; size_t bstride;
              int ks_pn, k0a, nta, k0b, ntb;
              const int* gidx; };

struct StaticOrder {
    int nM, nN, nwg, G, c;
    __host__ __device__ void init(int M, int N, int G_, int c_) { nM = M / BM; nN = N / BM; nwg = nM * nN; G = G_; c = c_; }
    __host__ __device__ bool next(int i, Unit& u) const {
        const long L = (long)i * G + c; if (L >= nwg) return false;
        int wgid = (int)L; { const int q = nwg / NXCD, r = nwg % NXCD, xcd = wgid % NXCD, off = wgid / NXCD; wgid = (xcd < r ? xcd * (q + 1) : r * (q + 1) + (xcd - r) * q) + off; }
        const int nig = WGM * nN, gid = wgid / nig, fm = gid * WGM, gsz = (nM - fm) < WGM ? (nM - fm) : WGM;
        u.pm = fm + ((wgid % nig) % gsz); u.pn = (wgid % nig) / gsz; return true;
    }
    __device__ __forceinline__ void a_ready(const Unit&) const {}
    __device__ __forceinline__ void done(const Unit&) const {}
};

struct MoeOrder {
    int nM, G, c;
    __host__ __device__ void init(int M, int G_, int c_) { nM = M / BM; G = G_; c = c_; }
    __host__ __device__ bool next(int i, Unit& u) const {
        if (G == 256) { const int slot = c >> 3; u.pm = ((i * 8 + (c & 7)) << 3) + (slot & 7); u.pn = slot >> 3; return u.pm < nM; }
        const int L = i * G + c; u.pm = L >> 2; u.pn = L & 3; return u.pm < nM;
    }
    __device__ __forceinline__ void a_ready(const Unit&) const {}
    __device__ __forceinline__ void done(const Unit&) const {}
};

template <class Epi, class Sched, bool GATHER = false>
__device__ __forceinline__ void gemm_phase(LAS unsigned char* lds, const int tid, const Gemm g, const Sched& S, const Epi& E) {
    const int wid = __builtin_amdgcn_readfirstlane(tid >> 6), lane = tid & 63, wr = wid >> 2, wc = wid & 3, fr = lane & 15, fq = lane >> 4;
    const int K = g.K;
#define PG8_KOFF(u) ((size_t)(g.ks_pn < 0 ? 0 : ((u).pn < g.ks_pn ? g.k0a : g.k0b)) * 2)
#define PG8_NT(u) (g.ks_pn < 0 ? K / BK : ((u).pn < g.ks_pn ? g.nta : g.ntb))
    unsigned voffA[2], voffB[2]; int Rrow[2], Ccol[2];
#pragma unroll
    for (int i = 0; i < 2; ++i) { int R, C; stage_rc(tid * 16 + i * 8192, R, C); const int Rb = Epi::PERM ? ((R & ~31) + perm32(R & 31)) : R; Rrow[i] = R; Ccol[i] = C;
        voffA[i] = (unsigned)(R * g.lda + C) * 2u; voffB[i] = (unsigned)(Rb * g.ldb + C) * 2u; }
    unsigned gc[2][2] = {{0u, 0u}, {0u, 0u}}, gn[2][2] = {{0u, 0u}, {0u, 0u}};
#define PG8_GLOAD(dst, u) do { _Pragma("unroll") for (int h_ = 0; h_ < 2; ++h_) _Pragma("unroll") for (int i_ = 0; i_ < 2; ++i_) \
        dst[h_][i_] = (unsigned)(ldg<int>(g.gidx + (u).pm * BM + h_ * HALF + Rrow[i_]) * g.lda + Ccol[i_]) * 2u; \
        _Pragma("unroll") for (int h_ = 0; h_ < 2; ++h_) _Pragma("unroll") for (int i_ = 0; i_ < 2; ++i_) asm volatile("" : "+v"(dst[h_][i_])); } while (0)
#define PG8_STAGE_A(bufoff, gbase, hh_, ARR) do { if (GATHER) PG8_STAGE(bufoff, gbase, ARR[hh_]); else PG8_STAGE(bufoff, (gbase) + (hh_) * hstepA, voffA); } while (0)
    const size_t kstep = (size_t)(BK * 2);
    const size_t hstepA = (size_t)HALF * g.lda * 2, hstepB = (size_t)HALF * g.ldb * 2;
    const size_t tstepA = 2 * hstepA, tstepB = 2 * hstepB;
    const unsigned ldsw = (unsigned)wid * 1024u;
    const int aoff = lds_byte(wr * 64 + fr, fq * 8), boff = lds_byte(wc * 32 + fr, fq * 8);
#define PG8_SA(b, h) (((b) * 2 + (h)) * HTB)
#define PG8_SB(b, h) ((4 + (b) * 2 + (h)) * HTB)
#define PG8_STAGE(bufoff, gbase, voff) do { _Pragma("unroll") for (int _i = 0; _i < 2; ++_i) \
        __builtin_amdgcn_global_load_lds((const unsigned*)((const char*)(gbase) + (voff)[_i]), (LAS unsigned*)(lds + (bufoff) + ldsw + _i * 8192), 16, 0, 0); } while (0)
#define PG8_LDA(dst, b, h) do { _Pragma("unroll") for (int m = 0; m < 4; ++m) _Pragma("unroll") for (int k = 0; k < 2; ++k) dst[m][k] = *(const LAS bf16x8*)(lds + PG8_SA(b, h) + aoff + m * 2048 + k * 1024); } while (0)
#define PG8_LDB(dst, b, h) do { _Pragma("unroll") for (int n = 0; n < 2; ++n) _Pragma("unroll") for (int k = 0; k < 2; ++k) dst[n][k] = *(const LAS bf16x8*)(lds + PG8_SB(b, h) + boff + n * 2048 + k * 1024); } while (0)
#define PG8_MMA(ai, bj, At, Bt) do { __builtin_amdgcn_s_setprio(1); _Pragma("unroll") for (int m = 0; m < 4; ++m) _Pragma("unroll") for (int n = 0; n < 2; ++n) _Pragma("unroll") for (int k = 0; k < 2; ++k) \
        acc[ai][bj][m][n] = __builtin_amdgcn_mfma_f32_16x16x32_bf16(Bt[n][k], At[m][k], acc[ai][bj][m][n], 0, 0, 0); __builtin_amdgcn_s_setprio(0); } while (0)
#define PG8_WAIT_V(n) asm volatile("s_waitcnt vmcnt(" #n ")" ::: "memory")
#define PG8_WAIT_L(n) asm volatile("s_waitcnt lgkmcnt(" #n ")" ::: "memory")
#define PG8_BAR __builtin_amdgcn_s_barrier()
#define PG8_SCHED __builtin_amdgcn_sched_barrier(0)
#define PG8_BBASE(u) ((const char*)g.Bt + (g.bsel ? (size_t)g.bsel[(u).pm] * g.bstride * 2 : (size_t)0) + (size_t)(u).pn * tstepB)
    Unit cur, nxt; int ui = 0;
    if (!S.next(0, cur)) return;
    f32x4 acc[2][2][4][2];
#pragma unroll
    for (int a = 0; a < 2; ++a)
#pragma unroll
        for (int b = 0; b < 2; ++b)
#pragma unroll
            for (int m = 0; m < 4; ++m)
#pragma unroll
                for (int n = 0; n < 2; ++n) acc[a][b][m][n] = (f32x4){0.f, 0.f, 0.f, 0.f};
    bf16x8 At[4][2], B0[2][2], B1[2][2];
    const char* cA = (const char*)g.A + (GATHER ? (size_t)0 : (size_t)cur.pm * tstepA) + PG8_KOFF(cur); const char* cB = PG8_BBASE(cur) + PG8_KOFF(cur);
    int nt = PG8_NT(cur);
    S.a_ready(cur);
    if (GATHER) PG8_GLOAD(gc, cur);
    PG8_STAGE(PG8_SB(0, 0), cB, voffB); PG8_STAGE_A(PG8_SA(0, 0), cA, 0, gc); PG8_STAGE(PG8_SB(0, 1), cB + hstepB, voffB); PG8_STAGE_A(PG8_SA(0, 1), cA, 1, gc);
    if (wr == 1) PG8_BAR;
    PG8_WAIT_V(4); PG8_BAR;
    PG8_STAGE(PG8_SB(1, 0), cB + kstep, voffB); PG8_STAGE_A(PG8_SA(1, 0), cA + kstep, 0, gc); PG8_STAGE(PG8_SB(1, 1), cB + hstepB + kstep, voffB);
    PG8_WAIT_V(6); PG8_BAR;
    for (;;) {
        const bool has_next = S.next(ui + 1, nxt);
        const char* nA = has_next ? (const char*)g.A + (GATHER ? (size_t)0 : (size_t)nxt.pm * tstepA) + PG8_KOFF(nxt) : cA; const char* nB = has_next ? PG8_BBASE(nxt) + PG8_KOFF(nxt) : cB;
        if (GATHER) { if (has_next) PG8_GLOAD(gn, nxt); else { _Pragma("unroll") for (int h_ = 0; h_ < 2; ++h_) _Pragma("unroll") for (int i_ = 0; i_ < 2; ++i_) gn[h_][i_] = gc[h_][i_]; } }
#pragma nounroll
        for (int t = 0; t < nt; t += 2) {
            const bool last = (t == nt - 2);
            const char* a1 = cA + (size_t)(t + 1) * kstep;
            const char* a2 = last ? nA : cA + (size_t)(t + 2) * kstep; const char* b2 = last ? nB : cB + (size_t)(t + 2) * kstep;
            const char* a3 = a2 + kstep; const char* b3 = b2 + kstep;
            if (last && has_next) S.a_ready(nxt);
            unsigned g2[2][2];
#pragma unroll
            for (int h_ = 0; h_ < 2; ++h_)
#pragma unroll
                for (int i_ = 0; i_ < 2; ++i_) g2[h_][i_] = last ? gn[h_][i_] : gc[h_][i_];
            PG8_LDB(B0, 0, 0); PG8_SCHED; PG8_LDA(At, 0, 0); PG8_STAGE_A(PG8_SA(1, 1), a1, 1, gc);
            PG8_WAIT_L(8); PG8_BAR; PG8_WAIT_L(0); PG8_MMA(0, 0, At, B0); PG8_BAR; PG8_SCHED;
            PG8_LDB(B1, 0, 1); PG8_STAGE(PG8_SB(0, 0), b2, voffB);
            PG8_BAR; PG8_WAIT_L(0); PG8_MMA(0, 1, At, B1); PG8_BAR;
            PG8_LDA(At, 0, 1); PG8_STAGE_A(PG8_SA(0, 0), a2, 0, g2);
            PG8_BAR; PG8_WAIT_L(0); PG8_MMA(1, 0, At, B0); PG8_BAR; PG8_SCHED;
            PG8_STAGE(PG8_SB(0, 1), b2 + hstepB, voffB);
            PG8_WAIT_V(6); PG8_BAR; PG8_MMA(1, 1, At, B1); PG8_BAR;
            PG8_LDB(B0, 1, 0); PG8_SCHED; PG8_LDA(At, 1, 0); PG8_STAGE_A(PG8_SA(0, 1), a2, 1, g2);
            PG8_WAIT_L(8); PG8_BAR; PG8_WAIT_L(0); PG8_MMA(0, 0, At, B0); PG8_BAR; PG8_SCHED;
            PG8_LDB(B1, 1, 1); PG8_STAGE(PG8_SB(1, 0), b3, voffB);
            PG8_BAR; PG8_WAIT_L(0); PG8_MMA(0, 1, At, B1); PG8_BAR;
            PG8_LDA(At, 1, 1); PG8_STAGE_A(PG8_SA(1, 0), a3, 0, g2);
            PG8_BAR; PG8_WAIT_L(0); PG8_MMA(1, 0, At, B0); PG8_BAR; PG8_SCHED;
            PG8_STAGE(PG8_SB(1, 1), b3 + hstepB, voffB);
            PG8_WAIT_V(6); PG8_BAR; PG8_MMA(1, 1, At, B1); PG8_BAR;
        }
        E(acc, cur, wr, wc, fr, fq);
        if (!has_next) break;
#pragma unroll
        for (int a = 0; a < 2; ++a)
#pragma unroll
            for (int b = 0; b < 2; ++b)
#pragma unroll
                for (int m = 0; m < 4; ++m)
#pragma unroll
                    for (int n = 0; n < 2; ++n) acc[a][b][m][n] = (f32x4){0.f, 0.f, 0.f, 0.f};
        cur = nxt; cA = nA; cB = nB; ++ui; nt = PG8_NT(cur);
        if (GATHER) { _Pragma("unroll") for (int h_ = 0; h_ < 2; ++h_) _Pragma("unroll") for (int i_ = 0; i_ < 2; ++i_) gc[h_][i_] = gn[h_][i_]; }
    }
    PG8_WAIT_V(0);
    if (wr == 0) PG8_BAR;
    PG8_BAR;
#undef PG8_SA
#undef PG8_SB
#undef PG8_STAGE
#undef PG8_LDA
#undef PG8_LDB
#undef PG8_MMA
#undef PG8_WAIT_V
#undef PG8_WAIT_L
#undef PG8_BAR
#undef PG8_SCHED
#undef PG8_BBASE
#undef PG8_KOFF
#undef PG8_NT
#undef PG8_GLOAD
#undef PG8_STAGE_A
}

struct EpiStoreBf16 {
    static constexpr bool PERM = true;
    bf16_t* O; int ldc;
    __device__ __forceinline__ void operator()(const f32x4 (&acc)[2][2][4][2], const Unit& u, int wr, int wc, int fr, int fq) const {
        const int row0 = u.pm * BM + wr * 64 + fr, col0 = u.pn * BM + wc * 32 + 8 * fq;
#pragma unroll
        for (int ai = 0; ai < 2; ++ai)
#pragma unroll
            for (int m = 0; m < 4; ++m) { bf16_t* rowp = O + (size_t)(row0 + ai * HALF + m * 16) * ldc + col0;
#pragma unroll
                for (int bj = 0; bj < 2; ++bj) { const f32x4 v0 = acc[ai][bj][m][0], v1 = acc[ai][bj][m][1];
                    u32x4 w; w.x = cvt_pk(v0[0], v0[1]); w.y = cvt_pk(v0[2], v0[3]); w.z = cvt_pk(v1[0], v1[1]); w.w = cvt_pk(v1[2], v1[3]);
                    *(u32x4*)(rowp + bj * HALF) = w; } }
    }
};
struct EpiResGate {
    static constexpr bool PERM = false;
    float* xl; float* xc; const float* gate;
    __device__ __forceinline__ void operator()(const f32x4 (&acc)[2][2][4][2], const Unit& u, int wr, int wc, int fr, int fq) const {
        const int row0 = u.pm * BM + wr * 64 + fr, col0 = u.pn * BM + wc * 32 + 4 * fq;
        const int ms = row0 < TL ? (row0 >> 14) : 2;
        float* const base = (row0 < TL ? xl + (size_t)row0 * DM : xc + (size_t)(row0 - TL) * DM) + col0;
        const float* gp = gate + (size_t)ms * 6144 + col0;
        f32x4 gv[2][2];
#pragma unroll
        for (int bj = 0; bj < 2; ++bj)
#pragma unroll
            for (int n = 0; n < 2; ++n) gv[bj][n] = ldg<f32x4>(gp + bj * HALF + n * 16);
        f32x4 xb[3][2][2];
#define ERG_LOAD(q_) do { const float* rp_ = base + (size_t)(((q_) >> 2) * HALF + ((q_) & 3) * 16) * DM; \
            _Pragma("unroll") for (int bj = 0; bj < 2; ++bj) _Pragma("unroll") for (int n = 0; n < 2; ++n) xb[(q_) % 3][bj][n] = ldg<f32x4>(rp_ + bj * HALF + n * 16); } while (0)
        ERG_LOAD(0); ERG_LOAD(1);
#pragma unroll
        for (int q = 0; q < 8; ++q) {
            if (q + 2 < 8) ERG_LOAD(q + 2);
            float* rp = base + (size_t)((q >> 2) * HALF + (q & 3) * 16) * DM;
#pragma unroll
            for (int bj = 0; bj < 2; ++bj)
#pragma unroll
                for (int n = 0; n < 2; ++n) stg<f32x4>(rp + bj * HALF + n * 16, xb[q % 3][bj][n] * ALPHA + gv[bj][n] * acc[q >> 2][bj][q & 3][n]);
            __builtin_amdgcn_sched_barrier(0);
        }
#undef ERG_LOAD
    }
};
struct EpiSwiGLU {
    static constexpr bool PERM = true;
    bf16_t* U;
    __device__ __forceinline__ void operator()(const f32x4 (&acc)[2][2][4][2], const Unit& u, int wr, int wc, int fr, int fq) const {
        const int row0 = u.pm * BM + wr * 64 + fr, col0 = u.pn * BM + wc * 32 + 8 * fq;
#pragma unroll
        for (int ai = 0; ai < 2; ++ai)
#pragma unroll
            for (int m = 0; m < 4; ++m) { bf16_t* rowp = U + (size_t)(row0 + ai * HALF + m * 16) * DEXP + (col0 >> 1);
#pragma unroll
                for (int bj = 0; bj < 2; ++bj) { const f32x4 a = acc[ai][bj][m][0], b = acc[ai][bj][m][1];
                    float r[4];
#pragma unroll
                    for (int j = 0; j < 4; ++j) r[j] = a[j] / (1.0f + __expf(-a[j])) * b[j];
                    u32x2 w; w.x = cvt_pk(r[0], r[1]); w.y = cvt_pk(r[2], r[3]);
                    *(u32x2*)(rowp + bj * (HALF / 2)) = w; } }
    }
};
}

struct Params {
    const float *x, *c, *ctx, *c_ctx, *w_ada, *b_ada, *w_in, *da_lambda, *da_subln, *mla_q_norm, *mla_w_uq, *mla_kv_norm, *mla_w_ukv,
                *ret_decay_f, *ret_decay_b, *w_out, *ln1_g, *ln1_b, *router_w, *router_b, *exp_w1, *exp_w3, *exp_w2, *ln2_g, *ln2_b;
    float* out; unsigned char* ws; int ph_lo, ph_hi;
};
struct Frame {
    LAS unsigned char* lds; int tid, lane, wave, G, bid;
    unsigned char* ws;
    int* cnt; unsigned* kmax_da; unsigned* kmax_mla; int* misc;
    float *modp, *mods, *rope, *xc; int* route; int* gidx; float *qn_da, *qn_mla;
    bf16_t *WinT, *W2m, *WoutT, *H, *retq, *retk; float* ust;
    bf16_t *Z, *Hs, *Z2, *Uact, *QRDA, *QFDA, *KDA, *VTDA, *QRMLA, *QPE, *KMLA, *VTMLA, *Fs, *W13, *W2e;
};
constexpr int LDS_MAIN = 131072;
constexpr int LDS_BYTES = LDS_MAIN + 256;

__device__ __forceinline__ float* xrow(const Params& p, const Frame& F, int row) { return row < TL ? p.out + (size_t)row * DM : F.xc + (size_t)(row - TL) * DM; }
__device__ __forceinline__ int msel_of(int row) { return row < TL ? (row >> 14) : 2; }

template <bool ILV>
__device__ __forceinline__ void cvt_tile(const Frame& F, const float* srcA, const float* srcB, int validA, int validB, int ldsrc, int k0, bf16_t* dst, int ldd, int n0) {
    LAS float* tile = (LAS float*)F.lds;
    const int t = F.tid, kk = t >> 3, j = t & 7;
    const float* sp = (j < 4 ? srcA + 8 * j : srcB + 8 * (j - 4)) + (size_t)(k0 + kk) * ldsrc;
    const bool ok = (j < 4) ? (8 * j < validA) : (8 * (j - 4) < validB);
    f32x4 v0 = (f32x4){0.f, 0.f, 0.f, 0.f}, v1 = v0;
    if (ok) { v0 = *(const f32x4*)sp; v1 = *(const f32x4*)(sp + 4); }
    __syncthreads();
#pragma unroll
    for (int i = 0; i < 4; ++i) { tile[kk * 65 + 8 * j + i] = v0[i]; tile[kk * 65 + 8 * j + 4 + i] = v1[i]; }
    __syncthreads();
    const int nn = t >> 3, ks = t & 7;
    int col = nn; if (ILV) { const int q = nn >> 3, i = nn & 7; col = (i < 4) ? 4 * q + i : 32 + 4 * q + (i - 4); }
    float r[8];
#pragma unroll
    for (int i = 0; i < 8; ++i) r[i] = tile[(ks * 8 + i) * 65 + col];
    u32x4 w; w.x = cvt_pk(r[0], r[1]); w.y = cvt_pk(r[2], r[3]); w.z = cvt_pk(r[4], r[5]); w.w = cvt_pk(r[6], r[7]);
    *(u32x4*)(dst + (size_t)(n0 + nn) * ldd + k0 + ks * 8) = w;
}
__device__ __forceinline__ void convert_small_weights(const Params& p, const Frame& F, int l) {
    const float* win = p.w_in + (size_t)l * DM * NIN;
    const float* wout = p.w_out + (size_t)l * DM * DM;
    constexpr int T_IN = (NINP / 64) * 16, T_OUT = 16 * 16;
    for (int u = F.bid; u < T_IN + T_OUT; u += F.G) {
        if (u < T_IN) { const int tn = u >> 4, tk = u & 15, n0 = tn * 64; int vA = NIN - n0; vA = vA < 0 ? 0 : (vA > 32 ? 32 : vA); int vB = NIN - n0 - 32; vB = vB < 0 ? 0 : (vB > 32 ? 32 : vB);
            const int nc = n0 < NIN - 64 ? n0 : (n0 < NIN ? n0 : 0);
            cvt_tile<false>(F, win + nc, win + (nc + 32 < NIN ? nc + 32 : 0), vA, vB, NIN, tk * 64, F.WinT, DM, n0); }
        else { const int v = u - T_IN, tn = v >> 4, tk = v & 15;
            cvt_tile<false>(F, wout + tn * 64, wout + tn * 64 + 32, 32, 32, DM, tk * 64, F.WoutT, DM, tn * 64); }
    }
    const float* wuq = p.mla_w_uq + (size_t)l * 256 * 576; const float* wukv = p.mla_w_ukv + (size_t)l * 128 * 768;
    const float* gq = p.mla_q_norm + l * 256; const float* gkv = p.mla_kv_norm + l * 128;
    for (int i = F.bid * 512 + F.tid; i < N2P * (K2 / 8); i += F.G * 512) {
        const int n = i / (K2 / 8), k0 = (i % (K2 / 8)) * 8; float r[8];
#pragma unroll
        for (int j = 0; j < 8; ++j) { const int k = k0 + j; float v = 0.f;
            if (n < 576) { if (k < 256) v = wuq[(size_t)k * 576 + n] * gq[k] * C2_MLA; }
            else if (n >= KVC0) { if (k >= 256) v = wukv[(size_t)(k - 256) * 768 + (n - KVC0)] * gkv[k - 256]; }
            r[j] = v; }
        u32x4 w; w.x = cvt_pk(r[0], r[1]); w.y = cvt_pk(r[2], r[3]); w.z = cvt_pk(r[4], r[5]); w.w = cvt_pk(r[6], r[7]);
        *(u32x4*)(F.W2m + (size_t)n * K2 + k0) = w;
    }
}
constexpr int CVT_T13 = NEXP * 16 * 16, CVT_T2 = NEXP * 16 * 8, CVT_TILES = CVT_T13 + CVT_T2;
__device__ __forceinline__ void convert_expert_tile(const Params& p, const Frame& F, int l, int u) {
    if (u < CVT_T13) { const int e = u >> 8, tn = (u >> 4) & 15, tk = u & 15;
        const float* w1 = p.exp_w1 + ((size_t)(l * NEXP + e) * DM) * DEXP + tn * 32; const float* w3 = p.exp_w3 + ((size_t)(l * NEXP + e) * DM) * DEXP + tn * 32;
        cvt_tile<true>(F, w1, w3, 32, 32, DEXP, tk * 64, F.W13 + (size_t)e * 1024 * 1024, DM, tn * 64); }
    else { const int v = u - CVT_T13, e = v >> 7, tn = (v >> 3) & 15, tk = v & 7;
        const float* w2 = p.exp_w2 + ((size_t)(l * NEXP + e) * DEXP) * DM + tn * 64;
        cvt_tile<false>(F, w2, w2 + 32, 32, 32, DM, tk * 64, F.W2e + (size_t)e * 1024 * 512, DEXP, tn * 64); }
}

__device__ __forceinline__ void convert_expert_chunk(const Params& p, const Frame& F, int l, int c) {
    LAS float* tile = (LAS float*)F.lds;
    const int t = F.tid, kk = t >> 3, j = t & 7;
    const bool w13 = (c * 8 < CVT_T13);
    f32x4 v0[8], v1[8];
#pragma unroll
    for (int k = 0; k < 8; ++k) { const int u = c * 8 + k;
        const float* sp;
        if (w13) { const int e = u >> 8, tn = (u >> 4) & 15, tk = u & 15;
            const float* w1 = p.exp_w1 + ((size_t)(l * NEXP + e) * DM) * DEXP + tn * 32; const float* w3 = p.exp_w3 + ((size_t)(l * NEXP + e) * DM) * DEXP + tn * 32;
            sp = (j < 4 ? w1 + 8 * j : w3 + 8 * (j - 4)) + (size_t)(tk * 64 + kk) * DEXP; }
        else { const int v = u - CVT_T13, e = v >> 7, tn = (v >> 3) & 15, tk = v & 7;
            const float* w2 = p.exp_w2 + ((size_t)(l * NEXP + e) * DEXP) * DM + tn * 64;
            sp = (j < 4 ? w2 + 8 * j : w2 + 32 + 8 * (j - 4)) + (size_t)(tk * 64 + kk) * DM; }
        v0[k] = ldg<f32x4>(sp); v1[k] = ldg<f32x4>(sp + 4); }
#pragma unroll
    for (int k = 0; k < 8; ++k) { asm volatile("" : "+v"(v0[k])); asm volatile("" : "+v"(v1[k])); }
    __builtin_amdgcn_sched_barrier(0);
#pragma unroll
    for (int k = 0; k < 8; ++k) { const int u = c * 8 + k;
        __syncthreads();
#pragma unroll
        for (int i = 0; i < 4; ++i) { tile[kk * 65 + 8 * j + i] = v0[k][i]; tile[kk * 65 + 8 * j + 4 + i] = v1[k][i]; }
        __syncthreads();
        const int nn = t >> 3, ks = t & 7;
        int col = nn; if (w13) { const int q = nn >> 3, i = nn & 7; col = (i < 4) ? 4 * q + i : 32 + 4 * q + (i - 4); }
        float r[8];
#pragma unroll
        for (int i = 0; i < 8; ++i) r[i] = tile[(ks * 8 + i) * 65 + col];
        u32x4 w; w.x = cvt_pk(r[0], r[1]); w.y = cvt_pk(r[2], r[3]); w.z = cvt_pk(r[4], r[5]); w.w = cvt_pk(r[6], r[7]);
        if (w13) { const int e = u >> 8, tn = (u >> 4) & 15, tk = u & 15; stg<u32x4>(F.W13 + (size_t)e * 1024 * 1024 + (size_t)(tn * 64 + nn) * DM + tk * 64 + ks * 8, w); }
        else { const int v = u - CVT_T13, e = v >> 7, tn = (v >> 3) & 15, tk = v & 7; stg<u32x4>(F.W2e + (size_t)e * 1024 * 512 + (size_t)(tn * 64 + nn) * DEXP + tk * 64 + ks * 8, w); }
    }
}

__device__ __forceinline__ void phase_prologue(const Params& p, const Frame& F) {
    LAS float* sv = (LAS float*)(F.lds + 32768);
    for (int i = F.tid; i < 3 * DM; i += 512) { const float v = i < 2 * DM ? p.c[i] : p.c_ctx[i - 2 * DM]; sv[i] = siluf(v); }
    __syncthreads();
    for (int it = F.bid * 512 + F.tid; it < DEPTH * 8 * 6144; it += F.G * 512) {
        const int n = it % 6144, ks = (it / 6144) & 7, l = it / (6144 * 8);
        const float* w = p.w_ada + ((size_t)l * DM + ks * 128) * 6144 + n;
        float a0 = 0.f, a1 = 0.f, a2 = 0.f;
#pragma unroll 8
        for (int k = 0; k < 128; ++k) { const float wv = w[(size_t)k * 6144]; a0 += sv[ks * 128 + k] * wv; a1 += sv[DM + ks * 128 + k] * wv; a2 += sv[2 * DM + ks * 128 + k] * wv; }
        float* o = F.modp + ((size_t)(l * 8 + ks) * 3) * 6144 + n; o[0] = a0; o[6144] = a1; o[2 * 6144] = a2;
    }
    for (int it = F.bid * 512 + F.tid; it < 256 * 24; it += F.G * 512) {
        const int idx = it / 24, f = it % 24; const bool ret = f >= 8; const int fi = ret ? f - 8 : f, nf = ret ? 16 : 8;
        const double freq = exp2(-(double)fi / (double)nf * 13.287712379549449);
        double ang = (double)idx * freq; const double k = rint(ang * 0.15915494309189535); ang = ang - k * 6.283185307179586 ;
        const float a = (float)ang; const float cs = cosf(a), sn = sinf(a);
        float* rp = F.rope + idx * 48;
        if (ret) { rp[16 + fi] = cs; rp[32 + fi] = sn; } else { rp[fi] = cs; rp[8 + fi] = sn; }
    }
    for (size_t i = (size_t)F.bid * 512 + F.tid; i < (size_t)TL * DM / 4; i += (size_t)F.G * 512) ((f32x4*)p.out)[i] = ((const f32x4*)p.x)[i];
    for (size_t i = (size_t)F.bid * 512 + F.tid; i < (size_t)TC * DM / 4; i += (size_t)F.G * 512) ((f32x4*)F.xc)[i] = ((const f32x4*)p.ctx)[i];
    convert_small_weights(p, F, 0);
}
__device__ __forceinline__ void phase_mods(const Params& p, const Frame& F) {
    for (int it = F.bid * 512 + F.tid; it < DEPTH * 3 * 6144; it += F.G * 512) {
        const int n = it % 6144, v = (it / 6144) % 3, l = it / (3 * 6144);
        float a = p.b_ada[l * 6144 + n];
#pragma unroll
        for (int ks = 0; ks < 8; ++ks) a += F.modp[((size_t)(l * 8 + ks) * 3 + v) * 6144 + n];
        F.mods[it] = a;
    }
}
__device__ __forceinline__ void phase_modulate(const Params& p, const Frame& F, int l, int shift_idx) {
    for (int row = F.bid * 8 + F.wave; row < TT; row += F.G * 8) {
        const float* xr = xrow(p, F, row); const float* md = F.mods + ((size_t)l * 3 + msel_of(row)) * 6144;
#pragma unroll
        for (int j = 0; j < 4; ++j) { const int c = j * 256 + F.lane * 4; const f32x4 xv = ldg<f32x4>(xr + c), sh = ldg<f32x4>(md + shift_idx * DM + c), sc = ldg<f32x4>(md + (shift_idx + 1) * DM + c);
            const f32x4 h = xv * (sc + 1.0f) + sh; u32x2 w; w.x = cvt_pk(h[0], h[1]); w.y = cvt_pk(h[2], h[3]); stg<u32x2>(F.H + (size_t)row * DM + c, w); }
    }
}

struct TokTile { int r0, b, isctx, pos0, kidx0, pF0, n; };
constexpr int NU_LAT = TL / 32, NU_POST = NU_LAT + TC / 2;
constexpr int PT = 32;
__device__ __forceinline__ TokTile tok_tile(int u) {
    TokTile t;
    if (u < NU_LAT) { t.r0 = u * PT; t.isctx = 0; t.b = t.r0 >> 14; t.pos0 = t.r0 & (SEQ - 1); t.kidx0 = t.pos0; t.pF0 = CTXL + t.pos0; t.n = PT; }
    else { const int c0 = (u - NU_LAT) * 2; t.r0 = TL + c0; t.isctx = 1; t.b = c0 >> 8; t.pos0 = c0 & 255; t.kidx0 = SEQ + t.pos0; t.pF0 = t.pos0; t.n = 2; }
    return t;
}
constexpr int VT_PITCH = 68;
__device__ __forceinline__ void vt_writeout(const Frame& F, bf16_t* dst_b  , int kidx0, int n) {
    const LAS bf16_t* vt = (const LAS bf16_t*)F.lds;
    if (n == PT) {
        for (int idx = F.tid; idx < 384 * (PT / 4); idx += 512) { const int col = idx / (PT / 4), seg = idx % (PT / 4);
            const u32x2 w = *(const LAS u32x2*)(vt + col * VT_PITCH + seg * 4);
            stg<u32x2>(dst_b + (size_t)col * SK + kidx0 + seg * 4, w); }
    } else {
        for (int col = F.tid; col < 384; col += 512) stg<unsigned>(dst_b + (size_t)col * SK + kidx0, *(const LAS unsigned*)(vt + col * VT_PITCH));
    }
}
__device__ __forceinline__ void phase_post1(const Params& p, const Frame& F, int l) {
    LAS bf16_t* vt = (LAS bf16_t*)F.lds;
    LAS unsigned* lmax = (LAS unsigned*)(F.lds + 65536);
    const int lane = F.lane;
    for (int u = F.bid; u < NU_POST; u += F.G) {
        const TokTile tt = tok_tile(u);
        float kmx[3] = {0.f, 0.f, 0.f};
        if (F.tid < 12) lmax[F.tid] = 0u;
        __syncthreads();
        unsigned wqS[PT / 8][3], wkS[PT / 8][3], wvS[PT / 8][3], wrqS[PT / 8][2], wrkS[PT / 8][2]; float csaS[PT / 8][3], snaS[PT / 8][3], csrS[PT / 8][2], snrS[PT / 8][2];
#pragma unroll
        for (int i = 0; i < PT / 8; ++i) {
            const int tok = F.wave * (PT / 8) + i, row = tt.r0 + tok, pos = tt.pos0 + tok;
#pragma unroll
            for (int j = 0; j < 3; ++j) { wqS[i][j] = 0u; wkS[i][j] = 0u; wvS[i][j] = 0u; csaS[i][j] = 0.f; snaS[i][j] = 0.f; }
#pragma unroll
            for (int j = 0; j < 2; ++j) { wrqS[i][j] = 0u; wrkS[i][j] = 0u; csrS[i][j] = 0.f; snrS[i][j] = 0.f; }
            if (tok < tt.n) {
                const bf16_t* z = F.Z + (size_t)row * NINP;
                const float* rr = F.rope + (pos >> 6) * 48; const float* rc = F.rope + (pos & 63) * 48;
#pragma unroll
                for (int j = 0; j < 3; ++j) { const int pr = lane + 64 * j, i16 = pr & 15; const float* rp = (i16 < 8) ? rr : rc;
                    wqS[i][j] = ldg<unsigned>(z + ZC_DAQ + 2 * pr); wkS[i][j] = ldg<unsigned>(z + ZC_DAK + 2 * pr); wvS[i][j] = ldg<unsigned>(z + ZC_DAV + 2 * lane + 128 * j);
                    csaS[i][j] = ldgf(rp + (i16 & 7)); snaS[i][j] = ldgf(rp + 8 + (i16 & 7)); }
#pragma unroll
                for (int j = 0; j < 2; ++j) { const int pr = lane + 64 * j, i32 = pr & 31; const float* rp = (i32 < 16) ? rr : rc;
                    wrqS[i][j] = ldg<unsigned>(z + ZC_RQ + 2 * pr); wrkS[i][j] = ldg<unsigned>(z + ZC_RK + 2 * pr);
                    csrS[i][j] = ldgf(rp + 16 + (i32 & 15)); snrS[i][j] = ldgf(rp + 32 + (i32 & 15)); }
            }
        }
        __builtin_amdgcn_sched_barrier(0);
#pragma unroll
        for (int i = 0; i < PT / 8; ++i) {
            const int tok = F.wave * (PT / 8) + i, kidx = tt.kidx0 + tok, pF = tt.pF0 + tok;
            if (tok >= tt.n) break;
            unsigned wq[3], wk[3], wv[3], wrq[2], wrk[2]; float csa[3], sna[3], csr[2], snr[2];
#pragma unroll
            for (int j = 0; j < 3; ++j) { wq[j] = wqS[i][j]; wk[j] = wkS[i][j]; wv[j] = wvS[i][j]; csa[j] = csaS[i][j]; sna[j] = snaS[i][j]; }
#pragma unroll
            for (int j = 0; j < 2; ++j) { wrq[j] = wrqS[i][j]; wrk[j] = wrkS[i][j]; csr[j] = csrS[i][j]; snr[j] = snrS[i][j]; }
#pragma unroll
            for (int j = 0; j < 3; ++j) {
                const int pr = lane + 64 * j, hm = pr >> 4, i16 = pr & 15;
                const float cs = tt.isctx ? 1.f : csa[j], sn = tt.isctx ? 0.f : sna[j];
                const size_t o = ((size_t)(tt.b * 12 + hm) * SK + kidx) * 32 + 2 * i16;
                { const unsigned w = wq[j]; const float x1 = bflo(w) * C2_DA, x2 = bfhi(w) * C2_DA;
                  stg<unsigned>(F.QFDA + o, cvt_pk(x1, x2));
                  stg<unsigned>(F.QRDA + o, cvt_pk(x1 * cs - x2 * sn, x1 * sn + x2 * cs));
                  const float n2 = rsum16(x1 * x1 + x2 * x2);
                  if (i16 == 0) stg<float>(F.qn_da + (size_t)(tt.b * 12 + hm) * SK + kidx, sqrtf(n2)); }
                { const unsigned w = wk[j]; const float x1 = bflo(w), x2 = bfhi(w);
                  stg<unsigned>(F.KDA + o, cvt_pk(x1 * cs - x2 * sn, x1 * sn + x2 * cs));
                  const float n2 = rsum16(x1 * x1 + x2 * x2);
                  kmx[j] = fmaxf(kmx[j], n2); }
            }
#pragma unroll
            for (int j = 0; j < 3; ++j) { const int col = 2 * lane + 128 * j; const unsigned w = wv[j];
                vt[col * VT_PITCH + tok] = (bf16_t)(w & 0xffffu); vt[(col + 1) * VT_PITCH + tok] = (bf16_t)(w >> 16); }
#pragma unroll
            for (int j = 0; j < 2; ++j) {
                const int pr = lane + 64 * j, h = pr >> 5, i32 = pr & 31;
                const float cs = tt.isctx ? 1.f : csr[j], sn = tt.isctx ? 0.f : snr[j];
                const size_t o = ((size_t)(tt.b * 4 + h) * SK + pF) * 64 + 2 * i32;
                { const unsigned w = wrq[j]; const float x1 = bflo(w), x2 = bfhi(w);
                  stg<unsigned>(F.retq + o, cvt_pk(x1 * cs - x2 * sn, x1 * sn + x2 * cs)); }
                { const unsigned w = wrk[j]; const float x1 = bflo(w) * 0.125f, x2 = bfhi(w) * 0.125f;
                  stg<unsigned>(F.retk + o, cvt_pk(x1 * cs - x2 * sn, x1 * sn + x2 * cs)); }
            }
        }
        if ((lane & 15) == 0) {
#pragma unroll
            for (int j = 0; j < 3; ++j) __hip_atomic_fetch_max(lmax + ((lane + 64 * j) >> 4), __float_as_uint(kmx[j]), __ATOMIC_RELAXED, __HIP_MEMORY_SCOPE_WORKGROUP);
        }
        __syncthreads();
        if (F.tid < 12) atomicMax(F.kmax_da + l * 24 + tt.b * 12 + F.tid, lmax[F.tid]);
        vt_writeout(F, F.VTDA + (size_t)tt.b * 384 * SK, tt.kidx0, tt.n);
    }
}

__device__ __forceinline__ void phase_post2(const Params& p, const Frame& F, int l) {
    LAS bf16_t* vt = (LAS bf16_t*)F.lds;
    LAS unsigned* lmax = (LAS unsigned*)(F.lds + 65536);
    const int lane = F.lane;
    for (int u = F.bid; u < NU_POST; u += F.G) {
        const TokTile tt = tok_tile(u);
        float kmx[6] = {0.f, 0.f, 0.f, 0.f, 0.f, 0.f};
        if (F.tid < 6) lmax[F.tid] = 0u;
        __syncthreads();
        u32x2 wcqS[PT / 8]; unsigned wckvS[PT / 8], wqS[PT / 8][5], wknS[PT / 8][3], wvvS[PT / 8][3], wpeS[PT / 8]; float csqS[PT / 8][5], snqS[PT / 8][5], cspeS[PT / 8], snpeS[PT / 8];
#pragma unroll
        for (int i = 0; i < PT / 8; ++i) {
            const int tok = F.wave * (PT / 8) + i, row = tt.r0 + tok, pos = tt.pos0 + tok;
            wcqS[i] = (u32x2){0u, 0u}; wckvS[i] = 0u; wpeS[i] = 0u; cspeS[i] = 0.f; snpeS[i] = 0.f;
#pragma unroll
            for (int j = 0; j < 5; ++j) { wqS[i][j] = 0u; csqS[i][j] = 0.f; snqS[i][j] = 0.f; }
#pragma unroll
            for (int j = 0; j < 3; ++j) { wknS[i][j] = 0u; wvvS[i][j] = 0u; }
            if (tok < tt.n) {
                const bf16_t* z = F.Z + (size_t)row * NINP; const bf16_t* z2 = F.Z2 + (size_t)row * N2P;
                const float* rr = F.rope + (pos >> 6) * 48; const float* rc = F.rope + (pos & 63) * 48;
                wcqS[i] = ldg<u32x2>(z + ZC_CQ + 4 * lane); wckvS[i] = ldg<unsigned>(z + ZC_CKV + 2 * lane);
#pragma unroll
                for (int j = 0; j < 5; ++j) { const int pr = lane + 64 * j; wqS[i][j] = (pr < 288) ? ldg<unsigned>(z2 + 2 * pr) : 0u; }
#pragma unroll
                for (int j = 0; j < 3; ++j) { const int pr = lane + 64 * j, h = pr >> 5, i32 = pr & 31; wknS[i][j] = ldg<unsigned>(z2 + KVC0 + h * 128 + 2 * i32); wvvS[i][j] = ldg<unsigned>(z2 + KVC0 + h * 128 + 64 + 2 * i32); }
                wpeS[i] = ldg<unsigned>(z + ZC_KPE + 2 * (lane & 15));
#pragma unroll
                for (int j = 0; j < 5; ++j) { const int pr = lane + 64 * j, i48 = pr % 48, i16 = (i48 - 32) & 15; const float* rp = (i16 < 8) ? rr : rc; csqS[i][j] = ldgf(rp + (i16 & 7)); snqS[i][j] = ldgf(rp + 8 + (i16 & 7)); }
                { const int i16 = lane & 15; const float* rp = (i16 < 8) ? rr : rc; cspeS[i] = ldgf(rp + (i16 & 7)); snpeS[i] = ldgf(rp + 8 + (i16 & 7)); }
            }
        }
        __builtin_amdgcn_sched_barrier(0);
#pragma unroll
        for (int i = 0; i < PT / 8; ++i) {
            const int tok = F.wave * (PT / 8) + i, kidx = tt.kidx0 + tok;
            if (tok >= tt.n) break;
            const u32x2 wcq = wcqS[i]; const unsigned wckv = wckvS[i], wpe = wpeS[i]; const float cspe = cspeS[i], snpe = snpeS[i];
            unsigned wq[5], wkn[3], wvv[3]; float csq[5], snq[5];
#pragma unroll
            for (int j = 0; j < 5; ++j) { wq[j] = wqS[i][j]; csq[j] = csqS[i][j]; snq[j] = snqS[i][j]; }
#pragma unroll
            for (int j = 0; j < 3; ++j) { wkn[j] = wknS[i][j]; wvv[j] = wvvS[i][j]; }
            float rinv_q, rinv_kv;
            { const float a = bflo(wcq.x), b = bfhi(wcq.x), c = bflo(wcq.y), d = bfhi(wcq.y);
              rinv_q = rsqrtf(wsum(a * a + b * b + c * c + d * d) * (1.0f / 256.0f) + 1e-6f); }
            { const float a = bflo(wckv), b = bfhi(wckv);
              rinv_kv = rsqrtf(wsum(a * a + b * b) * (1.0f / 128.0f) + 1e-6f); }
            float qs[6] = {0.f, 0.f, 0.f, 0.f, 0.f, 0.f};
#pragma unroll
            for (int j = 0; j < 5; ++j) {
                const int pr = lane + 64 * j;
                if (pr < 288) {
                    const int h = pr / 48, i48 = pr - h * 48;
                    const unsigned w = wq[j]; const float x1 = bflo(w) * rinv_q, x2 = bfhi(w) * rinv_q;
                    const size_t qo = ((size_t)(tt.b * 6 + h) * SK + kidx);
                    if (i48 < 32) stg<unsigned>(F.QRMLA + qo * 96 + 2 * i48, cvt_pk(x1, x2));
                    else { const int i16 = i48 - 32; const float cs = tt.isctx ? 1.f : csq[j], sn = tt.isctx ? 0.f : snq[j];
                        stg<unsigned>(F.QPE + qo * 32 + 2 * i16, cvt_pk(x1, x2));
                        stg<unsigned>(F.QRMLA + qo * 96 + 64 + 2 * i16, cvt_pk(x1 * cs - x2 * sn, x1 * sn + x2 * cs)); }
                    const float n2 = x1 * x1 + x2 * x2;
#pragma unroll
                    for (int hh = 0; hh < 6; ++hh) qs[hh] += (h == hh) ? n2 : 0.f;
                }
            }
#pragma unroll
            for (int hh = 0; hh < 6; ++hh) { const float s = wsum(qs[hh]); if (lane == hh) stg<float>(F.qn_mla + (size_t)(tt.b * 6 + hh) * SK + kidx, sqrtf(s)); }
            float pe2 = 0.f;
            { const int i16 = lane & 15; const unsigned w = wpe; const float x1 = bflo(w), x2 = bfhi(w);
              const float cs = tt.isctx ? 1.f : cspe, sn = tt.isctx ? 0.f : snpe;
              const unsigned pk = cvt_pk(x1 * cs - x2 * sn, x1 * sn + x2 * cs);
              if (lane < 16) {
#pragma unroll
                  for (int h = 0; h < 6; ++h) stg<unsigned>(F.KMLA + ((size_t)(tt.b * 6 + h) * SK + kidx) * 96 + 64 + 2 * i16, pk); }
              pe2 = rsum16(x1 * x1 + x2 * x2); }
#pragma unroll
            for (int j = 0; j < 3; ++j) {
                const int pr = lane + 64 * j, h = pr >> 5, i32 = pr & 31;
                const unsigned w = wkn[j]; const float x1 = bflo(w) * rinv_kv, x2 = bfhi(w) * rinv_kv;
                stg<unsigned>(F.KMLA + ((size_t)(tt.b * 6 + h) * SK + kidx) * 96 + 2 * i32, cvt_pk(x1, x2));
                const float n2 = add_xor16(rsum16(x1 * x1 + x2 * x2));
                kmx[2 * j] = fmaxf(kmx[2 * j], (lane < 32) ? n2 + pe2 : 0.f); kmx[2 * j + 1] = fmaxf(kmx[2 * j + 1], (lane >= 32) ? n2 + pe2 : 0.f);
                const unsigned wv = wvv[j];
                const unsigned pv = cvt_pk(bflo(wv) * rinv_kv, bfhi(wv) * rinv_kv);
                const int col = h * 64 + 2 * i32;
                vt[col * VT_PITCH + tok] = (bf16_t)(pv & 0xffffu); vt[(col + 1) * VT_PITCH + tok] = (bf16_t)(pv >> 16);
            }
        }
        if (lane == 0 || lane == 32) {
#pragma unroll
            for (int j = 0; j < 3; ++j) { const int h = 2 * j + (lane >> 5); __hip_atomic_fetch_max(lmax + h, __float_as_uint(lane == 0 ? kmx[2 * j] : kmx[2 * j + 1]), __ATOMIC_RELAXED, __HIP_MEMORY_SCOPE_WORKGROUP); }
        }
        __syncthreads();
        if (F.tid < 6) atomicMax(F.kmax_mla + l * 12 + tt.b * 6 + F.tid, lmax[F.tid]);
        vt_writeout(F, F.VTMLA + (size_t)tt.b * 384 * SK, tt.kidx0, tt.n);
    }
}

#define MFMA32(a, b, c) __builtin_amdgcn_mfma_f32_32x32x16_bf16(a, b, c, 0, 0, 0)
struct AttnArgs {
    const bf16_t *qr0, *qr1, *qf0, *qf1;
    const bf16_t* qpe;
    const bf16_t *k0, *k1;
    const bf16_t* vt;
    const float *qn0, *qn1; float kmax0, kmax1;
    int q0, t0, t1;
    bf16_t* y; int yrow0;
    float lam, post; const float* subg;
};
template <int DQK, bool DA>
__device__ __forceinline__ void attn_item(const Frame& F, const AttnArgs& A) {
    constexpr int NST = DQK / 16, NKC = DQK / 8, KREG = NKC * 2048, BUFB = KREG + 16384, NKL = NKC / 4;
    const int tid = F.tid, lane = F.lane, r = lane & 31, hh = lane >> 5, wave = F.wave;
    const int qk = A.q0 + wave * 32 + r;
    const int kkey = tid & 127, kch0 = tid >> 7;
    unsigned voffb[2];
#pragma unroll
    for (int j = 0; j < 2; ++j) { const int item = tid + 512 * j, vd = item >> 4, c = (item & 15) ^ (vd & 15); voffb[j] = (unsigned)(vd * SK + c * 8) * 2u; }
    const int kl0 = hh * 2048 + pi32(r) * 16;
    const int vl0 = r * 256, vsw = r & 15;
    unsigned o0p[16];
#pragma unroll
    for (int i = 0; i < 16; ++i) o0p[i] = 0u;
    f32x16 O[2]; float inv = 0.f;
#pragma nounroll
    for (int m = 0; m < (DA ? 2 : 1); ++m) {
        const bf16_t* qrp = (DA && m) ? A.qr1 : A.qr0; const bf16_t* qfp = (DA && m) ? A.qf1 : A.qf0;
        const char* kbase = (const char*)((DA && m) ? A.k1 : A.k0);
        const float bound = ldgf(((DA && m) ? A.qn1 : A.qn0) + qk) * ((DA && m) ? A.kmax1 : A.kmax0);
        f32x16 cinit;
#pragma unroll
        for (int i = 0; i < 16; ++i) { cinit[i] = -bound; O[0][i] = 0.f; O[1][i] = 0.f; }
        float lsum = 0.f;
        constexpr bool LSUM_MFMA = false;
        const bf16x8 ones8 = __builtin_bit_cast(bf16x8, (u32x4){0x3F803F80u, 0x3F803F80u, 0x3F803F80u, 0x3F803F80u});
        f32x16 Lacc;
#pragma unroll
        for (int i = 0; i < 16; ++i) Lacc[i] = 0.f;
        bf16x8 qf[NST];
        const unsigned kdma = (unsigned)((kch0) * 2048 + (kkey & 64) * 16);
        const unsigned vdma = (unsigned)(KREG + (tid & ~63) * 16);
#define ATT_LOADG(t, bsel) do { LAS unsigned char* db_ = F.lds + (bsel) * BUFB; \
            _Pragma("unroll") for (int j_ = 0; j_ < NKL; ++j_) __builtin_amdgcn_global_load_lds((const unsigned*)(kbase + (size_t)(t) * (128 * DQK * 2) + (unsigned)(kkey * DQK + (kch0 + 4 * j_) * 8) * 2u), \
                (LAS unsigned*)(db_ + __builtin_amdgcn_readfirstlane(kdma) + j_ * 8192), 16, 0, 0); \
            _Pragma("unroll") for (int j_ = 0; j_ < 2; ++j_) __builtin_amdgcn_global_load_lds((const unsigned*)((const char*)A.vt + (size_t)(t) * 256 + voffb[j_]), \
                (LAS unsigned*)(db_ + __builtin_amdgcn_readfirstlane(vdma) + j_ * 8192), 16, 0, 0); } while (0)
        bf16x8 kf[NST], vf[2][4]; f32x16 sv[2]; u32x4 pb[2][2];
#pragma unroll
        for (int i = 0; i < 4; ++i) vf[1][i] = __builtin_bit_cast(bf16x8, (u32x4){0u, 0u, 0u, 0u});
        pb[1][0] = (u32x4){0u, 0u, 0u, 0u}; pb[1][1] = pb[1][0];
        __syncthreads();
        ATT_LOADG(A.t0, 0);
        int t = A.t0;
#pragma nounroll
        for (int seg = 0; seg < 2; ++seg) {
            const int tend = (seg == 0) ? (A.t1 < 128 ? A.t1 : 128) : A.t1;
            if (t >= tend) continue;
#pragma unroll
            for (int st = 0; st < NST; ++st) {
                const bf16_t* src;
                if (DQK == 32) src = (seg ? qfp : qrp) + (size_t)qk * 32 + st * 16 + hh * 8;
                else src = (seg && st >= 4) ? A.qpe + (size_t)qk * 32 + (st - 4) * 16 + hh * 8 : qrp + (size_t)qk * 96 + st * 16 + hh * 8;
                qf[st] = __builtin_bit_cast(bf16x8, ldg16(src)); }
#pragma unroll
            for (int st = 0; st < NST; ++st) asm volatile("" : "+v"(qf[st]));
        for (; t < tend; ++t) {
            const int bsel = (t - A.t0) & 1;
            LAS unsigned char* buf = F.lds + bsel * BUFB;
            asm volatile("s_waitcnt vmcnt(0)" ::: "memory");
            __syncthreads();
#define ATT_RK(j) do { _Pragma("unroll") for (int st_ = 0; st_ < NST; ++st_) kf[st_] = *(const LAS bf16x8*)(buf + st_ * 4096 + kl0 + (j) * 512); } while (0)
#define ATT_RV(j, set) do { _Pragma("unroll") for (int vt_ = 0; vt_ < 2; ++vt_) _Pragma("unroll") for (int s2_ = 0; s2_ < 2; ++s2_) \
                vf[set][vt_ * 2 + s2_] = *(const LAS bf16x8*)(buf + KREG + vt_ * 8192 + vl0 + (((4 * (j) + 2 * s2_ + hh) ^ vsw) << 4)); } while (0)
#define ATT_S(set) do { sv[set] = cinit; _Pragma("unroll") for (int st_ = 0; st_ < NST; ++st_) sv[set] = MFMA32(kf[st_], qf[st_], sv[set]); } while (0)
#define ATT_PV(set, vset) do { _Pragma("unroll") for (int vt_ = 0; vt_ < 2; ++vt_) _Pragma("unroll") for (int s2_ = 0; s2_ < 2; ++s2_) \
                O[vt_] = MFMA32(vf[vset][vt_ * 2 + s2_], __builtin_bit_cast(bf16x8, pb[set][s2_]), O[vt_]); \
                if (LSUM_MFMA) { _Pragma("unroll") for (int s2_ = 0; s2_ < 2; ++s2_) Lacc = MFMA32(ones8, __builtin_bit_cast(bf16x8, pb[set][s2_]), Lacc); } } while (0)
#define ATT_EXP(set) do { float ls_ = 0.f; _Pragma("unroll") for (int i_ = 0; i_ < 16; ++i_) { sv[set][i_] = __builtin_amdgcn_exp2f(sv[set][i_]); if (!LSUM_MFMA) ls_ += sv[set][i_]; } lsum += ls_; \
                pb[set][0] = (u32x4){cvt_pk(sv[set][0], sv[set][1]), cvt_pk(sv[set][2], sv[set][3]), cvt_pk(sv[set][4], sv[set][5]), cvt_pk(sv[set][6], sv[set][7])}; \
                pb[set][1] = (u32x4){cvt_pk(sv[set][8], sv[set][9]), cvt_pk(sv[set][10], sv[set][11]), cvt_pk(sv[set][12], sv[set][13]), cvt_pk(sv[set][14], sv[set][15])}; } while (0)
            ATT_RK(0);
#pragma unroll
            for (int vt_ = 0; vt_ < 2; ++vt_)
#pragma unroll
                for (int s2_ = 0; s2_ < 2; ++s2_) { O[vt_] = MFMA32(vf[1][vt_ * 2 + s2_], __builtin_bit_cast(bf16x8, pb[1][s2_]), O[vt_]); asm volatile("" : "+v"(O[vt_])); }
#pragma unroll
            for (int st_ = 0; st_ < NST; ++st_) { sv[0] = MFMA32(kf[st_], qf[st_], st_ == 0 ? cinit : sv[0]); asm volatile("" : "+v"(sv[0])); kf[st_] = *(const LAS bf16x8*)(buf + st_ * 4096 + kl0 + 512); }
            __builtin_amdgcn_sched_barrier(0);
            if (t + 1 < A.t1) ATT_LOADG(t + 1, bsel ^ 1);
            __builtin_amdgcn_sched_barrier(0);
            static_assert(NST == 6 || NST == 2, "attn_item slot schedule");
#define ME_(i_) sv[se_][i_] = __builtin_amdgcn_exp2f(sv[se_][i_])
#define MA_(i_) ls_ += sv[se_][i_]
#define MC_(k_) pw_[k_] = cvt_pk(sv[se_][2 * (k_)], sv[se_][2 * (k_) + 1])
#define MGEND_() do { asm volatile("" : "+v"(sv[se_]), "+v"(ls_)); __builtin_amdgcn_sched_barrier(0); } while (0)
#define MS_(st_) do { if (j + 1 < 4 && (st_) < NST) { sv[so_] = MFMA32(kf[st_], qf[st_], (st_) == 0 ? cinit : sv[so_]); asm volatile("" : "+v"(sv[so_])); \
                    if (j + 2 < 4) kf[st_] = *(const LAS bf16x8*)(buf + (st_) * 4096 + kl0 + (j + 2) * 512); } } while (0)
#define MP_(vt_, s2_) do { if (j >= 1) { O[vt_] = MFMA32(vf[0][(vt_) * 2 + (s2_)], __builtin_bit_cast(bf16x8, pb[so_][s2_]), O[vt_]); asm volatile("" : "+v"(O[vt_])); \
                    if (j < 3) vf[0][(vt_) * 2 + (s2_)] = *(const LAS bf16x8*)(buf + KREG + (vt_) * 8192 + vl0 + (((4 * j + 2 * (s2_) + hh) ^ vsw) << 4)); } } while (0)
#pragma unroll
            for (int j = 0; j < 4; ++j) {
                const int se_ = j & 1, so_ = se_ ^ 1;
                if (j == 0) ATT_RV(0, 0);
                float ls_ = 0.f; unsigned pw_[8];
                MS_(0);       ME_(0); ME_(1); MGEND_();
                MP_(0, 0);    ME_(2); ME_(3); MA_(0); MA_(1); MGEND_();
                MS_(1);       ME_(4); ME_(5); MA_(2); MA_(3); MC_(0); asm volatile("" : "+v"(pw_[0])); MGEND_();
                MP_(1, 0);    ME_(6); ME_(7); MA_(4); MA_(5); MC_(1); asm volatile("" : "+v"(pw_[1])); MGEND_();
                MS_(2);       ME_(8); ME_(9); MA_(6); MA_(7); MC_(2); asm volatile("" : "+v"(pw_[2])); MGEND_();
                MP_(0, 1);    ME_(10); ME_(11); MA_(8); MA_(9); MC_(3); asm volatile("" : "+v"(pw_[3])); MGEND_();
                MS_(3);       ME_(12); ME_(13); MA_(10); MA_(11); MC_(4); asm volatile("" : "+v"(pw_[4])); MGEND_();
                MP_(1, 1);    ME_(14); ME_(15); MA_(12); MA_(13); MC_(5); asm volatile("" : "+v"(pw_[5])); MGEND_();
                MS_(4);       MA_(14); MC_(6); asm volatile("" : "+v"(pw_[6])); MGEND_();
                MS_(5);       MA_(15); MC_(7);
                lsum += ls_; pb[se_][0] = (u32x4){pw_[0], pw_[1], pw_[2], pw_[3]}; pb[se_][1] = (u32x4){pw_[4], pw_[5], pw_[6], pw_[7]};
                asm volatile("" : "+v"(pb[se_][0]), "+v"(pb[se_][1]), "+v"(lsum));
                __builtin_amdgcn_sched_barrier(0);
            }
#undef MP_
#undef MS_
#undef MGEND_
#undef MC_
#undef MA_
#undef ME_
            ATT_RV(3, 1);
#undef ATT_RK
#undef ATT_RV
#undef ATT_S
#undef ATT_PV
#undef ATT_EXP
        }
        }
#undef ATT_LOADG
#pragma unroll
        for (int vt_ = 0; vt_ < 2; ++vt_)
#pragma unroll
            for (int s2_ = 0; s2_ < 2; ++s2_) O[vt_] = MFMA32(vf[1][vt_ * 2 + s2_], __builtin_bit_cast(bf16x8, pb[1][s2_]), O[vt_]);
        inv = LSUM_MFMA ? 1.0f / Lacc[0] : 1.0f / add_xor32(lsum);
        if (DA && m == 0) {
#pragma unroll
            for (int i = 0; i < 8; ++i) { o0p[i] = cvt_pk(O[0][2 * i] * inv, O[0][2 * i + 1] * inv); o0p[8 + i] = cvt_pk(O[1][2 * i] * inv, O[1][2 * i + 1] * inv); }
        }
    }
    bf16_t* yrow = A.y + (size_t)(A.yrow0 + wave * 32 + r) * DM;
    if (DA) {
        float ss = 0.f;
#pragma unroll
        for (int vt = 0; vt < 2; ++vt)
#pragma unroll
            for (int i = 0; i < 16; ++i) { const unsigned w = o0p[vt * 8 + (i >> 1)]; const float o0 = (i & 1) ? bfhi(w) : bflo(w);
                const float o = o0 - A.lam * (O[vt][i] * inv); O[vt][i] = o; ss += o * o; }
        ss = add_xor32(ss);
        const float rs = rsqrtf(ss * (1.0f / 64.0f) + 1e-6f) * A.post;
#pragma unroll
        for (int vt = 0; vt < 2; ++vt)
#pragma unroll
            for (int g = 0; g < 4; ++g) { const int vd = vt * 32 + 8 * g + 4 * hh; const f32x4 sg = *(const f32x4*)(A.subg + vd);
                u32x2 w; w.x = cvt_pk(O[vt][4 * g] * rs * sg[0], O[vt][4 * g + 1] * rs * sg[1]); w.y = cvt_pk(O[vt][4 * g + 2] * rs * sg[2], O[vt][4 * g + 3] * rs * sg[3]);
                *(u32x2*)(yrow + vd) = w; }
    } else {
#pragma unroll
        for (int vt = 0; vt < 2; ++vt)
#pragma unroll
            for (int g = 0; g < 4; ++g) { const int vd = vt * 32 + 8 * g + 4 * hh;
                u32x2 w; w.x = cvt_pk(O[vt][4 * g] * inv, O[vt][4 * g + 1] * inv); w.y = cvt_pk(O[vt][4 * g + 2] * inv, O[vt][4 * g + 3] * inv);
                *(u32x2*)(yrow + vd) = w; }
    }
}

__device__ __forceinline__ void attn_item_da2(const Frame& F, const AttnArgs& A) {
    constexpr int KMAP = 8192, KREG = 2 * KMAP, BUFB = KREG + 16384;
    const int tid = F.tid, lane = F.lane, r = lane & 31, hh = lane >> 5, wave = F.wave;
    const int qk = A.q0 + wave * 32 + r;
    const int kkey = tid & 127, kch0 = (tid >> 7) & 1, km = wave >> 2;
    const char* kbase = (const char*)(km ? A.k1 : A.k0);
    const unsigned kdma = (unsigned)(km * KMAP + kch0 * 2048 + (kkey & 64) * 16);
    const unsigned vdma = (unsigned)(KREG + (tid & ~63) * 16);
    unsigned voffb[2];
#pragma unroll
    for (int j = 0; j < 2; ++j) { const int item = tid + 512 * j, vd = item >> 4, c = (item & 15) ^ (vd & 15); voffb[j] = (unsigned)(vd * SK + c * 8) * 2u; }
#define DA2_LOADG(t, bsel) do { LAS unsigned char* db_ = F.lds + (bsel) * BUFB; \
        _Pragma("unroll") for (int j_ = 0; j_ < 2; ++j_) __builtin_amdgcn_global_load_lds((const unsigned*)(kbase + (size_t)(t) * (128 * 32 * 2) + (unsigned)(kkey * 32 + (kch0 + 2 * j_) * 8) * 2u), \
            (LAS unsigned*)(db_ + __builtin_amdgcn_readfirstlane(kdma) + j_ * 4096), 16, 0, 0); \
        _Pragma("unroll") for (int j_ = 0; j_ < 2; ++j_) __builtin_amdgcn_global_load_lds((const unsigned*)((const char*)A.vt + (size_t)(t) * 256 + voffb[j_]), \
            (LAS unsigned*)(db_ + __builtin_amdgcn_readfirstlane(vdma) + j_ * 8192), 16, 0, 0); } while (0)
    const int kl0 = hh * 2048 + pi32(r) * 16;
    const int vl0 = r * 256, vsw = r & 15;
    f32x16 cinit; f32x16 O[2][2]; float lsum[2] = {0.f, 0.f};
    { const float bound = fmaxf(ldgf(A.qn0 + qk) * A.kmax0, ldgf(A.qn1 + qk) * A.kmax1);
#pragma unroll
      for (int i = 0; i < 16; ++i) { cinit[i] = -bound; O[0][0][i] = 0.f; O[0][1][i] = 0.f; O[1][0][i] = 0.f; O[1][1][i] = 0.f; } }
    bf16x8 qf[2][2];
    bf16x8 kf[2], vf[4]; f32x16 sv[2]; u32x4 pb[2][2];
#pragma unroll
    for (int i = 0; i < 4; ++i) vf[i] = __builtin_bit_cast(bf16x8, (u32x4){0u, 0u, 0u, 0u});
    pb[1][0] = (u32x4){0u, 0u, 0u, 0u}; pb[1][1] = pb[1][0];
    int vlo[2]; vlo[0] = vl0 + ((hh ^ (r & 3)) << 4); vlo[1] = vl0 + (((2 + hh) ^ (r & 3)) << 4);
    const int vq = (r >> 2) & 3;
    __syncthreads();
    DA2_LOADG(A.t0, 0);
    int t = A.t0;
#pragma nounroll
    for (int seg = 0; seg < 2; ++seg) {
        const int tend = (seg == 0) ? (A.t1 < 128 ? A.t1 : 128) : A.t1;
        if (t >= tend) continue;
#pragma unroll
        for (int m = 0; m < 2; ++m)
#pragma unroll
            for (int st = 0; st < 2; ++st) { const bf16_t* qa = (m == 0) ? A.qr0 : A.qr1; const bf16_t* qb = (m == 0) ? A.qf0 : A.qf1;
                qf[m][st] = __builtin_bit_cast(bf16x8, ldg16((seg ? qb : qa) + (size_t)qk * 32 + st * 16 + hh * 8)); }
#pragma unroll
        for (int m = 0; m < 2; ++m)
#pragma unroll
            for (int st = 0; st < 2; ++st) asm volatile("" : "+v"(qf[m][st]));
        for (; t < tend; ++t) {
            const int bsel = (t - A.t0) & 1;
            LAS unsigned char* buf = F.lds + bsel * BUFB;
            asm volatile("s_waitcnt vmcnt(0)" ::: "memory");
            __syncthreads();
#define DA2_RKJ(m_, jj) do { _Pragma("unroll") for (int st_ = 0; st_ < 2; ++st_) kf[st_] = *(const LAS bf16x8*)(buf + (m_) * KMAP + st_ * 4096 + kl0 + (jj) * 512); } while (0)
#define DA2_RVJ(jj) do { const int vo_ = ((jj) ^ vq) << 6; _Pragma("unroll") for (int vt_ = 0; vt_ < 2; ++vt_) _Pragma("unroll") for (int s2_ = 0; s2_ < 2; ++s2_) \
                vf[vt_ * 2 + s2_] = *(const LAS bf16x8*)(buf + KREG + vt_ * 8192 + (vlo[s2_] + vo_)); } while (0)
#define DA2_RV1(jj, idx_) do { vf[idx_] = *(const LAS bf16x8*)(buf + KREG + ((idx_) >> 1) * 8192 + (vlo[(idx_) & 1] + ((((jj)) ^ vq) << 6))); } while (0)
#define DA2_S(m_) do { sv[m_] = cinit; _Pragma("unroll") for (int st_ = 0; st_ < 2; ++st_) sv[m_] = MFMA32(kf[st_], qf[m_][st_], sv[m_]); } while (0)
#define DA2_PV(m_) do { _Pragma("unroll") for (int vt_ = 0; vt_ < 2; ++vt_) _Pragma("unroll") for (int s2_ = 0; s2_ < 2; ++s2_) \
                O[m_][vt_] = MFMA32(vf[vt_ * 2 + s2_], __builtin_bit_cast(bf16x8, pb[m_][s2_]), O[m_][vt_]); } while (0)
#define DA2_EXP(m_) do { float ls_ = 0.f; _Pragma("unroll") for (int i_ = 0; i_ < 16; ++i_) { sv[m_][i_] = __builtin_amdgcn_exp2f(sv[m_][i_]); ls_ += sv[m_][i_]; } lsum[m_] += ls_; \
                pb[m_][0] = (u32x4){cvt_pk(sv[m_][0], sv[m_][1]), cvt_pk(sv[m_][2], sv[m_][3]), cvt_pk(sv[m_][4], sv[m_][5]), cvt_pk(sv[m_][6], sv[m_][7])}; \
                pb[m_][1] = (u32x4){cvt_pk(sv[m_][8], sv[m_][9]), cvt_pk(sv[m_][10], sv[m_][11]), cvt_pk(sv[m_][12], sv[m_][13]), cvt_pk(sv[m_][14], sv[m_][15])}; } while (0)
            DA2_RKJ(0, 0); DA2_S(0); DA2_RKJ(1, 0);
            __builtin_amdgcn_sched_barrier(0);
            if (t + 1 < A.t1) DA2_LOADG(t + 1, bsel ^ 1);
            __builtin_amdgcn_sched_barrier(0);
#define XE_(i_) sv[me_][i_] = __builtin_amdgcn_exp2f(sv[me_][i_])
#define XA_(i_) ls_ += sv[me_][i_]
#define XC_(k_) pw_[k_] = cvt_pk(sv[me_][2 * (k_)], sv[me_][2 * (k_) + 1])
#define GEND_() do { asm volatile("" : "+v"(sv[me_]), "+v"(ls_)); __builtin_amdgcn_sched_barrier(0); } while (0)
#define DA2_HALF(ME, MO, doS_, PRE_, MID_, VA_, VB_, VC_) do { constexpr int me_ = (ME), mo_ = (MO); PRE_; float ls_ = 0.f; unsigned pw_[8]; \
                if (doS_) { sv[mo_] = MFMA32(kf[0], qf[mo_][0], cinit); asm volatile("" : "+v"(sv[mo_])); } \
                XE_(0); XE_(1); XE_(2); GEND_(); \
                O[mo_][0] = MFMA32(vf[0], __builtin_bit_cast(bf16x8, pb[mo_][0]), O[mo_][0]); asm volatile("" : "+v"(O[mo_][0])); \
                XE_(3); XE_(4); XE_(5); XA_(0); XA_(1); XA_(2); GEND_(); \
                VA_; \
                if (doS_) { sv[mo_] = MFMA32(kf[1], qf[mo_][1], sv[mo_]); asm volatile("" : "+v"(sv[mo_])); } \
                XE_(6); XE_(7); XE_(8); XA_(3); XA_(4); XA_(5); XC_(0); asm volatile("" : "+v"(pw_[0])); GEND_(); \
                MID_; \
                O[mo_][1] = MFMA32(vf[2], __builtin_bit_cast(bf16x8, pb[mo_][0]), O[mo_][1]); asm volatile("" : "+v"(O[mo_][1])); \
                XE_(9); XE_(10); XE_(11); XA_(6); XA_(7); XA_(8); XC_(1); XC_(2); asm volatile("" : "+v"(pw_[1]), "+v"(pw_[2])); GEND_(); \
                VB_; \
                O[mo_][0] = MFMA32(vf[1], __builtin_bit_cast(bf16x8, pb[mo_][1]), O[mo_][0]); asm volatile("" : "+v"(O[mo_][0])); \
                XE_(12); XE_(13); XA_(9); XA_(10); XA_(11); XC_(3); XC_(4); asm volatile("" : "+v"(pw_[3]), "+v"(pw_[4])); GEND_(); \
                VC_; \
                O[mo_][1] = MFMA32(vf[3], __builtin_bit_cast(bf16x8, pb[mo_][1]), O[mo_][1]); asm volatile("" : "+v"(O[mo_][1])); \
                XE_(14); XE_(15); XA_(12); XA_(13); XA_(14); XA_(15); XC_(5); XC_(6); XC_(7); \
                lsum[me_] += ls_; pb[me_][0] = (u32x4){pw_[0], pw_[1], pw_[2], pw_[3]}; pb[me_][1] = (u32x4){pw_[4], pw_[5], pw_[6], pw_[7]}; \
                asm volatile("" : "+v"(pb[me_][0]), "+v"(pb[me_][1]), "+v"(lsum[me_])); __builtin_amdgcn_sched_barrier(0); } while (0)
#pragma unroll
            for (int j = 0; j < 4; ++j) {
                DA2_HALF(0, 1, true, (void)0, if (j < 3) DA2_RKJ(0, j + 1), DA2_RV1(j, 0), DA2_RV1(j, 2), DA2_RV1(j, 1));
                DA2_HALF(1, 0, (j < 3), DA2_RV1(j, 3), if (j < 3) DA2_RKJ(1, j + 1), (void)0, (void)0, (void)0);
            }
#undef DA2_HALF
#undef GEND_
#undef XC_
#undef XA_
#undef XE_
        }
    }
    DA2_PV(1);
#undef DA2_RKJ
#undef DA2_RVJ
#undef DA2_RV1
#undef DA2_S
#undef DA2_PV
#undef DA2_EXP
#undef DA2_LOADG
    const float inv0 = 1.0f / add_xor32(lsum[0]), inv1 = A.lam / add_xor32(lsum[1]);
    bf16_t* yrow = A.y + (size_t)(A.yrow0 + wave * 32 + r) * DM;
    float ss = 0.f;
#pragma unroll
    for (int vt = 0; vt < 2; ++vt)
#pragma unroll
        for (int i = 0; i < 16; ++i) { const float o = O[0][vt][i] * inv0 - O[1][vt][i] * inv1; O[0][vt][i] = o; ss += o * o; }
    ss = add_xor32(ss);
    const float rs = rsqrtf(ss * (1.0f / 64.0f) + 1e-6f) * A.post;
#pragma unroll
    for (int vt = 0; vt < 2; ++vt)
#pragma unroll
        for (int g = 0; g < 4; ++g) { const int vd = vt * 32 + 8 * g + 4 * hh; const f32x4 sg = *(const f32x4*)(A.subg + vd);
            u32x2 w; w.x = cvt_pk(O[0][vt][4 * g] * rs * sg[0], O[0][vt][4 * g + 1] * rs * sg[1]); w.y = cvt_pk(O[0][vt][4 * g + 2] * rs * sg[2], O[0][vt][4 * g + 3] * rs * sg[3]);
            *(u32x2*)(yrow + vd) = w; }
}

__device__ __forceinline__ int ret_row0(int b, int n) { return n < 2 ? TL + b * CTXL + n * 128 : b * SEQ + (n - 2) * 128; }
__device__ __forceinline__ float log2_gamma(float d) { return -log1pf(__expf(-d)) * LOG2E; }
constexpr int RP = 72;

__device__ __forceinline__ void phase_ret_chunk_states(const Params& p, const Frame& F, int l) {
    LAS bf16_t* kt = (LAS bf16_t*)F.lds; LAS bf16_t* vtile = kt + 128 * RP;
    const int lane = F.lane, r = lane & 31, hh = lane >> 5, wave = F.wave, dir = wave >> 2, dkt = (wave >> 1) & 1, dvt = wave & 1;
    for (int it = (F.bid + F.G / 2) % F.G; it < NB * 4 * NCH; it += F.G) {
        const int n = it % NCH, bh = it / NCH, b = bh >> 2, h = bh & 3;
        const float lg2 = log2_gamma(dir ? p.ret_decay_b[l * 4 + h] : p.ret_decay_f[l * 4 + h]);
        const bf16_t* ksrc = F.retk + ((size_t)bh * SK + n * 128) * 64;
        const bf16_t* vsrc = F.Z + (size_t)ret_row0(b, n) * NINP + ZC_RV + h * 64;
        __syncthreads();
        { u32x4 gk[2], gv[2];
#pragma unroll
          for (int it2 = 0; it2 < 2; ++it2) { const int i = F.tid + 512 * it2, tok = i >> 3, c8 = (i & 7) * 8; gk[it2] = ldg<u32x4>(ksrc + tok * 64 + c8); gv[it2] = ldg<u32x4>(vsrc + (size_t)tok * NINP + c8); }
#pragma unroll
          for (int it2 = 0; it2 < 2; ++it2) { asm volatile("" : "+v"(gk[it2])); asm volatile("" : "+v"(gv[it2])); }
          __builtin_amdgcn_sched_barrier(0);
#pragma unroll
          for (int it2 = 0; it2 < 2; ++it2) { const int i = F.tid + 512 * it2, tok = i >> 3, c8 = (i & 7) * 8; *(LAS u32x4*)(kt + tok * RP + c8) = gk[it2]; *(LAS u32x4*)(vtile + tok * RP + c8) = gv[it2]; } }
        __syncthreads();
        f32x16 acc; for (int i = 0; i < 16; ++i) acc[i] = 0.f;
        const int dk = dkt * 32 + r, dv = dvt * 32 + r;
#pragma unroll
        for (int j = 0; j < 8; ++j) {
            float a[8], bv[8];
#pragma unroll
            for (int e = 0; e < 8; ++e) { const int c = 16 * j + 8 * hh + e;
                const float w = __builtin_amdgcn_exp2f(lg2 * (float)(dir ? c + 1 : 128 - c));
                a[e] = bf2f(kt[c * RP + dk]) * w; bv[e] = bf2f(vtile[c * RP + dv]); }
            const u32x4 af = (u32x4){cvt_pk(a[0], a[1]), cvt_pk(a[2], a[3]), cvt_pk(a[4], a[5]), cvt_pk(a[6], a[7])};
            const u32x4 bf = (u32x4){cvt_pk(bv[0], bv[1]), cvt_pk(bv[2], bv[3]), cvt_pk(bv[4], bv[5]), cvt_pk(bv[6], bv[7])};
            acc = MFMA32(__builtin_bit_cast(bf16x8, af), __builtin_bit_cast(bf16x8, bf), acc);
        }
        float* o = F.ust + ((size_t)(bh * NCH + n) * 2 + dir) * 4096;
#pragma unroll
        for (int i = 0; i < 16; ++i) o[(dkt * 32 + (i & 3) + 8 * (i >> 2) + 4 * hh) * 64 + dvt * 32 + r] = acc[i];
    }
}
__device__ __forceinline__ void phase_ret_scan(const Params& p, const Frame& F, int l) {
    for (int it = F.bid * 512 + F.tid; it < NB * 4 * 2 * 4096; it += F.G * 512) {
        const int e = it & 4095, dir = (it >> 12) & 1, bh = it >> 13, h = bh & 3;
        const float dec = __builtin_amdgcn_exp2f(128.0f * log2_gamma(dir ? p.ret_decay_b[l * 4 + h] : p.ret_decay_f[l * 4 + h]));
        float* base = F.ust + ((size_t)bh * NCH * 2 + dir) * 4096 + e;
        float st = 0.f;
        for (int i0 = 0; i0 < NCH; i0 += 10) {
            float u[10];
#pragma unroll
            for (int j = 0; j < 10; ++j) { const int idx = dir ? (NCH - 1 - (i0 + j)) : (i0 + j); const int n = dir ? (idx < 128 ? idx + 2 : idx - 128) : idx; u[j] = base[(size_t)n * 8192]; }
#pragma unroll
            for (int j = 0; j < 10; ++j) { const int idx = dir ? (NCH - 1 - (i0 + j)) : (i0 + j); const int n = dir ? (idx < 128 ? idx + 2 : idx - 128) : idx; base[(size_t)n * 8192] = st; st = st * dec + u[j]; }
        }
    }
}
__device__ __forceinline__ void ret_out_item(const Params& p, const Frame& F, int l, int it) {
    LAS unsigned char* lq = F.lds;
    LAS unsigned char* lk = F.lds + 16384;
    LAS bf16_t* lv = (LAS bf16_t*)(F.lds + 32768);
    LAS bf16_t* lsf = lv + 128 * RP;
    LAS bf16_t* lrb = lsf + 64 * RP;
    LAS float* lss = (LAS float*)(lrb + 64 * RP);
    const int tid = F.tid, lane = F.lane, r = lane & 31, hh = lane >> 5, wave = F.wave, qb = wave & 3, dt = wave >> 2;
    const int n = it % NCH, bh = it / NCH, b = bh >> 2, h = bh & 3;
    const float lgf = log2_gamma(p.ret_decay_f[l * 4 + h]), lgb = log2_gamma(p.ret_decay_b[l * 4 + h]);
    const int row0 = ret_row0(b, n);
    const bf16_t* qsrc = F.retq + ((size_t)bh * SK + n * 128) * 64; const bf16_t* ksrc = F.retk + ((size_t)bh * SK + n * 128) * 64;
    const bf16_t* vsrc = F.Z + (size_t)row0 * NINP + ZC_RV + h * 64;
    const float* sf = F.ust + ((size_t)(bh * NCH + n) * 2) * 4096; const float* rb = sf + 4096;
    __syncthreads();
    { u32x4 gq[2], gk[2], gv[2]; f32x4 ga[2], gb[2];
#pragma unroll
      for (int it2 = 0; it2 < 2; ++it2) { const int i = tid + 512 * it2, tok = i >> 3, ch = i & 7;
          gq[it2] = ldg<u32x4>(qsrc + tok * 64 + ch * 8); gk[it2] = ldg<u32x4>(ksrc + tok * 64 + ch * 8); gv[it2] = ldg<u32x4>(vsrc + (size_t)tok * NINP + ch * 8);
          const int dk = i >> 4, c4 = (i & 15) * 4; ga[it2] = ldg<f32x4>(sf + dk * 64 + c4); gb[it2] = ldg<f32x4>(rb + dk * 64 + c4); }
#pragma unroll
      for (int it2 = 0; it2 < 2; ++it2) { asm volatile("" : "+v"(gq[it2])); asm volatile("" : "+v"(gk[it2])); asm volatile("" : "+v"(gv[it2])); asm volatile("" : "+v"(ga[it2])); asm volatile("" : "+v"(gb[it2])); }
      __builtin_amdgcn_sched_barrier(0);
#pragma unroll
      for (int it2 = 0; it2 < 2; ++it2) { const int i = tid + 512 * it2, tok = i >> 3, ch = i & 7;
          *(LAS u32x4*)(lq + ch * 2048 + tok * 16) = gq[it2]; *(LAS u32x4*)(lk + ch * 2048 + tok * 16) = gk[it2]; *(LAS u32x4*)(lv + tok * RP + ch * 8) = gv[it2];
          const int dk = i >> 4, c4 = (i & 15) * 4; const f32x4 a = ga[it2], bb = gb[it2];
          *(LAS u32x2*)(lsf + dk * RP + c4) = (u32x2){cvt_pk(a[0], a[1]), cvt_pk(a[2], a[3])};
          *(LAS u32x2*)(lrb + dk * RP + c4) = (u32x2){cvt_pk(bb[0], bb[1]), cvt_pk(bb[2], bb[3])}; } }
    __syncthreads();
    const int cq = qb * 32 + r, dvl = dt * 32 + r;
    bf16x8 qf[4];
#pragma unroll
    for (int st = 0; st < 4; ++st) qf[st] = *(const LAS bf16x8*)(lq + (2 * st + hh) * 2048 + cq * 16);
    f32x16 O; for (int i = 0; i < 16; ++i) O[i] = 0.f;
#pragma unroll
    for (int kb = 0; kb < 4; ++kb) {
        f32x16 s; for (int i = 0; i < 16; ++i) s[i] = 0.f;
#pragma unroll
        for (int st = 0; st < 4; ++st) { const bf16x8 kf = *(const LAS bf16x8*)(lk + (2 * st + hh) * 2048 + (kb * 32 + pi32(r)) * 16); s = MFMA32(kf, qf[st], s); }
#pragma unroll
        for (int i = 0; i < 16; ++i) { const int c = 32 * kb + 16 * (i >> 3) + 8 * hh + (i & 7); const int dl = cq - c;
            s[i] *= __builtin_amdgcn_exp2f(dl >= 0 ? lgf * (float)dl : lgb * (float)(-dl)); }
#pragma unroll
        for (int s2 = 0; s2 < 2; ++s2) {
            const u32x4 pf = (u32x4){cvt_pk(s[8 * s2], s[8 * s2 + 1]), cvt_pk(s[8 * s2 + 2], s[8 * s2 + 3]), cvt_pk(s[8 * s2 + 4], s[8 * s2 + 5]), cvt_pk(s[8 * s2 + 6], s[8 * s2 + 7])};
            unsigned short ve[8];
#pragma unroll
            for (int e = 0; e < 8; ++e) ve[e] = lv[(32 * kb + 16 * s2 + 8 * hh + e) * RP + dvl];
            const u32x4 vf = (u32x4){(unsigned)ve[0] | ((unsigned)ve[1] << 16), (unsigned)ve[2] | ((unsigned)ve[3] << 16), (unsigned)ve[4] | ((unsigned)ve[5] << 16), (unsigned)ve[6] | ((unsigned)ve[7] << 16)};
            O = MFMA32(__builtin_bit_cast(bf16x8, vf), __builtin_bit_cast(bf16x8, pf), O);
        }
    }
    f32x16 xf, xb; for (int i = 0; i < 16; ++i) { xf[i] = 0.f; xb[i] = 0.f; }
#pragma unroll
    for (int st = 0; st < 4; ++st) {
        unsigned short se[8], re[8];
#pragma unroll
        for (int e = 0; e < 8; ++e) { se[e] = lsf[(16 * st + 8 * hh + e) * RP + dvl]; re[e] = lrb[(16 * st + 8 * hh + e) * RP + dvl]; }
        const u32x4 sfv = (u32x4){(unsigned)se[0] | ((unsigned)se[1] << 16), (unsigned)se[2] | ((unsigned)se[3] << 16), (unsigned)se[4] | ((unsigned)se[5] << 16), (unsigned)se[6] | ((unsigned)se[7] << 16)};
        const u32x4 rbv = (u32x4){(unsigned)re[0] | ((unsigned)re[1] << 16), (unsigned)re[2] | ((unsigned)re[3] << 16), (unsigned)re[4] | ((unsigned)re[5] << 16), (unsigned)re[6] | ((unsigned)re[7] << 16)};
        xf = MFMA32(__builtin_bit_cast(bf16x8, sfv), qf[st], xf); xb = MFMA32(__builtin_bit_cast(bf16x8, rbv), qf[st], xb);
    }
    const float wf = __builtin_amdgcn_exp2f(lgf * (float)cq), wb = __builtin_amdgcn_exp2f(lgb * (float)(127 - cq));
    float ss = 0.f;
#pragma unroll
    for (int i = 0; i < 16; ++i) { O[i] += wf * xf[i] + wb * xb[i]; ss += O[i] * O[i]; }
    ss = add_xor32(ss);
    if (hh == 0) lss[wave * 32 + r] = ss;
    __syncthreads();
    ss += lss[(wave ^ 4) * 32 + r];
    const float rs = rsqrtf(ss * (1.0f / 64.0f) + 1e-6f);
    const bf16_t* grow = F.Z + (size_t)(row0 + cq) * NINP + ZC_RG + h * 64;
    bf16_t* yrow = F.H + (size_t)(row0 + cq) * DM + 768 + h * 64;
#pragma unroll
    for (int g = 0; g < 4; ++g) { const int dv = dt * 32 + 8 * g + 4 * hh; const u32x2 gw = *(const u32x2*)(grow + dv);
        const float g0 = bflo(gw.x), g1 = bfhi(gw.x), g2 = bflo(gw.y), g3 = bfhi(gw.y);
        u32x2 w; w.x = cvt_pk(O[4 * g] * rs * siluf(g0), O[4 * g + 1] * rs * siluf(g1)); w.y = cvt_pk(O[4 * g + 2] * rs * siluf(g2), O[4 * g + 3] * rs * siluf(g3));
        *(u32x2*)(yrow + dv) = w; }
}

__device__ __forceinline__ void phase_ln1(const Params& p, const Frame& F, int l) {
    const int lane = F.lane;
    const float* g = p.ln1_g + l * DM; const float* bta = p.ln1_b + l * DM;
    LAS float* wt = (LAS float*)F.lds;
    for (int i = F.bid * 512 + F.tid; i < MAXPAN * 256; i += F.G * 512) F.gidx[i] = 0;
    __syncthreads();
    { f32x4 w[2][4];
#pragma unroll
      for (int it = 0; it < 2; ++it)
#pragma unroll
          for (int q4 = 0; q4 < 4; ++q4) w[it][q4] = ldg<f32x4>(p.router_w + (size_t)(F.tid + 512 * it) * 16 + 4 * q4);
#pragma unroll
      for (int it = 0; it < 2; ++it)
#pragma unroll
          for (int q4 = 0; q4 < 4; ++q4) asm volatile("" : "+v"(w[it][q4]));
      __builtin_amdgcn_sched_barrier(0);
#pragma unroll
      for (int it = 0; it < 2; ++it)
#pragma unroll
          for (int q4 = 0; q4 < 4; ++q4)
#pragma unroll
              for (int e = 0; e < 4; ++e) wt[(4 * q4 + e) * DM + F.tid + 512 * it] = w[it][q4][e]; }
    __syncthreads();
    LAS int* lcnt = (LAS int*)(F.lds + 65536);
    if (F.tid < 32) lcnt[F.tid] = 0;
    __syncthreads();
    float rb = p.router_b[(lane >> 2) & 15];
    const int MT = (l == DEPTH - 1) ? TL : TT;
    LAS float* pv = (LAS float*)(F.lds + 66560);
    { float t[2][8];
#pragma unroll
      for (int it = 0; it < 2; ++it) { const int c = F.tid + 512 * it; t[it][0] = ldgf(g + c); t[it][1] = ldgf(bta + c);
#pragma unroll
          for (int sg = 0; sg < 3; ++sg) { const float* md = F.mods + ((size_t)l * 3 + sg) * 6144; t[it][2 + 2 * sg] = ldgf(md + 3 * DM + c); t[it][3 + 2 * sg] = ldgf(md + 4 * DM + c); } }
#pragma unroll
      for (int it = 0; it < 2; ++it)
#pragma unroll
          for (int k = 0; k < 8; ++k) asm volatile("" : "+v"(t[it][k]));
      __builtin_amdgcn_sched_barrier(0);
#pragma unroll
      for (int it = 0; it < 2; ++it) { const int c = F.tid + 512 * it; pv[c] = t[it][0]; pv[DM + c] = t[it][1];
#pragma unroll
          for (int sg = 0; sg < 3; ++sg) { pv[(2 + 2 * sg) * DM + c] = t[it][2 + 2 * sg]; pv[(3 + 2 * sg) * DM + c] = 1.0f + t[it][3 + 2 * sg]; } } }
    __syncthreads();
    const int stride = F.G * 8;
#pragma nounroll
    for (int seg = 0; seg < 3; ++seg) {
    const int lo = seg * SEQ, hi = (seg < 2) ? lo + SEQ : TT;
    if (lo >= MT) break;
    const LAS float* psh = pv + (2 + 2 * seg) * DM; const LAS float* psc = psh + DM;
    for (int row = lo + F.bid * 8 + F.wave; row < hi; row += stride) {
        float* xr = xrow(p, F, row);
        f32x4 v[4];
#pragma unroll
        for (int j = 0; j < 4; ++j) v[j] = ldg<f32x4>(xr + j * 256 + lane * 4);
        float s = 0.f;
#pragma unroll
        for (int j = 0; j < 4; ++j) s += v[j][0] + v[j][1] + v[j][2] + v[j][3];
        const float mean = wsum(s) * (1.0f / DM); float q = 0.f;
#pragma unroll
        for (int j = 0; j < 4; ++j)
#pragma unroll
            for (int e = 0; e < 4; ++e) { const float d = v[j][e] - mean; q += d * d; }
        const float rstd = rsqrtf(wsum(q) * (1.0f / DM) + 1e-5f);
        float lg[16];
#pragma unroll
        for (int e = 0; e < 16; ++e) lg[e] = 0.f;
#pragma unroll
        for (int j = 0; j < 4; ++j) { const int c = j * 256 + lane * 4;
            f32x4 xn, hv;
            const f32x4 gv = *(const LAS f32x4*)(pv + c), bv = *(const LAS f32x4*)(pv + DM + c), shv = *(const LAS f32x4*)(psh + c), sc1 = *(const LAS f32x4*)(psc + c);
#pragma unroll
            for (int e = 0; e < 4; ++e) { xn[e] = (v[j][e] - mean) * rstd * gv[e] + bv[e]; hv[e] = xn[e] * sc1[e] + shv[e]; }
            stg<f32x4>(xr + c, xn);
            u32x2 w; w.x = cvt_pk(hv[0], hv[1]); w.y = cvt_pk(hv[2], hv[3]); stg<u32x2>(F.H + (size_t)row * DM + c, w);
#pragma unroll
            for (int e = 0; e < 16; ++e) { const f32x4 wv = *(const LAS f32x4*)(wt + e * DM + c); lg[e] += hv[0] * wv[0] + hv[1] * wv[1] + hv[2] * wv[2] + hv[3] * wv[3];
                if (e == 7) __builtin_amdgcn_sched_barrier(0); }
            __builtin_amdgcn_sched_barrier(0);
        }
#pragma unroll
        for (int e = 0; e < 8; ++e) { const auto r2 = __builtin_amdgcn_permlane32_swap(__float_as_uint(lg[e]), __float_as_uint(lg[e + 8]), false, false); lg[e] = __uint_as_float(r2[0]) + __uint_as_float(r2[1]); }
#pragma unroll
        for (int e = 0; e < 4; ++e) { const auto r2 = __builtin_amdgcn_permlane16_swap(__float_as_uint(lg[e]), __float_as_uint(lg[e + 4]), false, false); lg[e] = __uint_as_float(r2[0]) + __uint_as_float(r2[1]); }
#pragma unroll
        for (int e = 0; e < 2; ++e) { const bool up = lane & 8; const float keep = up ? lg[e + 2] : lg[e], give = up ? lg[e] : lg[e + 2]; lg[e] = keep + dppf<0x128>(give); }
        { const bool up = lane & 4; const float keep = up ? lg[1] : lg[0], give = up ? lg[0] : lg[1]; lg[0] = keep + dppf<0x141>(dppf<0x1B>(give)); }
        float lgt = lg[0]; lgt += dppf<0x4E>(lgt); lgt += dppf<0xB1>(lgt);
        const float mysc = 1.0f / (1.0f + __expf(-lgt)), mych = mysc + rb;
        float gsum;
        { const float cb = dppf<0x124>(mych), cc = dppf<0x128>(mych), cd = dppf<0x12C>(mych);
          const float h1 = fmaxf(mych, cb), l1 = fminf(mych, cb), h2 = fmaxf(cc, cd), l2 = fminf(cc, cd);
          gsum = fmaxf(h1, h2) + fmaxf(fminf(h1, h2), fmaxf(l1, l2)); }
        int bg = 0; float bgs = rdlane(gsum, 0);
        { const float g1 = rdlane(gsum, 16), g2 = rdlane(gsum, 32), g3 = rdlane(gsum, 48);
          if (g1 > bgs) { bgs = g1; bg = 1; } if (g2 > bgs) { bgs = g2; bg = 2; } if (g3 > bgs) { bgs = g3; bg = 3; } }
        bg = __builtin_amdgcn_readfirstlane(bg);
        int e0 = 0, e1 = 0; float c0 = -1e30f, c1 = -1e30f, s0 = 0.f, s1 = 0.f;
#pragma unroll
        for (int k = 0; k < 4; ++k) { const float c = rdlane(mych, bg * 16 + 4 * k), s2 = rdlane(mysc, bg * 16 + 4 * k); const int ee = bg * 4 + k;
            if (c > c0) { c1 = c0; e1 = e0; s1 = s0; c0 = c; e0 = ee; s0 = s2; } else if (c > c1) { c1 = c; e1 = ee; s1 = s2; } }
        if (lane == 0) {
            const float inv = 1.0f / (s0 + s1);
            const int p0 = __hip_atomic_fetch_add(lcnt + e0, 1, __ATOMIC_RELAXED, __HIP_MEMORY_SCOPE_WORKGROUP), p1 = __hip_atomic_fetch_add(lcnt + e1, 1, __ATOMIC_RELAXED, __HIP_MEMORY_SCOPE_WORKGROUP);
            int* rt = F.route + (size_t)row * 8; stg<u32x4>(rt, (u32x4){(unsigned)e0, (unsigned)e1, (unsigned)p0, (unsigned)p1}); stg<u32x2>(rt + 4, (u32x2){__float_as_uint(s0 * inv), __float_as_uint(s1 * inv)});
        }
    }
    }
    __syncthreads();
    if (F.tid < 16) lcnt[16 + F.tid] = atomicAdd(F.cnt + l * 16 + F.tid, lcnt[F.tid]);
    asm volatile("s_waitcnt vmcnt(0)" ::: "memory");
    __syncthreads();
#pragma nounroll
    for (int seg = 0; seg < 3; ++seg) { const int lo = seg * SEQ, hi = (seg < 2) ? lo + SEQ : TT; if (lo >= MT) break;
        for (int row = lo + F.bid * 8 + F.wave + lane * stride; row < hi; row += 64 * stride) { int* rt = F.route + (size_t)row * 8;
            const u32x4 r = ldg<u32x4>(rt); stg<u32x2>(rt + 2, (u32x2){r.z + (unsigned)lcnt[16 + r.x], r.w + (unsigned)lcnt[16 + r.y]}); } }
    __syncthreads();
}
__device__ __forceinline__ void phase_perm(const Params& p, const Frame& F, int l) {
    LAS int* off = (LAS int*)F.lds; LAS int* cn = off + 32;
    __syncthreads();
    if (F.tid < 16) cn[F.tid] = ldg<int>(F.cnt + l * 16 + F.tid);
    __syncthreads();
    if (F.tid == 0) { int a = 0; for (int e = 0; e < 16; ++e) { off[e] = a; a += (cn[e] + 255) & ~255; } off[16] = a;
        if (F.bid == 0) { F.misc[0] = a >> 8; for (int e = 0; e < 16; ++e) for (int q = off[e] >> 8; q < (off[e + 1 < 17 ? e + 1 : 16] >> 8); ++q) F.misc[16 + q] = e; } }
    __syncthreads();
    const int MT = (l == DEPTH - 1) ? TL : TT;
    for (int row = (F.bid * 8 + F.wave) * 64 + F.lane; row < MT; row += F.G * 8 * 64) {
        int* rt = F.route + (size_t)row * 8;
        const u32x4 r = ldg<u32x4>(rt);
        const int d0 = off[r.x] + (int)r.z, d1 = off[r.y] + (int)r.w;
        stg<u32x2>(rt + 6, (u32x2){(unsigned)d0, (unsigned)d1});
        stg<int>(F.gidx + d0, row); stg<int>(F.gidx + d1, row);
    }
}
__device__ __forceinline__ void phase_ln2(const Params& p, const Frame& F, int l) {
    const int lane = F.lane;
    const float* g = p.ln2_g + l * DM; const float* bta = p.ln2_b + l * DM;
    const int MT = (l == DEPTH - 1) ? TL : TT;
    const bool hasn = (l + 1 < DEPTH);
    f32x4 gv[4], bv[4];
#pragma unroll
    for (int j = 0; j < 4; ++j) { gv[j] = ldg<f32x4>(g + j * 256 + lane * 4); bv[j] = ldg<f32x4>(bta + j * 256 + lane * 4); }
    const int stride = F.G * 8;
#define LN2_LOADROW(rw, rt_, X, A_, B_) do { const float* xs_ = xrow(p, F, (rw)); \
        const bf16_t* f0_ = F.Fs + (size_t)__builtin_amdgcn_readfirstlane((int)(rt_)[2]) * DM; const bf16_t* f1_ = F.Fs + (size_t)__builtin_amdgcn_readfirstlane((int)(rt_)[3]) * DM; \
        _Pragma("unroll") for (int j_ = 0; j_ < 4; ++j_) { const int c_ = j_ * 256 + lane * 4; X[j_] = ldg<f32x4>(xs_ + c_); A_[j_] = ldg<u32x2>(f0_ + c_); B_[j_] = ldg<u32x2>(f1_ + c_); } } while (0)
#pragma nounroll
    for (int seg = 0; seg < 3; ++seg) {
    const int lo = seg * SEQ, hi = (seg < 2) ? lo + SEQ : TT;
    if (lo >= MT) break;
    const float* md = F.mods + ((size_t)l * 3 + seg) * 6144;
    const float* mdn = F.mods + ((size_t)(hasn ? l + 1 : l) * 3 + seg) * 6144;
    f32x4 gt[4], nsh[4], nsc1[4];
#pragma unroll
    for (int j = 0; j < 4; ++j) { const int c = j * 256 + lane * 4; gt[j] = ldg<f32x4>(md + 5 * DM + c); nsh[j] = ldg<f32x4>(mdn + c); nsc1[j] = ldg<f32x4>(mdn + DM + c) + 1.0f; }
    int row = lo + F.bid * 8 + F.wave;
    u32x4 rc = (u32x4){0u, 0u, 0u, 0u}, rn = rc;
    f32x4 xv[4]; u32x2 fa[4], fb[4];
#pragma unroll
    for (int j = 0; j < 4; ++j) { xv[j] = (f32x4){0.f, 0.f, 0.f, 0.f}; fa[j] = (u32x2){0u, 0u}; fb[j] = fa[j]; }
    if (row < hi) { rc = ldg<u32x4>(F.route + (size_t)row * 8 + 4); LN2_LOADROW(row, rc, xv, fa, fb); }
    if (row + stride < hi) rn = ldg<u32x4>(F.route + (size_t)(row + stride) * 8 + 4);
    for (; row < hi; row += stride) {
        float* xr = xrow(p, F, row);
        f32x4 xvn[4]; u32x2 fan[4], fbn[4]; u32x4 rn2 = rn;
#pragma unroll
        for (int j = 0; j < 4; ++j) { xvn[j] = xv[j]; fan[j] = fa[j]; fbn[j] = fb[j]; }
        if (row + stride < hi) { LN2_LOADROW(row + stride, rn, xvn, fan, fbn);
            if (row + 2 * stride < hi) rn2 = ldg<u32x4>(F.route + (size_t)(row + 2 * stride) * 8 + 4); }
        const float w0 = __uint_as_float(rc[0]), w1 = __uint_as_float(rc[1]);
        f32x4 v[4]; float s = 0.f;
#pragma unroll
        for (int j = 0; j < 4; ++j) { const u32x2 a = fa[j], b = fb[j];
            f32x4 f; f[0] = w0 * bflo(a.x) + w1 * bflo(b.x); f[1] = w0 * bfhi(a.x) + w1 * bfhi(b.x); f[2] = w0 * bflo(a.y) + w1 * bflo(b.y); f[3] = w0 * bfhi(a.y) + w1 * bfhi(b.y);
            v[j] = xv[j] * ALPHA + gt[j] * f; s += v[j][0] + v[j][1] + v[j][2] + v[j][3]; }
        const float mean = wsum(s) * (1.0f / DM); float q = 0.f;
#pragma unroll
        for (int j = 0; j < 4; ++j)
#pragma unroll
            for (int e = 0; e < 4; ++e) { const float d = v[j][e] - mean; q += d * d; }
        const float rstd = rsqrtf(wsum(q) * (1.0f / DM) + 1e-5f);
#pragma unroll
        for (int j = 0; j < 4; ++j) { const int c = j * 256 + lane * 4;
            f32x4 xn;
#pragma unroll
            for (int e = 0; e < 4; ++e) xn[e] = (v[j][e] - mean) * rstd * gv[j][e] + bv[j][e];
            stg<f32x4>(xr + c, xn);
            if (hasn) { u32x2 w; w.x = cvt_pk(xn[0] * nsc1[j][0] + nsh[j][0], xn[1] * nsc1[j][1] + nsh[j][1]); w.y = cvt_pk(xn[2] * nsc1[j][2] + nsh[j][2], xn[3] * nsc1[j][3] + nsh[j][3]);
                stg<u32x2>(F.H + (size_t)row * DM + c, w); }
        }
#pragma unroll
        for (int j = 0; j < 4; ++j) { xv[j] = xvn[j]; fa[j] = fan[j]; fb[j] = fbn[j]; }
        rc = rn; rn = rn2;
    }
    }
#undef LN2_LOADROW
}

__device__ __forceinline__ Frame make_frame(const Params& p, unsigned char* lds_raw, int wave_s);
__device__ __forceinline__ void phase_attn(const Params& p, const Frame& F, int l) {
    const bool last = (l == DEPTH - 1);
    float lam, post;
    { const float* lv = p.da_lambda + l * 128; const int i = F.lane & 31;
      const float a = wsum(F.lane < 32 ? lv[i] * lv[32 + i] : 0.f), b = wsum(F.lane < 32 ? lv[64 + i] * lv[96 + i] : 0.f);
      const float li = 0.8f - 0.6f * expf(-0.3f * (float)l); lam = expf(a) - expf(b) + li; post = 1.0f - li;
      lam = __uint_as_float(__builtin_amdgcn_readfirstlane(__float_as_uint(lam))); post = __uint_as_float(__builtin_amdgcn_readfirstlane(__float_as_uint(post))); }
    const int nDA = 768 + (last ? 0 : 12);
#ifndef ATT_MASK
#define ATT_MASK 7
#endif
    if (ATT_MASK & 1) for (int i = 0;; ++i) {
        const int L = i * F.G + F.bid; if (L >= nDA) break;
        int bh, qt; if (L < 768) { const int w = L & 255, xcd = w & 7; bh = (L >> 8) * 4 + (xcd >> 1); qt = (xcd & 1) * 32 + (w >> 3); } else { bh = L - 768; qt = 64; }
        const int b = bh / 6, h = bh - b * 6;
        AttnArgs A;
        { const size_t o = (size_t)(b * 12 + h * 2) * SK; A.qr0 = F.QRDA + o * 32; A.qf0 = F.QFDA + o * 32; A.k0 = F.KDA + o * 32; A.qn0 = F.qn_da + o;
          A.qr1 = A.qr0 + (size_t)SK * 32; A.qf1 = A.qf0 + (size_t)SK * 32; A.k1 = A.k0 + (size_t)SK * 32; A.qn1 = A.qn0 + SK;
          A.kmax0 = sqrtf(__uint_as_float(F.kmax_da[l * 24 + b * 12 + h * 2])); A.kmax1 = sqrtf(__uint_as_float(F.kmax_da[l * 24 + b * 12 + h * 2 + 1])); }
        A.qpe = nullptr; A.vt = F.VTDA + (size_t)(b * 6 + h) * 64 * SK;
        if (qt < 64) { A.q0 = qt * 256; A.t0 = 0; A.t1 = 130; A.yrow0 = b * SEQ + qt * 256; } else { A.q0 = SEQ; A.t0 = 128; A.t1 = 130; A.yrow0 = TL + b * CTXL; }
        A.y = F.H + h * 64; A.lam = lam; A.post = post; A.subg = p.da_subln + l * 64;
        attn_item_da2(F, A);
    }
    if (ATT_MASK & 2) for (int i = 0;; ++i) {
        const int L = i * F.G + F.bid; if (L >= nDA) break;
        int bh, qt; if (L < 768) { const int w = L & 255, xcd = w & 7; bh = (L >> 8) * 4 + (xcd >> 1); qt = (xcd & 1) * 32 + (w >> 3); } else { bh = L - 768; qt = 64; }
        const int b = bh / 6, h = bh - b * 6;
        AttnArgs A; const size_t o = (size_t)(b * 6 + h) * SK;
        A.qr0 = F.QRMLA + o * 96; A.qr1 = A.qr0; A.qf0 = A.qr0; A.qf1 = A.qr0; A.qpe = F.QPE + o * 32; A.k0 = F.KMLA + o * 96; A.k1 = A.k0; A.qn0 = F.qn_mla + o; A.qn1 = A.qn0;
        A.kmax0 = sqrtf(__uint_as_float(F.kmax_mla[l * 12 + b * 6 + h])); A.kmax1 = A.kmax0;
        A.vt = F.VTMLA + o * 64;
        if (qt < 64) { A.q0 = qt * 256; A.t0 = 0; A.t1 = 130; A.yrow0 = b * SEQ + qt * 256; } else { A.q0 = SEQ; A.t0 = 128; A.t1 = 130; A.yrow0 = TL + b * CTXL; }
        A.y = F.H + 384 + h * 64; A.lam = 0.f; A.post = 1.f; A.subg = nullptr;
        attn_item<96, false>(F, A);
    }
    LAS int* qs = (LAS int*)(F.lds + LDS_MAIN + 64);
    int* qctr = F.cnt + 192 + l * 2;
    if (ATT_MASK & 4) for (;;) {
        __syncthreads();
        if (F.tid == 0) *qs = atomicAdd(qctr, 1);
        __syncthreads();
        const int it = __builtin_amdgcn_readfirstlane(*qs);
        if (it >= NB * 4 * NCH) break;
        if (last && (it % NCH) < 2) continue;
        const Frame F2 = make_frame(p, (unsigned char*)F.lds, F.wave); ret_out_item(p, F2, l, it);
    }
    for (;;) {
        __syncthreads();
        if (F.tid == 0) *qs = atomicAdd(qctr + 1, 1);
        __syncthreads();
        const int c = __builtin_amdgcn_readfirstlane(*qs);
        if (c >= CVT_TILES / 8) break;
        { const Frame F2 = make_frame(p, (unsigned char*)F.lds, F.wave); convert_expert_chunk(p, F2, l, c); }
    }
}

__device__ __forceinline__ int sig_plain(int r) { return 16 * ((r >> 2) & 1) + 4 * (r >> 3) + (r & 3); }
__device__ __forceinline__ int sig_swiglu(int r) { return 8 * ((r >> 4) + 2 * ((r >> 2) & 1)) + 4 * ((r >> 3) & 1) + (r & 3); }
template <int MR>
__device__ __forceinline__ void small_mma(const bf16_t* wp, const bf16_t* const (&ap)[MR], int nk16, f32x16 (&acc)[MR]) {
    bf16x8 wc[4], ac[MR][4];
#pragma unroll
    for (int j = 0; j < 4; ++j) { wc[j] = __builtin_bit_cast(bf16x8, ldg16(wp + 16 * j));
#pragma unroll
        for (int m = 0; m < MR; ++m) ac[m][j] = __builtin_bit_cast(bf16x8, ldg16(ap[m] + 16 * j)); }
#pragma nounroll
    for (int ks = 0; ks < nk16; ks += 4) {
        bf16x8 wn[4], an[MR][4];
#pragma unroll
        for (int j = 0; j < 4; ++j) { wn[j] = wc[j];
#pragma unroll
            for (int m = 0; m < MR; ++m) an[m][j] = ac[m][j]; }
        if (ks + 4 < nk16) {
#pragma unroll
            for (int j = 0; j < 4; ++j) { wn[j] = __builtin_bit_cast(bf16x8, ldg16(wp + 16 * (ks + 4 + j)));
#pragma unroll
                for (int m = 0; m < MR; ++m) an[m][j] = __builtin_bit_cast(bf16x8, ldg16(ap[m] + 16 * (ks + 4 + j))); } }
#pragma unroll
        for (int j = 0; j < 4; ++j)
#pragma unroll
            for (int m = 0; m < MR; ++m) acc[m] = MFMA32(wc[j], ac[m][j], acc[m]);
#pragma unroll
        for (int j = 0; j < 4; ++j) { wc[j] = wn[j];
#pragma unroll
            for (int m = 0; m < MR; ++m) ac[m][j] = an[m][j]; }
    }
}
__device__ __forceinline__ void small_store16(bf16_t* o, const f32x16& a) {
    stg<u32x4>(o, (u32x4){cvt_pk(a[0], a[1]), cvt_pk(a[2], a[3]), cvt_pk(a[4], a[5]), cvt_pk(a[6], a[7])});
    stg<u32x4>(o + 8, (u32x4){cvt_pk(a[8], a[9]), cvt_pk(a[10], a[11]), cvt_pk(a[12], a[13]), cvt_pk(a[14], a[15])});
}
#define SMALL_ZERO(acc, MR_) do { _Pragma("unroll") for (int m_ = 0; m_ < (MR_); ++m_) _Pragma("unroll") for (int i_ = 0; i_ < 16; ++i_) acc[m_][i_] = 0.f; } while (0)
__device__ __forceinline__ void small_g1(const Frame& F) {
    const int r = F.lane & 31, hh = F.lane >> 5, sg = sig_plain(r), nw = F.G * 8;
    for (int u = F.wave * F.G + F.bid; u < 512 + 8 * 81; u += nw) {
        int n0, row0;
        if (u < 512) { n0 = 2560; row0 = u * 64; } else { const int v = u - 512; n0 = (v % 81) * 32; row0 = TL + (v / 81) * 64; }
        const bf16_t* wp = F.WinT + (size_t)(n0 + sg) * DM + 8 * hh;
        const bf16_t* const ap[2] = { F.H + (size_t)(row0 + r) * DM + 8 * hh, F.H + (size_t)(row0 + 32 + r) * DM + 8 * hh };
        f32x16 acc[2]; SMALL_ZERO(acc, 2);
        small_mma<2>(wp, ap, DM / 16, acc);
#pragma unroll
        for (int m = 0; m < 2; ++m) small_store16(F.Z + (size_t)(row0 + 32 * m + r) * NINP + n0 + 16 * hh, acc[m]);
    }
}
__device__ __forceinline__ void small_g2(const Frame& F) {
    const int r = F.lane & 31, hh = F.lane >> 5, sg = sig_plain(r), nw = F.G * 8;
    for (int u = F.wave * F.G + F.bid; u < 8 * 42; u += nw) {
        const int nb = u % 42, n0 = (nb < 18 ? nb : nb + 6) * 32, row0 = TL + (u / 42) * 64;
        const int koff = n0 < KVC0 ? 0 : 256, nk16 = n0 < KVC0 ? 16 : 8;
        const bf16_t* wp = F.W2m + (size_t)(n0 + sg) * K2 + koff + 8 * hh;
        const bf16_t* const ap[2] = { F.Z + ZC_CQ + (size_t)(row0 + r) * NINP + koff + 8 * hh, F.Z + ZC_CQ + (size_t)(row0 + 32 + r) * NINP + koff + 8 * hh };
        f32x16 acc[2]; SMALL_ZERO(acc, 2);
        small_mma<2>(wp, ap, nk16, acc);
#pragma unroll
        for (int m = 0; m < 2; ++m) small_store16(F.Z2 + (size_t)(row0 + 32 * m + r) * N2P + n0 + 16 * hh, acc[m]);
    }
}
__device__ __forceinline__ void small_g3(const Frame& F, int l) {
    const int r = F.lane & 31, hh = F.lane >> 5, sg = sig_plain(r), nw = F.G * 8;
    const float* gate = F.mods + ((size_t)l * 3 + 2) * 6144 + 2 * DM;
    for (int u = F.wave * F.G + F.bid; u < 16 * 32; u += nw) {
        const int n0 = (u & 31) * 32, row0 = (u >> 5) * 32;
        const bf16_t* wp = F.WoutT + (size_t)(n0 + sg) * DM + 8 * hh;
        const bf16_t* const ap[1] = { F.H + (size_t)(TL + row0 + r) * DM + 8 * hh };
        f32x16 acc[1]; SMALL_ZERO(acc, 1);
        small_mma<1>(wp, ap, DM / 16, acc);
        float* xp = F.xc + (size_t)(row0 + r) * DM + n0 + 16 * hh; const float* gp = gate + n0 + 16 * hh;
#pragma unroll
        for (int q = 0; q < 4; ++q) { const f32x4 gv = ldg<f32x4>(gp + 4 * q), xv = ldg<f32x4>(xp + 4 * q);
            f32x4 a; a[0] = acc[0][4 * q]; a[1] = acc[0][4 * q + 1]; a[2] = acc[0][4 * q + 2]; a[3] = acc[0][4 * q + 3];
            stg<f32x4>(xp + 4 * q, xv * ALPHA + gv * a); }
    }
}
constexpr int PBIG = 256;
__device__ __forceinline__ void small_g4(const Frame& F, int npan) {
    const int r = F.lane & 31, hh = F.lane >> 5, sg = sig_swiglu(r), nw = F.G * 8;
    for (int u = F.wave * F.G + F.bid; u < (npan - PBIG) * 128; u += nw) {
        const int pm = PBIG + (u >> 7), v = u & 127, n0 = (v & 31) * 32, row0 = pm * 256 + (v >> 5) * 64;
        const int e = F.misc[16 + pm];
        const bf16_t* wp = F.W13 + (size_t)e * 1024 * 1024 + (size_t)(n0 + sg) * DM + 8 * hh;
        const bf16_t* const ap[2] = { F.H + (size_t)ldg<int>(F.gidx + row0 + r) * DM + 8 * hh, F.H + (size_t)ldg<int>(F.gidx + row0 + 32 + r) * DM + 8 * hh };
        f32x16 acc[2]; SMALL_ZERO(acc, 2);
        small_mma<2>(wp, ap, DM / 16, acc);
#pragma unroll
        for (int m = 0; m < 2; ++m) { float h[8];
#pragma unroll
            for (int t = 0; t < 8; ++t) { const float a = acc[m][8 * (t >> 2) + (t & 3)], b = acc[m][8 * (t >> 2) + 4 + (t & 3)]; h[t] = a / (1.0f + __expf(-a)) * b; }
            stg<u32x4>(F.Uact + (size_t)(row0 + 32 * m + r) * DEXP + (n0 >> 1) + 8 * hh, (u32x4){cvt_pk(h[0], h[1]), cvt_pk(h[2], h[3]), cvt_pk(h[4], h[5]), cvt_pk(h[6], h[7])}); }
    }
}
__device__ __forceinline__ void small_g5(const Frame& F, int npan) {
    const int r = F.lane & 31, hh = F.lane >> 5, sg = sig_plain(r), nw = F.G * 8;
    for (int u = F.wave * F.G + F.bid; u < (npan - PBIG) * 128; u += nw) {
        const int pm = PBIG + (u >> 7), v = u & 127, n0 = (v & 31) * 32, row0 = pm * 256 + (v >> 5) * 64;
        const int e = F.misc[16 + pm];
        const bf16_t* wp = F.W2e + (size_t)e * 1024 * 512 + (size_t)(n0 + sg) * DEXP + 8 * hh;
        const bf16_t* const ap[2] = { F.Uact + (size_t)(row0 + r) * DEXP + 8 * hh, F.Uact + (size_t)(row0 + 32 + r) * DEXP + 8 * hh };
        f32x16 acc[2]; SMALL_ZERO(acc, 2);
        small_mma<2>(wp, ap, DEXP / 16, acc);
#pragma unroll
        for (int m = 0; m < 2; ++m) small_store16(F.Fs + (size_t)(row0 + 32 * m + r) * DM + n0 + 16 * hh, acc[m]);
    }
}

typedef const __attribute__((address_space(4))) Params* KParams;
__device__ __forceinline__ Params load_params() {
    Params r;
#if defined(__HIP_DEVICE_COMPILE__)
    static_assert(sizeof(Params) == 28 * 8, "Params layout");
    const __attribute__((address_space(4))) unsigned long long* kp = (const __attribute__((address_space(4))) unsigned long long*)__builtin_amdgcn_kernarg_segment_ptr();
    asm volatile("" : "+s"(kp));
    unsigned long long* d = (unsigned long long*)&r;
#pragma unroll
    for (int i = 0; i < 28; ++i) d[i] = kp[i];
#endif
    return r;
}
__device__ __forceinline__ int lane_id() { int l; asm volatile("v_mbcnt_lo_u32_b32 %0, -1, 0\n\tv_mbcnt_hi_u32_b32 %0, -1, %0" : "=v"(l)); return l; }
__device__ __forceinline__ Frame make_frame(const Params& p, unsigned char* lds_raw, int wave_s) {
    int tid = wave_s * 64 + lane_id(); asm volatile("" : "+v"(tid));
    Frame F;
    int G = gridDim.x, bid = blockIdx.x; asm volatile("" : "+s"(G), "+s"(bid));
    F.lds = (LAS unsigned char*)lds_raw; F.tid = tid; F.lane = F.tid & 63; F.wave = __builtin_amdgcn_readfirstlane(F.tid >> 6); F.G = G; F.bid = bid;
    unsigned char* ws = p.ws; asm volatile("" : "+s"(ws)); F.ws = ws;
    F.cnt = (int*)(ws + WS_CTL); F.kmax_da = (unsigned*)(ws + WS_CTL + 256); F.kmax_mla = (unsigned*)(ws + WS_CTL + 1024); F.misc = (int*)(ws + WS_MISC);
    F.modp = (float*)(ws + WS_MODP); F.mods = (float*)(ws + WS_MODS); F.rope = (float*)(ws + WS_ROPE); F.xc = (float*)(ws + WS_XC); F.route = (int*)(ws + WS_ROUTE); F.gidx = (int*)(ws + WS_GIDX);
    F.qn_da = (float*)(ws + WS_QN); F.qn_mla = F.qn_da + (size_t)NB * 12 * SK;
    F.WinT = (bf16_t*)(ws + WS_WIN); F.W2m = (bf16_t*)(ws + WS_W2M); F.WoutT = (bf16_t*)(ws + WS_WOUT); F.H = (bf16_t*)(ws + WS_H);
    F.retq = (bf16_t*)(ws + WS_RETQ); F.retk = (bf16_t*)(ws + WS_RETK); F.ust = (float*)(ws + WS_UST);
    F.Z = (bf16_t*)(ws + WS_A); F.Hs = F.Z; F.Z2 = (bf16_t*)(ws + WS_B); F.Uact = F.Z2;
    unsigned char* rc = ws + WS_C;
    F.QRDA = (bf16_t*)(rc + WC_QRDA); F.QFDA = (bf16_t*)(rc + WC_QFDA); F.KDA = (bf16_t*)(rc + WC_KDA); F.VTDA = (bf16_t*)(rc + WC_VTDA);
    F.QRMLA = (bf16_t*)(rc + WC_QRMLA); F.QPE = (bf16_t*)(rc + WC_QPE); F.KMLA = (bf16_t*)(rc + WC_KMLA); F.VTMLA = (bf16_t*)(rc + WC_VTMLA);
    F.Fs = (bf16_t*)(rc + WC_FS); F.W13 = (bf16_t*)(ws + WS_W13); F.W2e = (bf16_t*)(ws + WS_W2E);

    return F;
}
constexpr int PH_PER_LAYER = 12, PH_PRE = 3, NPH = PH_PRE + DEPTH * PH_PER_LAYER;
__global__ void __launch_bounds__(512, 2) mk_fwd(Params p_arg) {
    extern __shared__ __attribute__((aligned(16))) unsigned char lds_raw[];
    const LAS unsigned char* const lds_c = (const LAS unsigned char*)lds_raw; (void)lds_c;
    unsigned char* ws = p_arg.ws;
    const int wave_s = __builtin_amdgcn_readfirstlane((int)threadIdx.x >> 6);
#define IS_T0 (wave_s == 0 && lane_id() == 0)
    volatile LAS unsigned* xbw = (volatile LAS unsigned*)((LAS unsigned char*)lds_raw + LDS_MAIN);
    if (threadIdx.x < 4) xbw[threadIdx.x] = 0u;
    __syncthreads();
    const int lo = p_arg.ph_lo, hi = p_arg.ph_hi;
    XcdBarrier bar; bar.bar = (unsigned*)(ws + WS_BAR); bar.x = 0; bar.st = xbw;
    if (hi - lo > 1) bar = xcd_barrier_post((unsigned*)(ws + WS_BAR), xbw, IS_T0);
#ifndef PH_MASK
#define PH_MASK 0xFFF
#endif
#ifndef PRE_MASK
#define PRE_MASK 7
#endif
#define IN(k) (lo <= (k) && (k) < hi)
#define INP(k) (((PRE_MASK >> (k)) & 1) && IN(k))
#define INL(j) (((PH_MASK >> (j)) & 1) && IN(pb + (j)))
#ifndef REP_MASK
#define REP_MASK 0
#endif
#define REPS(j) ((((REP_MASK) >> (j)) & 1) ? 2 : 1)
#define SEAM(k) do { if (IN(k) && IN((k) + 1)) xcd_barrier(bar, IS_T0); } while (0)

    if (INP(0)) { const Params p = load_params(); const Frame F = make_frame(p, lds_raw, wave_s); phase_prologue(p, F); } SEAM(0);
    if (INP(1)) { const Params p = load_params(); const Frame F = make_frame(p, lds_raw, wave_s); phase_mods(p, F); } SEAM(1);
    if (INP(2)) { const Params p = load_params(); const Frame F = make_frame(p, lds_raw, wave_s); phase_modulate(p, F, 0, 0); } SEAM(2);
    for (int l = 0; l < DEPTH; ++l) {
        const int pb = PH_PRE + l * PH_PER_LAYER;
        if (INL(0)) for (int rep_ = 0; rep_ < REPS(0); ++rep_) { const Params p = load_params(); const Frame F = make_frame(p, lds_raw, wave_s);
            pg8::Gemm g{F.H, F.WinT, TL, 2560, DM, DM, DM, nullptr, 0, -1, 0, 0, 0, 0, nullptr}; pg8::StaticOrder S; S.init(TL, 2560, F.G, F.bid);
            pg8::EpiStoreBf16 E{F.Z, NINP}; pg8::gemm_phase(F.lds, F.tid, g, S, E); small_g1(F); }
        SEAM(pb + 0);
        if (INL(1)) for (int rep_ = 0; rep_ < REPS(1); ++rep_) { const Params p = load_params(); const Frame F = make_frame(p, lds_raw, wave_s); phase_post1(p, F, l); } SEAM(pb + 1);
        if (INL(2)) for (int rep_ = 0; rep_ < REPS(2); ++rep_) { const Params p = load_params(); const Frame F = make_frame(p, lds_raw, wave_s);
            pg8::Gemm g{F.Z + ZC_CQ, F.W2m, TT, N2P, K2, NINP, K2, nullptr, 0, 3, 0, 4, 256, 2, nullptr};
            pg8::StaticOrder S; S.init(TL, N2P, F.G, F.bid);
            pg8::EpiStoreBf16 E{F.Z2, N2P}; pg8::gemm_phase(F.lds, F.tid, g, S, E); small_g2(F); }
        SEAM(pb + 2);
        if (INL(3)) for (int rep_ = 0; rep_ < REPS(3); ++rep_) { const Params p = load_params(); const Frame F = make_frame(p, lds_raw, wave_s); phase_post2(p, F, l); phase_ret_chunk_states(p, F, l); } SEAM(pb + 3);
        if (INL(4)) for (int rep_ = 0; rep_ < REPS(4); ++rep_) { const Params p = load_params(); const Frame F = make_frame(p, lds_raw, wave_s); phase_ret_scan(p, F, l); } SEAM(pb + 4);
        if (INL(5)) for (int rep_ = 0; rep_ < REPS(5); ++rep_) { const Params p = load_params(); const Frame F = make_frame(p, lds_raw, wave_s); phase_attn(p, F, l); } SEAM(pb + 5);
        if (INL(6)) for (int rep_ = 0; rep_ < REPS(6); ++rep_) { const Params p = load_params(); const Frame F = make_frame(p, lds_raw, wave_s);
            pg8::Gemm g{F.H, F.WoutT, TL, DM, DM, DM, DM, nullptr, 0, -1, 0, 0, 0, 0, nullptr}; pg8::StaticOrder S; S.init(TL, DM, F.G, F.bid);
            pg8::EpiResGate E{p.out, F.xc, F.mods + (size_t)l * 3 * 6144 + 2 * DM}; pg8::gemm_phase(F.lds, F.tid, g, S, E);
            if (l != DEPTH - 1) small_g3(F, l); }
        SEAM(pb + 6);
        if (INL(7)) for (int rep_ = 0; rep_ < REPS(7); ++rep_) { const Params p = load_params(); const Frame F = make_frame(p, lds_raw, wave_s); phase_ln1(p, F, l);
        } SEAM(pb + 7);
        if (INL(8)) for (int rep_ = 0; rep_ < REPS(8); ++rep_) { const Params p = load_params(); const Frame F = make_frame(p, lds_raw, wave_s); phase_perm(p, F, l); } SEAM(pb + 8);
        if (INL(9)) for (int rep_ = 0; rep_ < REPS(9); ++rep_) { const Params p = load_params(); const Frame F = make_frame(p, lds_raw, wave_s);
            const int npan = F.misc[0];
            const int nbig = npan < PBIG ? npan : PBIG;
            pg8::Gemm g{F.H, F.W13, nbig * 256, DM, DM, DM, DM, F.misc + 16, (size_t)1024 * 1024, -1, 0, 0, 0, 0, F.gidx}; pg8::MoeOrder S; S.init(nbig * 256, F.G, F.bid);
            pg8::EpiSwiGLU E{F.Uact}; pg8::gemm_phase<pg8::EpiSwiGLU, pg8::MoeOrder, true>(F.lds, F.tid, g, S, E); small_g4(F, npan); }
        SEAM(pb + 9);
        if (INL(10)) for (int rep_ = 0; rep_ < REPS(10); ++rep_) { const Params p = load_params(); const Frame F = make_frame(p, lds_raw, wave_s);
            const int npan = F.misc[0];
            const int nbig = npan < PBIG ? npan : PBIG;
            pg8::Gemm g{F.Uact, F.W2e, nbig * 256, DM, DEXP, DEXP, DEXP, F.misc + 16, (size_t)1024 * 512, -1, 0, 0, 0, 0, nullptr}; pg8::MoeOrder S; S.init(nbig * 256, F.G, F.bid);
            pg8::EpiStoreBf16 E{F.Fs, DM}; pg8::gemm_phase(F.lds, F.tid, g, S, E); small_g5(F, npan); }
        SEAM(pb + 10);
        if (INL(11)) for (int rep_ = 0; rep_ < REPS(11); ++rep_) { const Params p = load_params(); const Frame F = make_frame(p, lds_raw, wave_s); phase_ln2(p, F, l); if (l + 1 < DEPTH) convert_small_weights(p, F, l + 1); }
        SEAM(pb + 11);
    }
}

extern "C" void kernel_launch(void* const* d_in, const int* in_sizes, int n_in, void* d_out, int out_size, void* d_ws, size_t ws_size, hipStream_t stream) {
    static int grid = 0;
    if (grid == 0) {
        if (n_in != 25 || out_size != TL * DM || ws_size < WS_END) { fprintf(stderr, "kernel_launch: unexpected shapes / workspace (%d inputs, out %d, ws %zu < %zu)\n", n_in, out_size, ws_size, (size_t)WS_END); grid = -1; return; }
        int dev = 0, cus = 0;
        if (hipGetDevice(&dev) != hipSuccess || hipDeviceGetAttribute(&cus, hipDeviceAttributeMultiprocessorCount, dev) != hipSuccess) { grid = -1; return; }
        if (hipFuncSetAttribute((const void*)mk_fwd, hipFuncAttributeMaxDynamicSharedMemorySize, LDS_BYTES) != hipSuccess) { fprintf(stderr, "kernel_launch: hipFuncSetAttribute failed\n"); grid = -1; return; }
        int per_cu = 0;
        if (hipOccupancyMaxActiveBlocksPerMultiprocessor(&per_cu, (const void*)mk_fwd, 512, LDS_BYTES) != hipSuccess || per_cu < 1) { fprintf(stderr, "kernel_launch: occupancy query says %d\n", per_cu); }
        (void)hipGetLastError();
        grid = cus;
    }
    if (grid < 0) return;
    (void)hipMemsetAsync(d_ws, 0, WS_ZERO_BYTES, stream);
    Params p{};
    const float** pin = (const float**)&p;
    for (int i = 0; i < 25; ++i) pin[i] = (const float*)d_in[i];
    p.out = (float*)d_out; p.ws = (unsigned char*)d_ws;
#if MK_ONE_LAUNCH
    p.ph_lo = 0; p.ph_hi = NPH;
    hipLaunchKernelGGL(mk_fwd, dim3(grid), dim3(512), LDS_BYTES, stream, p);
#else
#ifndef PROBE_NPH
#define PROBE_NPH NPH
#endif
    for (int ph = 0; ph < PROBE_NPH; ++ph) { p.ph_lo = ph; p.ph_hi = ph + 1; hipLaunchKernelGGL(mk_fwd, dim3(grid), dim3(512), LDS_BYTES, stream, p); }
#endif
}
```

```cpp
#include <hip/hip_runtime.h>
#include <cstdio>
#include <cstdint>

#define LAS __attribute__((address_space(3)))
typedef unsigned short bf16_t;
typedef short bf16x8 __attribute__((ext_vector_type(8)));
typedef float f32x4 __attribute__((ext_vector_type(4)));
typedef float f32x16 __attribute__((ext_vector_type(16)));
typedef unsigned u32x4 __attribute__((ext_vector_type(4)));
typedef unsigned u32x2 __attribute__((ext_vector_type(2)));

#ifndef MK_ONE_LAUNCH
#define MK_ONE_LAUNCH 1
#endif

constexpr int DM = 1024, NB = 2, SEQ = 16384, DEPTH = 4, CTXL = 256;
constexpr int TL = NB * SEQ, TC = NB * CTXL, TT = TL + TC;
constexpr int SK = SEQ + CTXL;
constexpr int NIN = 2592, NINP = 2816;
constexpr int N2P = 1536, K2 = 384, KVC0 = 768;
constexpr int ZC_DAQ = 0, ZC_DAK = 384, ZC_DAV = 768, ZC_CQ = 1152, ZC_CKV = 1408, ZC_KPE = 1536, ZC_RQ = 1568, ZC_RK = 1824, ZC_RV = 2080, ZC_RG = 2336;
constexpr int NEXP = 16, DEXP = 512, MAXPAN = 276;
constexpr int NCH = SK / 128;
constexpr float ALPHA = 1.681792830507429f;
constexpr float LOG2E = 1.4426950408889634f;
constexpr float C2_DA = 0.17677669529663687f * LOG2E;
constexpr float C2_MLA = 0.10206207261596575f * LOG2E;

constexpr size_t al256(size_t x) { return (x + 255) & ~(size_t)255; }
constexpr size_t XCD_BAR_BYTES = 16384;
constexpr size_t WS_BAR = 0;
constexpr size_t WS_CTL = WS_BAR + XCD_BAR_BYTES;
constexpr size_t CTL_BYTES = 4096;
constexpr size_t WS_ZERO_BYTES = WS_CTL + CTL_BYTES;
constexpr size_t WS_MISC = WS_ZERO_BYTES;
constexpr size_t WS_MODP = WS_MISC + 4096;
constexpr size_t WS_MODS = WS_MODP + al256((size_t)DEPTH * 8 * 3 * 6144 * 4);
constexpr size_t WS_ROPE = WS_MODS + al256((size_t)DEPTH * 3 * 6144 * 4);
constexpr size_t WS_XC = WS_ROPE + al256((size_t)256 * 48 * 4);
constexpr size_t WS_ROUTE = WS_XC + al256((size_t)TC * DM * 4);
constexpr size_t WS_GIDX = WS_ROUTE + al256((size_t)TT * 8 * 4);
constexpr size_t WS_QN = WS_GIDX + al256((size_t)MAXPAN * 256 * 4);
constexpr size_t WS_WIN = WS_QN + al256((size_t)NB * 18 * SK * 4);
constexpr size_t WS_W2M = WS_WIN + al256((size_t)NINP * DM * 2);
constexpr size_t WS_WOUT = WS_W2M + al256((size_t)N2P * K2 * 2);
constexpr size_t WS_H = WS_WOUT + al256((size_t)DM * DM * 2);
constexpr size_t WS_RETQ = WS_H + al256((size_t)TT * DM * 2);
constexpr size_t WS_RETK = WS_RETQ + al256((size_t)NB * 4 * SK * 64 * 2);
constexpr size_t WS_UST = WS_RETK + al256((size_t)NB * 4 * SK * 64 * 2);
constexpr size_t WS_A = WS_UST + al256((size_t)NB * 4 * NCH * 2 * 4096 * 4);
constexpr size_t WS_B = WS_A + al256((size_t)TT * NINP * 2);
constexpr size_t WS_C = WS_B + al256((size_t)TT * N2P * 2);
constexpr size_t SZ_QDA = (size_t)NB * 12 * SK * 32 * 2, SZ_VT = (size_t)NB * 6 * 64 * SK * 2, SZ_QMLA = (size_t)NB * 6 * SK * 96 * 2, SZ_QPE = (size_t)NB * 6 * SK * 32 * 2;
constexpr size_t WC_QRDA = 0, WC_QFDA = WC_QRDA + SZ_QDA, WC_KDA = WC_QFDA + SZ_QDA, WC_VTDA = WC_KDA + SZ_QDA, WC_QRMLA = WC_VTDA + SZ_VT,
                 WC_QPE = WC_QRMLA + SZ_QMLA, WC_KMLA = WC_QPE + SZ_QPE, WC_VTMLA = WC_KMLA + SZ_QMLA, WC_END = WC_VTMLA + SZ_VT;
constexpr size_t WC_FS = 0, WC_W13 = (size_t)144 << 20, WC_W2E = WC_W13 + (size_t)NEXP * 1024 * 1024 * 2, WC_MOE_END = WC_W2E + (size_t)NEXP * 1024 * 512 * 2;
static_assert((size_t)MAXPAN * 256 * 1024 * 2 <= WC_W13 && WC_MOE_END <= WC_END, "region C aliasing");
static_assert((size_t)MAXPAN * 256 * 1024 * 2 <= (size_t)TT * NINP * 2 && (size_t)MAXPAN * 256 * 512 * 2 <= (size_t)TT * N2P * 2, "regions A/B aliasing");
constexpr size_t WS_W13 = WS_C + al256(WC_END);
constexpr size_t WS_W2E = WS_B + al256((size_t)MAXPAN * 256 * DEXP * 2);
static_assert(WS_W2E + (size_t)NEXP * 1024 * 512 * 2 <= WS_C, "W2e fits behind Uact in region B");
constexpr size_t WS_END = WS_W13 + al256((size_t)NEXP * 1024 * 1024 * 2);

typedef __bf16 bf16v2_t __attribute__((ext_vector_type(2)));
__device__ __forceinline__ unsigned cvt_pk(float lo, float hi) { bf16v2_t v; v[0] = (__bf16)lo; v[1] = (__bf16)hi; return __builtin_bit_cast(unsigned, v); }
__device__ __forceinline__ bf16_t f2bf(float f) { return (bf16_t)(cvt_pk(f, f) & 0xffffu); }
__device__ __forceinline__ float bf2f(bf16_t b) { return __uint_as_float(((unsigned)b) << 16); }
__device__ __forceinline__ float bflo(unsigned w) { return __uint_as_float(w << 16); }
__device__ __forceinline__ float bfhi(unsigned w) { return __uint_as_float(w & 0xffff0000u); }
template <int CTRL> __device__ __forceinline__ float dppf(float v) { return __builtin_bit_cast(float, __builtin_amdgcn_update_dpp(0, __builtin_bit_cast(int, v), CTRL, 0xF, 0xF, true)); }
__device__ __forceinline__ float rdlane(float v, int l) { return __builtin_bit_cast(float, __builtin_amdgcn_readlane(__builtin_bit_cast(int, v), l)); }
__device__ __forceinline__ float rsum16(float v) { v += dppf<0xB1>(v); v += dppf<0x4E>(v); v += dppf<0x141>(v); v += dppf<0x140>(v); return v; }
__device__ __forceinline__ float add_xor16(float v) { const auto r2 = __builtin_amdgcn_permlane16_swap(__float_as_uint(v), __float_as_uint(v), false, false); return __uint_as_float(r2[0]) + __uint_as_float(r2[1]); }
__device__ __forceinline__ float add_xor32(float v) { const auto r2 = __builtin_amdgcn_permlane32_swap(__float_as_uint(v), __float_as_uint(v), false, false); return __uint_as_float(r2[0]) + __uint_as_float(r2[1]); }
__device__ __forceinline__ float wsum(float v) {
    v += dppf<0xB1>(v);
    v += dppf<0x4E>(v);
    v += dppf<0x141>(v);
    v += dppf<0x140>(v);
    return ((rdlane(v, 0) + rdlane(v, 16)) + rdlane(v, 32)) + rdlane(v, 48); }
__device__ __forceinline__ float siluf(float v) { return v / (1.0f + __expf(-v)); }
__device__ __forceinline__ u32x4 ldg16(const void* p) { return *(const __attribute__((address_space(1))) u32x4*)p; }
__device__ __forceinline__ float ldgf(const float* p) { return *(const __attribute__((address_space(1))) float*)p; }
template <class T> __device__ __forceinline__ T ldg(const void* p) { return *(const __attribute__((address_space(1))) T*)p; }
template <class T> __device__ __forceinline__ void stg(void* p, T v) { *(__attribute__((address_space(1))) T*)p = v; }
__device__ __forceinline__ int pi32(int r) { return (r & ~12) | ((r & 4) << 1) | ((r & 8) >> 1); }

#define XB_TMO      128
#define XB_XCNT(j)  (256  + 64 * (j))
#define XB_XSUB(j)  (1280 + 64 * (j))
#define XB_XGEN(j)  (2304 + 64 * (j))
#define XB_TOP      3328
#define XB_TOPGEN   3392
#define XCD_BAR_WORDS 3456
#define XB_SPIN_CAP (1u << 22)
static_assert(XCD_BAR_WORDS * 4 <= XCD_BAR_BYTES, "barrier words");

__device__ __forceinline__ unsigned xb_ld(unsigned* p)              { return __hip_atomic_load(p, __ATOMIC_RELAXED, __HIP_MEMORY_SCOPE_AGENT); }
__device__ __forceinline__ unsigned xb_add(unsigned* p, unsigned v) { return __hip_atomic_fetch_add(p, v, __ATOMIC_RELAXED, __HIP_MEMORY_SCOPE_AGENT); }
__device__ __forceinline__ unsigned xb_xcc_id() { return (unsigned)__builtin_amdgcn_s_getreg((3 << 11) | 20) & 0xFu; }
#define XB_SPIN(cond, bar) do { unsigned _sp = 0; while (cond) { __builtin_amdgcn_s_sleep(1); \
    if ((++_sp & 255u) == 0u) { if (xb_ld(&(bar)[XB_TMO])) break; if (_sp > XB_SPIN_CAP) { atomicAdd(&(bar)[XB_TMO], 1u); break; } } } } while (0)

struct XcdBarrier { unsigned* bar; unsigned x; volatile LAS unsigned* st; };

__device__ __forceinline__ XcdBarrier xcd_barrier_post(unsigned* bar, volatile LAS unsigned* st, bool is_t0) {
    XcdBarrier b; b.bar = bar; b.x = xb_xcc_id(); b.st = st;
    if (is_t0) (void)xb_add(&bar[XB_XCNT(b.x)], 1u);
    return b;
}
__device__ __forceinline__ void xcd_barrier_complete(unsigned* bar, unsigned x, unsigned& nloc, unsigned& nx) {
    const unsigned G = gridDim.x * gridDim.y * gridDim.z;
    unsigned sum, cnt, mine, sp = 0u;
    for (;;) {
        sum = 0u; cnt = 0u; mine = 0u;
#pragma unroll
        for (unsigned j = 0; j < 16; ++j) { const unsigned c = xb_ld(&bar[XB_XCNT(j)]); sum += c; cnt += (c > 0u) ? 1u : 0u; }
        if (sum == G) { mine = xb_ld(&bar[XB_XCNT(x)]); break; }
        __builtin_amdgcn_s_sleep(1);
        if ((++sp & 255u) == 0u) { if (xb_ld(&bar[XB_TMO])) break; if (sp > XB_SPIN_CAP) { atomicAdd(&bar[XB_TMO], 1u); break; } }
    }
    nloc = mine > 0u ? mine : 1u; nx = cnt > 0u ? cnt : 1u;
}
__device__ __forceinline__ void xcd_barrier(const XcdBarrier& b, bool is_t0) {
    asm volatile("s_waitcnt vmcnt(0)" ::: "memory");
    __syncthreads();
    if (is_t0) {
        unsigned* bar = b.bar; asm volatile("" : "+s"(bar));
        __builtin_amdgcn_s_waitcnt(0);
        unsigned nloc = b.st[0], nx = b.st[1];
        if (nloc == 0u) { xcd_barrier_complete(bar, b.x, nloc, nx); b.st[0] = nloc; b.st[1] = nx; }
        const unsigned old = xb_add(&bar[XB_XSUB(b.x)], 1u);
        const unsigned gen = old / nloc;
        if (old + 1u == (gen + 1u) * nloc) {
            __builtin_amdgcn_fence(__ATOMIC_RELEASE, "agent");
            asm volatile("s_waitcnt vmcnt(0)" ::: "memory");
            const unsigned og = xb_add(&bar[XB_TOP], 1u);
            const unsigned tg = og / nx;
            if (og + 1u == (tg + 1u) * nx) xb_add(&bar[XB_TOPGEN], 1u);
            else XB_SPIN(xb_ld(&bar[XB_TOPGEN]) == tg, bar);
            __builtin_amdgcn_fence(__ATOMIC_ACQUIRE, "agent");
            xb_add(&bar[XB_XGEN(b.x)], 1u);
            asm volatile("s_waitcnt vmcnt(0)" ::: "memory");
        } else {
            XB_SPIN(xb_ld(&bar[XB_XGEN(b.x)]) == gen, bar);
            __builtin_amdgcn_fence(__ATOMIC_ACQUIRE, "agent");
            asm volatile("s_waitcnt vmcnt(0)" ::: "memory");
        }
    }
    __syncthreads();
}

namespace pg8 {
constexpr int BM = 256, BK = 64, HALF = 128, HTB = HALF * BK * 2, STAGE_BYTES = 8 * HTB, NXCD = 8, WGM = 8;
__host__ __device__ __forceinline__ int lds_byte(int r, int c) { const int st = (r >> 4) * 2 + (c >> 5), rr = r & 15, cc = c & 31, ob = rr * 64 + cc * 2; return st * 1024 + (ob ^ (((ob >> 9) & 1) << 5)); }
__host__ __device__ __forceinline__ void stage_rc(int b, int& R, int& C) { const int st = b / 1024, sb = b % 1024, swz = sb ^ (((sb >> 9) & 1) << 5); R = (st >> 1) * 16 + swz / 64; C = (st & 1) * 32 + (swz % 64) / 2; }
__host__ __device__ __forceinline__ int perm32(int rho) { const int n = rho >> 4, i = rho & 15; return 8 * (i >> 2) + 4 * n + (i & 3); }

struct Unit { int pm, pn; };
struct Gemm { const bf16_t* A; const bf16_t* Bt; int M, N, K, lda, ldb; const int* bsel; size_t bstride;
              int ks_pn, k0a, nta, k0b, ntb;
              const int* gidx; };

struct StaticOrder {
    int nM, nN, nwg, G, c;
    __host__ __device__ void init(int M, int N, int G_, int c_) { nM = M / BM; nN = N / BM; nwg = nM * nN; G = G_; c = c_; }
    __host__ __device__ bool next(int i, Unit& u) const {
        const long L = (long)i * G + c; if (L >= nwg) return false;
        int wgid = (int)L; { const int q = nwg / NXCD, r = nwg % NXCD, xcd = wgid % NXCD, off = wgid / NXCD; wgid = (xcd < r ? xcd * (q + 1) : r * (q + 1) + (xcd - r) * q) + off; }
        const int nig = WGM * nN, gid = wgid / nig, fm = gid * WGM, gsz = (nM - fm) < WGM ? (nM - fm) : WGM;
        u.pm = fm + ((wgid % nig) % gsz); u.pn = (wgid % nig) / gsz; return true;
    }
    __device__ __forceinline__ void a_ready(const Unit&) const {}
    __device__ __forceinline__ void done(const Unit&) const {}
};

struct MoeOrder {
    int nM, G, c;
    __host__ __device__ void init(int M, int G_, int c_) { nM = M / BM; G = G_; c = c_; }
    __host__ __device__ bool next(int i, Unit& u) const {
        if (G == 256) { const int slot = c >> 3; u.pm = ((i * 8 + (c & 7)) << 3) + (slot & 7); u.pn = slot >> 3; return u.pm < nM; }
        const int L = i * G + c; u.pm = L >> 2; u.pn = L & 3; return u.pm < nM;
    }
    __device__ __forceinline__ void a_ready(const Unit&) const {}
    __device__ __forceinline__ void done(const Unit&) const {}
};

template <class Epi, class Sched, bool GATHER = false>
__device__ __forceinline__ void gemm_phase(LAS unsigned char* lds, const int tid, const Gemm g, const Sched& S, const Epi& E) {
    const int wid = __builtin_amdgcn_readfirstlane(tid >> 6), lane = tid & 63, wr = wid >> 2, wc = wid & 3, fr = lane & 15, fq = lane >> 4;
    const int K = g.K;
#define PG8_KOFF(u) ((size_t)(g.ks_pn < 0 ? 0 : ((u).pn < g.ks_pn ? g.k0a : g.k0b)) * 2)
#define PG8_NT(u) (g.ks_pn < 0 ? K / BK : ((u).pn < g.ks_pn ? g.nta : g.ntb))
    unsigned voffA[2], voffB[2]; int Rrow[2], Ccol[2];
#pragma unroll
    for (int i = 0; i < 2; ++i) { int R, C; stage_rc(tid * 16 + i * 8192, R, C); const int Rb = Epi::PERM ? ((R & ~31) + perm32(R & 31)) : R; Rrow[i] = R; Ccol[i] = C;
        voffA[i] = (unsigned)(R * g.lda + C) * 2u; voffB[i] = (unsigned)(Rb * g.ldb + C) * 2u; }
    unsigned gc[2][2] = {{0u, 0u}, {0u, 0u}}, gn[2][2] = {{0u, 0u}, {0u, 0u}};
#define PG8_GLOAD(dst, u) do { _Pragma("unroll") for (int h_ = 0; h_ < 2; ++h_) _Pragma("unroll") for (int i_ = 0; i_ < 2; ++i_) \
        dst[h_][i_] = (unsigned)(ldg<int>(g.gidx + (u).pm * BM + h_ * HALF + Rrow[i_]) * g.lda + Ccol[i_]) * 2u; \
        _Pragma("unroll") for (int h_ = 0; h_ < 2; ++h_) _Pragma("unroll") for (int i_ = 0; i_ < 2; ++i_) asm volatile("" : "+v"(dst[h_][i_])); } while (0)
#define PG8_STAGE_A(bufoff, gbase, hh_, ARR) do { if (GATHER) PG8_STAGE(bufoff, gbase, ARR[hh_]); else PG8_STAGE(bufoff, (gbase) + (hh_) * hstepA, voffA); } while (0)
    const size_t kstep = (size_t)(BK * 2);
    const size_t hstepA = (size_t)HALF * g.lda * 2, hstepB = (size_t)HALF * g.ldb * 2;
    const size_t tstepA = 2 * hstepA, tstepB = 2 * hstepB;
    const unsigned ldsw = (unsigned)wid * 1024u;
    const int aoff = lds_byte(wr * 64 + fr, fq * 8), boff = lds_byte(wc * 32 + fr, fq * 8);
#define PG8_SA(b, h) (((b) * 2 + (h)) * HTB)
#define PG8_SB(b, h) ((4 + (b) * 2 + (h)) * HTB)
#define PG8_STAGE(bufoff, gbase, voff) do { _Pragma("unroll") for (int _i = 0; _i < 2; ++_i) \
        __builtin_amdgcn_global_load_lds((const unsigned*)((const char*)(gbase) + (voff)[_i]), (LAS unsigned*)(lds + (bufoff) + ldsw + _i * 8192), 16, 0, 0); } while (0)
#define PG8_LDA(dst, b, h) do { _Pragma("unroll") for (int m = 0; m < 4; ++m) _Pragma("unroll") for (int k = 0; k < 2; ++k) dst[m][k] = *(const LAS bf16x8*)(lds + PG8_SA(b, h) + aoff + m * 2048 + k * 1024); } while (0)
#define PG8_LDB(dst, b, h) do { _Pragma("unroll") for (int n = 0; n < 2; ++n) _Pragma("unroll") for (int k = 0; k < 2; ++k) dst[n][k] = *(const LAS bf16x8*)(lds + PG8_SB(b, h) + boff + n * 2048 + k * 1024); } while (0)
#define PG8_MMA(ai, bj, At, Bt) do { __builtin_amdgcn_s_setprio(1); _Pragma("unroll") for (int m = 0; m < 4; ++m) _Pragma("unroll") for (int n = 0; n < 2; ++n) _Pragma("unroll") for (int k = 0; k < 2; ++k) \
        acc[ai][bj][m][n] = __builtin_amdgcn_mfma_f32_16x16x32_bf16(Bt[n][k], At[m][k], acc[ai][bj][m][n], 0, 0, 0); __builtin_amdgcn_s_setprio(0); } while (0)
#define PG8_WAIT_V(n) asm volatile("s_waitcnt vmcnt(" #n ")" ::: "memory")
#define PG8_WAIT_L(n) asm volatile("s_waitcnt lgkmcnt(" #n ")" ::: "memory")
#define PG8_BAR __builtin_amdgcn_s_barrier()
#define PG8_SCHED __builtin_amdgcn_sched_barrier(0)
#define PG8_BBASE(u) ((const char*)g.Bt + (g.bsel ? (size_t)g.bsel[(u).pm] * g.bstride * 2 : (size_t)0) + (size_t)(u).pn * tstepB)
    Unit cur, nxt; int ui = 0;
    if (!S.next(0, cur)) return;
    f32x4 acc[2][2][4][2];
#pragma unroll
    for (int a = 0; a < 2; ++a)
#pragma unroll
        for (int b = 0; b < 2; ++b)
#pragma unroll
            for (int m = 0; m < 4; ++m)
#pragma unroll
                for (int n = 0; n < 2; ++n) acc[a][b][m][n] = (f32x4){0.f, 0.f, 0.f, 0.f};
    bf16x8 At[4][2], B0[2][2], B1[2][2];
    const char* cA = (const char*)g.A + (GATHER ? (size_t)0 : (size_t)cur.pm * tstepA) + PG8_KOFF(cur); const char* cB = PG8_BBASE(cur) + PG8_KOFF(cur);
    int nt = PG8_NT(cur);
    S.a_ready(cur);
    if (GATHER) PG8_GLOAD(gc, cur);
    PG8_STAGE(PG8_SB(0, 0), cB, voffB); PG8_STAGE_A(PG8_SA(0, 0), cA, 0, gc); PG8_STAGE(PG8_SB(0, 1), cB + hstepB, voffB); PG8_STAGE_A(PG8_SA(0, 1), cA, 1, gc);
    if (wr == 1) PG8_BAR;
    PG8_WAIT_V(4); PG8_BAR;
    PG8_STAGE(PG8_SB(1, 0), cB + kstep, voffB); PG8_STAGE_A(PG8_SA(1, 0), cA + kstep, 0, gc); PG8_STAGE(PG8_SB(1, 1), cB + hstepB + kstep, voffB);
    PG8_WAIT_V(6); PG8_BAR;
    for (;;) {
        const bool has_next = S.next(ui + 1, nxt);
        const char* nA = has_next ? (const char*)g.A + (GATHER ? (size_t)0 : (size_t)nxt.pm * tstepA) + PG8_KOFF(nxt) : cA; const char* nB = has_next ? PG8_BBASE(nxt) + PG8_KOFF(nxt) : cB;
        if (GATHER) { if (has_next) PG8_GLOAD(gn, nxt); else { _Pragma("unroll") for (int h_ = 0; h_ < 2; ++h_) _Pragma("unroll") for (int i_ = 0; i_ < 2; ++i_) gn[h_][i_] = gc[h_][i_]; } }
#pragma nounroll
        for (int t = 0; t < nt; t += 2) {
            const bool last = (t == nt - 2);
            const char* a1 = cA + (size_t)(t + 1) * kstep;
            const char* a2 = last ? nA : cA + (size_t)(t + 2) * kstep; const char* b2 = last ? nB : cB + (size_t)(t + 2) * kstep;
            const char* a3 = a2 + kstep; const char* b3 = b2 + kstep;
            if (last && has_next) S.a_ready(nxt);
            unsigned g2[2][2];
#pragma unroll
            for (int h_ = 0; h_ < 2; ++h_)
#pragma unroll
                for (int i_ = 0; i_ < 2; ++i_) g2[h_][i_] = last ? gn[h_][i_] : gc[h_][i_];
            PG8_LDB(B0, 0, 0); PG8_SCHED; PG8_LDA(At, 0, 0); PG8_STAGE_A(PG8_SA(1, 1), a1, 1, gc);
            PG8_WAIT_L(8); PG8_BAR; PG8_WAIT_L(0); PG8_MMA(0, 0, At, B0); PG8_BAR; PG8_SCHED;
            PG8_LDB(B1, 0, 1); PG8_STAGE(PG8_SB(0, 0), b2, voffB);
            PG8_BAR; PG8_WAIT_L(0); PG8_MMA(0, 1, At, B1); PG8_BAR;
            PG8_LDA(At, 0, 1); PG8_STAGE_A(PG8_SA(0, 0), a2, 0, g2);
            PG8_BAR; PG8_WAIT_L(0); PG8_MMA(1, 0, At, B0); PG8_BAR; PG8_SCHED;
            PG8_STAGE(PG8_SB(0, 1), b2 + hstepB, voffB);
            PG8_WAIT_V(6); PG8_BAR; PG8_MMA(1, 1, At, B1); PG8_BAR;
            PG8_LDB(B0, 1, 0); PG8_SCHED; PG8_LDA(At, 1, 0); PG8_STAGE_A(PG8_SA(0, 1), a2, 1, g2);
            PG8_WAIT_L(8); PG8_BAR; PG8_WAIT_L(0); PG8_MMA(0, 0, At, B0); PG8_BAR; PG8_SCHED;
            PG8_LDB(B1, 1, 1); PG8_STAGE(PG8_SB(1, 0), b3, voffB);
            PG8_BAR; PG8_WAIT_L(0); PG8_MMA(0, 1, At, B1); PG8_BAR;
            PG8_LDA(At, 1, 1); PG8_STAGE_A(PG8_SA(1, 0), a3, 0, g2);
            PG8_BAR; PG8_WAIT_L(0); PG8_MMA(1, 0, At, B0); PG8_BAR; PG8_SCHED;
            PG8_STAGE(PG8_SB(1, 1), b3 + hstepB, voffB);
            PG8_WAIT_V(6); PG8_BAR; PG8_MMA(1, 1, At, B1); PG8_BAR;
        }
        E(acc, cur, wr, wc, fr, fq);
        if (!has_next) break;
#pragma unroll
        for (int a = 0; a < 2; ++a)
#pragma unroll
            for (int b = 0; b < 2; ++b)
#pragma unroll
                for (int m = 0; m < 4; ++m)
#pragma unroll
                    for (int n = 0; n < 2; ++n) acc[a][b][m][n] = (f32x4){0.f, 0.f, 0.f, 0.f};
        cur = nxt; cA = nA; cB = nB; ++ui; nt = PG8_NT(cur);
        if (GATHER) { _Pragma("unroll") for (int h_ = 0; h_ < 2; ++h_) _Pragma("unroll") for (int i_ = 0; i_ < 2; ++i_) gc[h_][i_] = gn[h_][i_]; }
    }
    PG8_WAIT_V(0);
    if (wr == 0) PG8_BAR;
    PG8_BAR;
#undef PG8_SA
#undef PG8_SB
#undef PG8_STAGE
#undef PG8_LDA
#undef PG8_LDB
#undef PG8_MMA
#undef PG8_WAIT_V
#undef PG8_WAIT_L
#undef PG8_BAR
#undef PG8_SCHED
#undef PG8_BBASE
#undef PG8_KOFF
#undef PG8_NT
#undef PG8_GLOAD
#undef PG8_STAGE_A
}

struct EpiStoreBf16 {
    static constexpr bool PERM = true;
    bf16_t* O; int ldc;
    __device__ __forceinline__ void operator()(const f32x4 (&acc)[2][2][4][2], const Unit& u, int wr, int wc, int fr, int fq) const {
        const int row0 = u.pm * BM + wr * 64 + fr, col0 = u.pn * BM + wc * 32 + 8 * fq;
#pragma unroll
        for (int ai = 0; ai < 2; ++ai)
#pragma unroll
            for (int m = 0; m < 4; ++m) { bf16_t* rowp = O + (size_t)(row0 + ai * HALF + m * 16) * ldc + col0;
#pragma unroll
                for (int bj = 0; bj < 2; ++bj) { const f32x4 v0 = acc[ai][bj][m][0], v1 = acc[ai][bj][m][1];
                    u32x4 w; w.x = cvt_pk(v0[0], v0[1]); w.y = cvt_pk(v0[2], v0[3]); w.z = cvt_pk(v1[0], v1[1]); w.w = cvt_pk(v1[2], v1[3]);
                    *(u32x4*)(rowp + bj * HALF) = w; } }
    }
};
struct EpiResGate {
    static constexpr bool PERM = false;
    float* xl; float* xc; const float* gate;
    __device__ __forceinline__ void operator()(const f32x4 (&acc)[2][2][4][2], const Unit& u, int wr, int wc, int fr, int fq) const {
        const int row0 = u.pm * BM + wr * 64 + fr, col0 = u.pn * BM + wc * 32 + 4 * fq;
        const int ms = row0 < TL ? (row0 >> 14) : 2;
        float* const base = (row0 < TL ? xl + (size_t)row0 * DM : xc + (size_t)(row0 - TL) * DM) + col0;
        const float* gp = gate + (size_t)ms * 6144 + col0;
        f32x4 gv[2][2];
#pragma unroll
        for (int bj = 0; bj < 2; ++bj)
#pragma unroll
            for (int n = 0; n < 2; ++n) gv[bj][n] = ldg<f32x4>(gp + bj * HALF + n * 16);
        f32x4 xb[3][2][2];
#define ERG_LOAD(q_) do { const float* rp_ = base + (size_t)(((q_) >> 2) * HALF + ((q_) & 3) * 16) * DM; \
            _Pragma("unroll") for (int bj = 0; bj < 2; ++bj) _Pragma("unroll") for (int n = 0; n < 2; ++n) xb[(q_) % 3][bj][n] = ldg<f32x4>(rp_ + bj * HALF + n * 16); } while (0)
        ERG_LOAD(0); ERG_LOAD(1);
#pragma unroll
        for (int q = 0; q < 8; ++q) {
            if (q + 2 < 8) ERG_LOAD(q + 2);
            float* rp = base + (size_t)((q >> 2) * HALF + (q & 3) * 16) * DM;
#pragma unroll
            for (int bj = 0; bj < 2; ++bj)
#pragma unroll
                for (int n = 0; n < 2; ++n) stg<f32x4>(rp + bj * HALF + n * 16, xb[q % 3][bj][n] * ALPHA + gv[bj][n] * acc[q >> 2][bj][q & 3][n]);
            __builtin_amdgcn_sched_barrier(0);
        }
#undef ERG_LOAD
    }
};
struct EpiSwiGLU {
    static constexpr bool PERM = true;
    bf16_t* U;
    __device__ __forceinline__ void operator()(const f32x4 (&acc)[2][2][4][2], const Unit& u, int wr, int wc, int fr, int fq) const {
        const int row0 = u.pm * BM + wr * 64 + fr, col0 = u.pn * BM + wc * 32 + 8 * fq;
#pragma unroll
        for (int ai = 0; ai < 2; ++ai)
#pragma unroll
            for (int m = 0; m < 4; ++m) { bf16_t* rowp = U + (size_t)(row0 + ai * HALF + m * 16) * DEXP + (col0 >> 1);
#pragma unroll
                for (int bj = 0; bj < 2; ++bj) { const f32x4 a = acc[ai][bj][m][0], b = acc[ai][bj][m][1];
                    float r[4];
#pragma unroll
                    for (int j = 0; j < 4; ++j) r[j] = a[j] / (1.0f + __expf(-a[j])) * b[j];
                    u32x2 w; w.x = cvt_pk(r[0], r[1]); w.y = cvt_pk(r[2], r[3]);
                    *(u32x2*)(rowp + bj * (HALF / 2)) = w; } }
    }
};
}

struct Params {
    const float *x, *c, *ctx, *c_ctx, *w_ada, *b_ada, *w_in, *da_lambda, *da_subln, *mla_q_norm, *mla_w_uq, *mla_kv_norm, *mla_w_ukv,
                *ret_decay_f, *ret_decay_b, *w_out, *ln1_g, *ln1_b, *router_w, *router_b, *exp_w1, *exp_w3, *exp_w2, *ln2_g, *ln2_b;
    float* out; unsigned char* ws; int ph_lo, ph_hi;
};
struct Frame {
    LAS unsigned char* lds; int tid, lane, wave, G, bid;
    unsigned char* ws;
    int* cnt; unsigned* kmax_da; unsigned* kmax_mla; int* misc;
    float *modp, *mods, *rope, *xc; int* route; int* gidx; float *qn_da, *qn_mla;
    bf16_t *WinT, *W2m, *WoutT, *H, *retq, *retk; float* ust;
    bf16_t *Z, *Hs, *Z2, *Uact, *QRDA, *QFDA, *KDA, *VTDA, *QRMLA, *QPE, *KMLA, *VTMLA, *Fs, *W13, *W2e;
};
constexpr int LDS_MAIN = 131072;
constexpr int LDS_BYTES = LDS_MAIN + 256;

__device__ __forceinline__ float* xrow(const Params& p, const Frame& F, int row) { return row < TL ? p.out + (size_t)row * DM : F.xc + (size_t)(row - TL) * DM; }
__device__ __forceinline__ int msel_of(int row) { return row < TL ? (row >> 14) : 2; }

template <bool ILV>
__device__ __forceinline__ void cvt_tile(const Frame& F, const float* srcA, const float* srcB, int validA, int validB, int ldsrc, int k0, bf16_t* dst, int ldd, int n0) {
    LAS float* tile = (LAS float*)F.lds;
    const int t = F.tid, kk = t >> 3, j = t & 7;
    const float* sp = (j < 4 ? srcA + 8 * j : srcB + 8 * (j - 4)) + (size_t)(k0 + kk) * ldsrc;
    const bool ok = (j < 4) ? (8 * j < validA) : (8 * (j - 4) < validB);
    f32x4 v0 = (f32x4){0.f, 0.f, 0.f, 0.f}, v1 = v0;
    if (ok) { v0 = *(const f32x4*)sp; v1 = *(const f32x4*)(sp + 4); }
    __syncthreads();
#pragma unroll
    for (int i = 0; i < 4; ++i) { tile[kk * 65 + 8 * j + i] = v0[i]; tile[kk * 65 + 8 * j + 4 + i] = v1[i]; }
    __syncthreads();
    const int nn = t >> 3, ks = t & 7;
    int col = nn; if (ILV) { const int q = nn >> 3, i = nn & 7; col = (i < 4) ? 4 * q + i : 32 + 4 * q + (i - 4); }
    float r[8];
#pragma unroll
    for (int i = 0; i < 8; ++i) r[i] = tile[(ks * 8 + i) * 65 + col];
    u32x4 w; w.x = cvt_pk(r[0], r[1]); w.y = cvt_pk(r[2], r[3]); w.z = cvt_pk(r[4], r[5]); w.w = cvt_pk(r[6], r[7]);
    *(u32x4*)(dst + (size_t)(n0 + nn) * ldd + k0 + ks * 8) = w;
}
__device__ __forceinline__ void convert_small_weights(const Params& p, const Frame& F, int l) {
    const float* win = p.w_in + (size_t)l * DM * NIN;
    const float* wout = p.w_out + (size_t)l * DM * DM;
    constexpr int T_IN = (NINP / 64) * 16, T_OUT = 16 * 16;
    for (int u = F.bid; u < T_IN + T_OUT; u += F.G) {
        if (u < T_IN) { const int tn = u >> 4, tk = u & 15, n0 = tn * 64; int vA = NIN - n0; vA = vA < 0 ? 0 : (vA > 32 ? 32 : vA); int vB = NIN - n0 - 32; vB = vB < 0 ? 0 : (vB > 32 ? 32 : vB);
            const int nc = n0 < NIN - 64 ? n0 : (n0 < NIN ? n0 : 0);
            cvt_tile<false>(F, win + nc, win + (nc + 32 < NIN ? nc + 32 : 0), vA, vB, NIN, tk * 64, F.WinT, DM, n0); }
        else { const int v = u - T_IN, tn = v >> 4, tk = v & 15;
            cvt_tile<false>(F, wout + tn * 64, wout + tn * 64 + 32, 32, 32, DM, tk * 64, F.WoutT, DM, tn * 64); }
    }
    const float* wuq = p.mla_w_uq + (size_t)l * 256 * 576; const float* wukv = p.mla_w_ukv + (size_t)l * 128 * 768;
    const float* gq = p.mla_q_norm + l * 256; const float* gkv = p.mla_kv_norm + l * 128;
    for (int i = F.bid * 512 + F.tid; i < N2P * (K2 / 8); i += F.G * 512) {
        const int n = i / (K2 / 8), k0 = (i % (K2 / 8)) * 8; float r[8];
#pragma unroll
        for (int j = 0; j < 8; ++j) { const int k = k0 + j; float v = 0.f;
            if (n < 576) { if (k < 256) v = wuq[(size_t)k * 576 + n] * gq[k] * C2_MLA; }
            else if (n >= KVC0) { if (k >= 256) v = wukv[(size_t)(k - 256) * 768 + (n - KVC0)] * gkv[k - 256]; }
            r[j] = v; }
        u32x4 w; w.x = cvt_pk(r[0], r[1]); w.y = cvt_pk(r[2], r[3]); w.z = cvt_pk(r[4], r[5]); w.w = cvt_pk(r[6], r[7]);
        *(u32x4*)(F.W2m + (size_t)n * K2 + k0) = w;
    }
}
constexpr int CVT_T13 = NEXP * 16 * 16, CVT_T2 = NEXP * 16 * 8, CVT_TILES = CVT_T13 + CVT_T2;
__device__ __forceinline__ void convert_expert_tile(const Params& p, const Frame& F, int l, int u) {
    if (u < CVT_T13) { const int e = u >> 8, tn = (u >> 4) & 15, tk = u & 15;
        const float* w1 = p.exp_w1 + ((size_t)(l * NEXP + e) * DM) * DEXP + tn * 32; const float* w3 = p.exp_w3 + ((size_t)(l * NEXP + e) * DM) * DEXP + tn * 32;
        cvt_tile<true>(F, w1, w3, 32, 32, DEXP, tk * 64, F.W13 + (size_t)e * 1024 * 1024, DM, tn * 64); }
    else { const int v = u - CVT_T13, e = v >> 7, tn = (v >> 3) & 15, tk = v & 7;
        const float* w2 = p.exp_w2 + ((size_t)(l * NEXP + e) * DEXP) * DM + tn * 64;
        cvt_tile<false>(F, w2, w2 + 32, 32, 32, DM, tk * 64, F.W2e + (size_t)e * 1024 * 512, DEXP, tn * 64); }
}

__device__ __forceinline__ void convert_expert_chunk(const Params& p, const Frame& F, int l, int c) {
    LAS float* tile = (LAS float*)F.lds;
    const int t = F.tid, kk = t >> 3, j = t & 7;
    const bool w13 = (c * 8 < CVT_T13);
    f32x4 v0[8], v1[8];
#pragma unroll
    for (int k = 0; k < 8; ++k) { const int u = c * 8 + k;
        const float* sp;
        if (w13) { const int e = u >> 8, tn = (u >> 4) & 15, tk = u & 15;
            const float* w1 = p.exp_w1 + ((size_t)(l * NEXP + e) * DM) * DEXP + tn * 32; const float* w3 = p.exp_w3 + ((size_t)(l * NEXP + e) * DM) * DEXP + tn * 32;
            sp = (j < 4 ? w1 + 8 * j : w3 + 8 * (j - 4)) + (size_t)(tk * 64 + kk) * DEXP; }
        else { const int v = u - CVT_T13, e = v >> 7, tn = (v >> 3) & 15, tk = v & 7;
            const float* w2 = p.exp_w2 + ((size_t)(l * NEXP + e) * DEXP) * DM + tn * 64;
            sp = (j < 4 ? w2 + 8 * j : w2 + 32 + 8 * (j - 4)) + (size_t)(tk * 64 + kk) * DM; }
        v0[k] = ldg<f32x4>(sp); v1[k] = ldg<f32x4>(sp + 4); }
#pragma unroll
    for (int k = 0; k < 8; ++k) { asm volatile("" : "+v"(v0[k])); asm volatile("" : "+v"(v1[k])); }
    __builtin_amdgcn_sched_barrier(0);
#pragma unroll
    for (int k = 0; k < 8; ++k) { const int u = c * 8 + k;
        __syncthreads();
#pragma unroll
        for (int i = 0; i < 4; ++i) { tile[kk * 65 + 8 * j + i] = v0[k][i]; tile[kk * 65 + 8 * j + 4 + i] = v1[k][i]; }
        __syncthreads();
        const int nn = t >> 3, ks = t & 7;
        int col = nn; if (w13) { const int q = nn >> 3, i = nn & 7; col = (i < 4) ? 4 * q + i : 32 + 4 * q + (i - 4); }
        float r[8];
#pragma unroll
        for (int i = 0; i < 8; ++i) r[i] = tile[(ks * 8 + i) * 65 + col];
        u32x4 w; w.x = cvt_pk(r[0], r[1]); w.y = cvt_pk(r[2], r[3]); w.z = cvt_pk(r[4], r[5]); w.w = cvt_pk(r[6], r[7]);
        if (w13) { const int e = u >> 8, tn = (u >> 4) & 15, tk = u & 15; stg<u32x4>(F.W13 + (size_t)e * 1024 * 1024 + (size_t)(tn * 64 + nn) * DM + tk * 64 + ks * 8, w); }
        else { const int v = u - CVT_T13, e = v >> 7, tn = (v >> 3) & 15, tk = v & 7; stg<u32x4>(F.W2e + (size_t)e * 1024 * 512 + (size_t)(tn * 64 + nn) * DEXP + tk * 64 + ks * 8, w); }
    }
}

__device__ __forceinline__ void phase_prologue(const Params& p, const Frame& F) {
    LAS float* sv = (LAS float*)(F.lds + 32768);
    for (int i = F.tid; i < 3 * DM; i += 512) { const float v = i < 2 * DM ? p.c[i] : p.c_ctx[i - 2 * DM]; sv[i] = siluf(v); }
    __syncthreads();
    for (int it = F.bid * 512 + F.tid; it < DEPTH * 8 * 6144; it += F.G * 512) {
        const int n = it % 6144, ks = (it / 6144) & 7, l = it / (6144 * 8);
        const float* w = p.w_ada + ((size_t)l * DM + ks * 128) * 6144 + n;
        float a0 = 0.f, a1 = 0.f, a2 = 0.f;
#pragma unroll 8
        for (int k = 0; k < 128; ++k) { const float wv = w[(size_t)k * 6144]; a0 += sv[ks * 128 + k] * wv; a1 += sv[DM + ks * 128 + k] * wv; a2 += sv[2 * DM + ks * 128 + k] * wv; }
        float* o = F.modp + ((size_t)(l * 8 + ks) * 3) * 6144 + n; o[0] = a0; o[6144] = a1; o[2 * 6144] = a2;
    }
    for (int it = F.bid * 512 + F.tid; it < 256 * 24; it += F.G * 512) {
        const int idx = it / 24, f = it % 24; const bool ret = f >= 8; const int fi = ret ? f - 8 : f, nf = ret ? 16 : 8;
        const double freq = exp2(-(double)fi / (double)nf * 13.287712379549449);
        double ang = (double)idx * freq; const double k = rint(ang * 0.15915494309189535); ang = ang - k * 6.283185307179586 ;
        const float a = (float)ang; const float cs = cosf(a), sn = sinf(a);
        float* rp = F.rope + idx * 48;
        if (ret) { rp[16 + fi] = cs; rp[32 + fi] = sn; } else { rp[fi] = cs; rp[8 + fi] = sn; }
    }
    for (size_t i = (size_t)F.bid * 512 + F.tid; i < (size_t)TL * DM / 4; i += (size_t)F.G * 512) ((f32x4*)p.out)[i] = ((const f32x4*)p.x)[i];
    for (size_t i = (size_t)F.bid * 512 + F.tid; i < (size_t)TC * DM / 4; i += (size_t)F.G * 512) ((f32x4*)F.xc)[i] = ((const f32x4*)p.ctx)[i];
    convert_small_weights(p, F, 0);
}
__device__ __forceinline__ void phase_mods(const Params& p, const Frame& F) {
    for (int it = F.bid * 512 + F.tid; it < DEPTH * 3 * 6144; it += F.G * 512) {
        const int n = it % 6144, v = (it / 6144) % 3, l = it / (3 * 6144);
        float a = p.b_ada[l * 6144 + n];
#pragma unroll
        for (int ks = 0; ks < 8; ++ks) a += F.modp[((size_t)(l * 8 + ks) * 3 + v) * 6144 + n];
        F.mods[it] = a;
    }
}
__device__ __forceinline__ void phase_modulate(const Params& p, const Frame& F, int l, int shift_idx) {
    for (int row = F.bid * 8 + F.wave; row < TT; row += F.G * 8) {
        const float* xr = xrow(p, F, row); const float* md = F.mods + ((size_t)l * 3 + msel_of(row)) * 6144;
#pragma unroll
        for (int j = 0; j < 4; ++j) { const int c = j * 256 + F.lane * 4; const f32x4 xv = ldg<f32x4>(xr + c), sh = ldg<f32x4>(md + shift_idx * DM + c), sc = ldg<f32x4>(md + (shift_idx + 1) * DM + c);
            const f32x4 h = xv * (sc + 1.0f) + sh; u32x2 w; w.x = cvt_pk(h[0], h[1]); w.y = cvt_pk(h[2], h[3]); stg<u32x2>(F.H + (size_t)row * DM + c, w); }
    }
}

struct TokTile { int r0, b, isctx, pos0, kidx0, pF0, n; };
constexpr int NU_LAT = TL / 32, NU_POST = NU_LAT + TC / 2;
constexpr int PT = 32;
__device__ __forceinline__ TokTile tok_tile(int u) {
    TokTile t;
    if (u < NU_LAT) { t.r0 = u * PT; t.isctx = 0; t.b = t.r0 >> 14; t.pos0 = t.r0 & (SEQ - 1); t.kidx0 = t.pos0; t.pF0 = CTXL + t.pos0; t.n = PT; }
    else { const int c0 = (u - NU_LAT) * 2; t.r0 = TL + c0; t.isctx = 1; t.b = c0 >> 8; t.pos0 = c0 & 255; t.kidx0 = SEQ + t.pos0; t.pF0 = t.pos0; t.n = 2; }
    return t;
}
constexpr int VT_PITCH = 68;
__device__ __forceinline__ void vt_writeout(const Frame& F, bf16_t* dst_b  , int kidx0, int n) {
    const LAS bf16_t* vt = (const LAS bf16_t*)F.lds;
    if (n == PT) {
        for (int idx = F.tid; idx < 384 * (PT / 4); idx += 512) { const int col = idx / (PT / 4), seg = idx % (PT / 4);
            const u32x2 w = *(const LAS u32x2*)(vt + col * VT_PITCH + seg * 4);
            stg<u32x2>(dst_b + (size_t)col * SK + kidx0 + seg * 4, w); }
    } else {
        for (int col = F.tid; col < 384; col += 512) stg<unsigned>(dst_b + (size_t)col * SK + kidx0, *(const LAS unsigned*)(vt + col * VT_PITCH));
    }
}
__device__ __forceinline__ void phase_post1(const Params& p, const Frame& F, int l) {
    LAS bf16_t* vt = (LAS bf16_t*)F.lds;
    LAS unsigned* lmax = (LAS unsigned*)(F.lds + 65536);
    const int lane = F.lane;
    for (int u = F.bid; u < NU_POST; u += F.G) {
        const TokTile tt = tok_tile(u);
        float kmx[3] = {0.f, 0.f, 0.f};
        if (F.tid < 12) lmax[F.tid] = 0u;
        __syncthreads();
        unsigned wqS[PT / 8][3], wkS[PT / 8][3], wvS[PT / 8][3], wrqS[PT / 8][2], wrkS[PT / 8][2]; float csaS[PT / 8][3], snaS[PT / 8][3], csrS[PT / 8][2], snrS[PT / 8][2];
#pragma unroll
        for (int i = 0; i < PT / 8; ++i) {
            const int tok = F.wave * (PT / 8) + i, row = tt.r0 + tok, pos = tt.pos0 + tok;
#pragma unroll
            for (int j = 0; j < 3; ++j) { wqS[i][j] = 0u; wkS[i][j] = 0u; wvS[i][j] = 0u; csaS[i][j] = 0.f; snaS[i][j] = 0.f; }
#pragma unroll
            for (int j = 0; j < 2; ++j) { wrqS[i][j] = 0u; wrkS[i][j] = 0u; csrS[i][j] = 0.f; snrS[i][j] = 0.f; }
            if (tok < tt.n) {
                const bf16_t* z = F.Z + (size_t)row * NINP;
                const float* rr = F.rope + (pos >> 6) * 48; const float* rc = F.rope + (pos & 63) * 48;
#pragma unroll
                for (int j = 0; j < 3; ++j) { const int pr = lane + 64 * j, i16 = pr & 15; const float* rp = (i16 < 8) ? rr : rc;
                    wqS[i][j] = ldg<unsigned>(z + ZC_DAQ + 2 * pr); wkS[i][j] = ldg<unsigned>(z + ZC_DAK + 2 * pr); wvS[i][j] = ldg<unsigned>(z + ZC_DAV + 2 * lane + 128 * j);
                    csaS[i][j] = ldgf(rp + (i16 & 7)); snaS[i][j] = ldgf(rp + 8 + (i16 & 7)); }
#pragma unroll
                for (int j = 0; j < 2; ++j) { const int pr = lane + 64 * j, i32 = pr & 31; const float* rp = (i32 < 16) ? rr : rc;
                    wrqS[i][j] = ldg<unsigned>(z + ZC_RQ + 2 * pr); wrkS[i][j] = ldg<unsigned>(z + ZC_RK + 2 * pr);
                    csrS[i][j] = ldgf(rp + 16 + (i32 & 15)); snrS[i][j] = ldgf(rp + 32 + (i32 & 15)); }
            }
        }
        __builtin_amdgcn_sched_barrier(0);
#pragma unroll
        for (int i = 0; i < PT / 8; ++i) {
            const int tok = F.wave * (PT / 8) + i, kidx = tt.kidx0 + tok, pF = tt.pF0 + tok;
            if (tok >= tt.n) break;
            unsigned wq[3], wk[3], wv[3], wrq[2], wrk[2]; float csa[3], sna[3], csr[2], snr[2];
#pragma unroll
            for (int j = 0; j < 3; ++j) { wq[j] = wqS[i][j]; wk[j] = wkS[i][j]; wv[j] = wvS[i][j]; csa[j] = csaS[i][j]; sna[j] = snaS[i][j]; }
#pragma unroll
            for (int j = 0; j < 2; ++j) { wrq[j] = wrqS[i][j]; wrk[j] = wrkS[i][j]; csr[j] = csrS[i][j]; snr[j] = snrS[i][j]; }
#pragma unroll
            for (int j = 0; j < 3; ++j) {
                const int pr = lane + 64 * j, hm = pr >> 4, i16 = pr & 15;
                const float cs = tt.isctx ? 1.f : csa[j], sn = tt.isctx ? 0.f : sna[j];
                const size_t o = ((size_t)(tt.b * 12 + hm) * SK + kidx) * 32 + 2 * i16;
                { const unsigned w = wq[j]; const float x1 = bflo(w) * C2_DA, x2 = bfhi(w) * C2_DA;
                  stg<unsigned>(F.QFDA + o, cvt_pk(x1, x2));
                  stg<unsigned>(F.QRDA + o, cvt_pk(x1 * cs - x2 * sn, x1 * sn + x2 * cs));
                  const float n2 = rsum16(x1 * x1 + x2 * x2);
                  if (i16 == 0) stg<float>(F.qn_da + (size_t)(tt.b * 12 + hm) * SK + kidx, sqrtf(n2)); }
                { const unsigned w = wk[j]; const float x1 = bflo(w), x2 = bfhi(w);
                  stg<unsigned>(F.KDA + o, cvt_pk(x1 * cs - x2 * sn, x1 * sn + x2 * cs));
                  const float n2 = rsum16(x1 * x1 + x2 * x2);
                  kmx[j] = fmaxf(kmx[j], n2); }
            }
#pragma unroll
            for (int j = 0; j < 3; ++j) { const int col = 2 * lane + 128 * j; const unsigned w = wv[j];
                vt[col * VT_PITCH + tok] = (bf16_t)(w & 0xffffu); vt[(col + 1) * VT_PITCH + tok] = (bf16_t)(w >> 16); }
#pragma unroll
            for (int j = 0; j < 2; ++j) {
                const int pr = lane + 64 * j, h = pr >> 5, i32 = pr & 31;
                const float cs = tt.isctx ? 1.f : csr[j], sn = tt.isctx ? 0.f : snr[j];
                const size_t o = ((size_t)(tt.b * 4 + h) * SK + pF) * 64 + 2 * i32;
                { const unsigned w = wrq[j]; const float x1 = bflo(w), x2 = bfhi(w);
                  stg<unsigned>(F.retq + o, cvt_pk(x1 * cs - x2 * sn, x1 * sn + x2 * cs)); }
                { const unsigned w = wrk[j]; const float x1 = bflo(w) * 0.125f, x2 = bfhi(w) * 0.125f;
                  stg<unsigned>(F.retk + o, cvt_pk(x1 * cs - x2 * sn, x1 * sn + x2 * cs)); }
            }
        }
        if ((lane & 15) == 0) {
#pragma unroll
            for (int j = 0; j < 3; ++j) __hip_atomic_fetch_max(lmax + ((lane + 64 * j) >> 4), __float_as_uint(kmx[j]), __ATOMIC_RELAXED, __HIP_MEMORY_SCOPE_WORKGROUP);
        }
        __syncthreads();
        if (F.tid < 12) atomicMax(F.kmax_da + l * 24 + tt.b * 12 + F.tid, lmax[F.tid]);
        vt_writeout(F, F.VTDA + (size_t)tt.b * 384 * SK, tt.kidx0, tt.n);
    }
}

__device__ __forceinline__ void phase_post2(const Params& p, const Frame& F, int l) {
    LAS bf16_t* vt = (LAS bf16_t*)F.lds;
    LAS unsigned* lmax = (LAS unsigned*)(F.lds + 65536);
    const int lane = F.lane;
    for (int u = F.bid; u < NU_POST; u += F.G) {
        const TokTile tt = tok_tile(u);
        float kmx[6] = {0.f, 0.f, 0.f, 0.f, 0.f, 0.f};
        if (F.tid < 6) lmax[F.tid] = 0u;
        __syncthreads();
        u32x2 wcqS[PT / 8]; unsigned wckvS[PT / 8], wqS[PT / 8][5], wknS[PT / 8][3], wvvS[PT / 8][3], wpeS[PT / 8]; float csqS[PT / 8][5], snqS[PT / 8][5], cspeS[PT / 8], snpeS[PT / 8];
#pragma unroll
        for (int i = 0; i < PT / 8; ++i) {
            const int tok = F.wave * (PT / 8) + i, row = tt.r0 + tok, pos = tt.pos0 + tok;
            wcqS[i] = (u32x2){0u, 0u}; wckvS[i] = 0u; wpeS[i] = 0u; cspeS[i] = 0.f; snpeS[i] = 0.f;
#pragma unroll
            for (int j = 0; j < 5; ++j) { wqS[i][j] = 0u; csqS[i][j] = 0.f; snqS[i][j] = 0.f; }
#pragma unroll
            for (int j = 0; j < 3; ++j) { wknS[i][j] = 0u; wvvS[i][j] = 0u; }
            if (tok < tt.n) {
                const bf16_t* z = F.Z + (size_t)row * NINP; const bf16_t* z2 = F.Z2 + (size_t)row * N2P;
                const float* rr = F.rope + (pos >> 6) * 48; const float* rc = F.rope + (pos & 63) * 48;
                wcqS[i] = ldg<u32x2>(z + ZC_CQ + 4 * lane); wckvS[i] = ldg<unsigned>(z + ZC_CKV + 2 * lane);
#pragma unroll
                for (int j = 0; j < 5; ++j) { const int pr = lane + 64 * j; wqS[i][j] = (pr < 288) ? ldg<unsigned>(z2 + 2 * pr) : 0u; }
#pragma unroll
                for (int j = 0; j < 3; ++j) { const int pr = lane + 64 * j, h = pr >> 5, i32 = pr & 31; wknS[i][j] = ldg<unsigned>(z2 + KVC0 + h * 128 + 2 * i32); wvvS[i][j] = ldg<unsigned>(z2 + KVC0 + h * 128 + 64 + 2 * i32); }
                wpeS[i] = ldg<unsigned>(z + ZC_KPE + 2 * (lane & 15));
#pragma unroll
                for (int j = 0; j < 5; ++j) { const int pr = lane + 64 * j, i48 = pr % 48, i16 = (i48 - 32) & 15; const float* rp = (i16 < 8) ? rr : rc; csqS[i][j] = ldgf(rp + (i16 & 7)); snqS[i][j] = ldgf(rp + 8 + (i16 & 7)); }
                { const int i16 = lane & 15; const float* rp = (i16 < 8) ? rr : rc; cspeS[i] = ldgf(rp + (i16 & 7)); snpeS[i] = ldgf(rp + 8 + (i16 & 7)); }
            }
        }
        __builtin_amdgcn_sched_barrier(0);
#pragma unroll
        for (int i = 0; i < PT / 8; ++i) {
            const int tok = F.wave * (PT / 8) + i, kidx = tt.kidx0 + tok;
            if (tok >= tt.n) break;
            const u32x2 wcq = wcqS[i]; const unsigned wckv = wckvS[i], wpe = wpeS[i]; const float cspe = cspeS[i], snpe = snpeS[i];
            unsigned wq[5], wkn[3], wvv[3]; float csq[5], snq[5];
#pragma unroll
            for (int j = 0; j < 5; ++j) { wq[j] = wqS[i][j]; csq[j] = csqS[i][j]; snq[j] = snqS[i][j]; }
#pragma unroll
            for (int j = 0; j < 3; ++j) { wkn[j] = wknS[i][j]; wvv[j] = wvvS[i][j]; }
            float rinv_q, rinv_kv;
            { const float a = bflo(wcq.x), b = bfhi(wcq.x), c = bflo(wcq.y), d = bfhi(wcq.y);
              rinv_q = rsqrtf(wsum(a * a + b * b + c * c + d * d) * (1.0f / 256.0f) + 1e-6f); }
            { const float a = bflo(wckv), b = bfhi(wckv);
              rinv_kv = rsqrtf(wsum(a * a + b * b) * (1.0f / 128.0f) + 1e-6f); }
            float qs[6] = {0.f, 0.f, 0.f, 0.f, 0.f, 0.f};
#pragma unroll
            for (int j = 0; j < 5; ++j) {
                const int pr = lane + 64 * j;
                if (pr < 288) {
                    const int h = pr / 48, i48 = pr - h * 48;
                    const unsigned w = wq[j]; const float x1 = bflo(w) * rinv_q, x2 = bfhi(w) * rinv_q;
                    const size_t qo = ((size_t)(tt.b * 6 + h) * SK + kidx);
                    if (i48 < 32) stg<unsigned>(F.QRMLA + qo * 96 + 2 * i48, cvt_pk(x1, x2));
                    else { const int i16 = i48 - 32; const float cs = tt.isctx ? 1.f : csq[j], sn = tt.isctx ? 0.f : snq[j];
                        stg<unsigned>(F.QPE + qo * 32 + 2 * i16, cvt_pk(x1, x2));
                        stg<unsigned>(F.QRMLA + qo * 96 + 64 + 2 * i16, cvt_pk(x1 * cs - x2 * sn, x1 * sn + x2 * cs)); }
                    const float n2 = x1 * x1 + x2 * x2;
#pragma unroll
                    for (int hh = 0; hh < 6; ++hh) qs[hh] += (h == hh) ? n2 : 0.f;
                }
            }
#pragma unroll
            for (int hh = 0; hh < 6; ++hh) { const float s = wsum(qs[hh]); if (lane == hh) stg<float>(F.qn_mla + (size_t)(tt.b * 6 + hh) * SK + kidx, sqrtf(s)); }
            float pe2 = 0.f;
            { const int i16 = lane & 15; const unsigned w = wpe; const float x1 = bflo(w), x2 = bfhi(w);
              const float cs = tt.isctx ? 1.f : cspe, sn = tt.isctx ? 0.f : snpe;
              const unsigned pk = cvt_pk(x1 * cs - x2 * sn, x1 * sn + x2 * cs);
              if (lane < 16) {
#pragma unroll
                  for (int h = 0; h < 6; ++h) stg<unsigned>(F.KMLA + ((size_t)(tt.b * 6 + h) * SK + kidx) * 96 + 64 + 2 * i16, pk); }
              pe2 = rsum16(x1 * x1 + x2 * x2); }
#pragma unroll
            for (int j = 0; j < 3; ++j) {
                const int pr = lane + 64 * j, h = pr >> 5, i32 = pr & 31;
                const unsigned w = wkn[j]; const float x1 = bflo(w) * rinv_kv, x2 = bfhi(w) * rinv_kv;
                stg<unsigned>(F.KMLA + ((size_t)(tt.b * 6 + h) * SK + kidx) * 96 + 2 * i32, cvt_pk(x1, x2));
                const float n2 = add_xor16(rsum16(x1 * x1 + x2 * x2));
                kmx[2 * j] = fmaxf(kmx[2 * j], (lane < 32) ? n2 + pe2 : 0.f); kmx[2 * j + 1] = fmaxf(kmx[2 * j + 1], (lane >= 32) ? n2 + pe2 : 0.f);
                const unsigned wv = wvv[j];
                const unsigned pv = cvt_pk(bflo(wv) * rinv_kv, bfhi(wv) * rinv_kv);
                const int col = h * 64 + 2 * i32;
                vt[col * VT_PITCH + tok] = (bf16_t)(pv & 0xffffu); vt[(col + 1) * VT_PITCH + tok] = (bf16_t)(pv >> 16);
            }
        }
        if (lane == 0 || lane == 32) {
#pragma unroll
            for (int j = 0; j < 3; ++j) { const int h = 2 * j + (lane >> 5); __hip_atomic_fetch_max(lmax + h, __float_as_uint(lane == 0 ? kmx[2 * j] : kmx[2 * j + 1]), __ATOMIC_RELAXED, __HIP_MEMORY_SCOPE_WORKGROUP); }
        }
        __syncthreads();
        if (F.tid < 6) atomicMax(F.kmax_mla + l * 12 + tt.b * 6 + F.tid, lmax[F.tid]);
        vt_writeout(F, F.VTMLA + (size_t)tt.b * 384 * SK, tt.kidx0, tt.n);
    }
}

#define MFMA32(a, b, c) __builtin_amdgcn_mfma_f32_32x32x16_bf16(a, b, c, 0, 0, 0)
struct AttnArgs {
    const bf16_t *qr0, *qr1, *qf0, *qf1;
    const bf16_t* qpe;
    const bf16_t *k0, *k1;
    const bf16_t* vt;
    const float *qn0, *qn1; float kmax0, kmax1;
    int q0, t0, t1;
    bf16_t* y; int yrow0;
    float lam, post; const float* subg;
};
template <int DQK, bool DA>
__device__ __forceinline__ void attn_item(const Frame& F, const AttnArgs& A) {
    constexpr int NST = DQK / 16, NKC = DQK / 8, KREG = NKC * 2048, BUFB = KREG + 16384, NKL = NKC / 4;
    const int tid = F.tid, lane = F.lane, r = lane & 31, hh = lane >> 5, wave = F.wave;
    const int qk = A.q0 + wave * 32 + r;
    const int kkey = tid & 127, kch0 = tid >> 7;
    unsigned voffb[2];
#pragma unroll
    for (int j = 0; j < 2; ++j) { const int item = tid + 512 * j, vd = item >> 4, c = (item & 15) ^ (vd & 15); voffb[j] = (unsigned)(vd * SK + c * 8) * 2u; }
    const int kl0 = hh * 2048 + pi32(r) * 16;
    const int vl0 = r * 256, vsw = r & 15;
    unsigned o0p[16];
#pragma unroll
    for (int i = 0; i < 16; ++i) o0p[i] = 0u;
    f32x16 O[2]; float inv = 0.f;
#pragma nounroll
    for (int m = 0; m < (DA ? 2 : 1); ++m) {
        const bf16_t* qrp = (DA && m) ? A.qr1 : A.qr0; const bf16_t* qfp = (DA && m) ? A.qf1 : A.qf0;
        const char* kbase = (const char*)((DA && m) ? A.k1 : A.k0);
        const float bound = ldgf(((DA && m) ? A.qn1 : A.qn0) + qk) * ((DA && m) ? A.kmax1 : A.kmax0);
        f32x16 cinit;
#pragma unroll
        for (int i = 0; i < 16; ++i) { cinit[i] = -bound; O[0][i] = 0.f; O[1][i] = 0.f; }
        float lsum = 0.f;
        constexpr bool LSUM_MFMA = false;
        const bf16x8 ones8 = __builtin_bit_cast(bf16x8, (u32x4){0x3F803F80u, 0x3F803F80u, 0x3F803F80u, 0x3F803F80u});
        f32x16 Lacc;
#pragma unroll
        for (int i = 0; i < 16; ++i) Lacc[i] = 0.f;
        bf16x8 qf[NST];
        const unsigned kdma = (unsigned)((kch0) * 2048 + (kkey & 64) * 16);
        const unsigned vdma = (unsigned)(KREG + (tid & ~63) * 16);
#define ATT_LOADG(t, bsel) do { LAS unsigned char* db_ = F.lds + (bsel) * BUFB; \
            _Pragma("unroll") for (int j_ = 0; j_ < NKL; ++j_) __builtin_amdgcn_global_load_lds((const unsigned*)(kbase + (size_t)(t) * (128 * DQK * 2) + (unsigned)(kkey * DQK + (kch0 + 4 * j_) * 8) * 2u), \
                (LAS unsigned*)(db_ + __builtin_amdgcn_readfirstlane(kdma) + j_ * 8192), 16, 0, 0); \
            _Pragma("unroll") for (int j_ = 0; j_ < 2; ++j_) __builtin_amdgcn_global_load_lds((const unsigned*)((const char*)A.vt + (size_t)(t) * 256 + voffb[j_]), \
                (LAS unsigned*)(db_ + __builtin_amdgcn_readfirstlane(vdma) + j_ * 8192), 16, 0, 0); } while (0)
        bf16x8 kf[NST], vf[2][4]; f32x16 sv[2]; u32x4 pb[2][2];
#pragma unroll
        for (int i = 0; i < 4; ++i) vf[1][i] = __builtin_bit_cast(bf16x8, (u32x4){0u, 0u, 0u, 0u});
        pb[1][0] = (u32x4){0u, 0u, 0u, 0u}; pb[1][1] = pb[1][0];
        __syncthreads();
        ATT_LOADG(A.t0, 0);
        int t = A.t0;
#pragma nounroll
        for (int seg = 0; seg < 2; ++seg) {
            const int tend = (seg == 0) ? (A.t1 < 128 ? A.t1 : 128) : A.t1;
            if (t >= tend) continue;
#pragma unroll
            for (int st = 0; st < NST; ++st) {
                const bf16_t* src;
                if (DQK == 32) src = (seg ? qfp : qrp) + (size_t)qk * 32 + st * 16 + hh * 8;
                else src = (seg && st >= 4) ? A.qpe + (size_t)qk * 32 + (st - 4) * 16 + hh * 8 : qrp + (size_t)qk * 96 + st * 16 + hh * 8;
                qf[st] = __builtin_bit_cast(bf16x8, ldg16(src)); }
#pragma unroll
            for (int st = 0; st < NST; ++st) asm volatile("" : "+v"(qf[st]));
        for (; t < tend; ++t) {
            const int bsel = (t - A.t0) & 1;
            LAS unsigned char* buf = F.lds + bsel * BUFB;
            asm volatile("s_waitcnt vmcnt(0)" ::: "memory");
            __syncthreads();
#define ATT_RK(j) do { _Pragma("unroll") for (int st_ = 0; st_ < NST; ++st_) kf[st_] = *(const LAS bf16x8*)(buf + st_ * 4096 + kl0 + (j) * 512); } while (0)
#define ATT_RV(j, set) do { _Pragma("unroll") for (int vt_ = 0; vt_ < 2; ++vt_) _Pragma("unroll") for (int s2_ = 0; s2_ < 2; ++s2_) \
                vf[set][vt_ * 2 + s2_] = *(const LAS bf16x8*)(buf + KREG + vt_ * 8192 + vl0 + (((4 * (j) + 2 * s2_ + hh) ^ vsw) << 4)); } while (0)
#define ATT_S(set) do { sv[set] = cinit; _Pragma("unroll") for (int st_ = 0; st_ < NST; ++st_) sv[set] = MFMA32(kf[st_], qf[st_], sv[set]); } while (0)
#define ATT_PV(set, vset) do { _Pragma("unroll") for (int vt_ = 0; vt_ < 2; ++vt_) _Pragma("unroll") for (int s2_ = 0; s2_ < 2; ++s2_) \
                O[vt_] = MFMA32(vf[vset][vt_ * 2 + s2_], __builtin_bit_cast(bf16x8, pb[set][s2_]), O[vt_]); \
                if (LSUM_MFMA) { _Pragma("unroll") for (int s2_ = 0; s2_ < 2; ++s2_) Lacc = MFMA32(ones8, __builtin_bit_cast(bf16x8, pb[set][s2_]), Lacc); } } while (0)
#define ATT_EXP(set) do { float ls_ = 0.f; _Pragma("unroll") for (int i_ = 0; i_ < 16; ++i_) { sv[set][i_] = __builtin_amdgcn_exp2f(sv[set][i_]); if (!LSUM_MFMA) ls_ += sv[set][i_]; } lsum += ls_; \
                pb[set][0] = (u32x4){cvt_pk(sv[set][0], sv[set][1]), cvt_pk(sv[set][2], sv[set][3]), cvt_pk(sv[set][4], sv[set][5]), cvt_pk(sv[set][6], sv[set][7])}; \
                pb[set][1] = (u32x4){cvt_pk(sv[set][8], sv[set][9]), cvt_pk(sv[set][10], sv[set][11]), cvt_pk(sv[set][12], sv[set][13]), cvt_pk(sv[set][14], sv[set][15])}; } while (0)
            ATT_RK(0);
#pragma unroll
            for (int vt_ = 0; vt_ < 2; ++vt_)
#pragma unroll
                for (int s2_ = 0; s2_ < 2; ++s2_) { O[vt_] = MFMA32(vf[1][vt_ * 2 + s2_], __builtin_bit_cast(bf16x8, pb[1][s2_]), O[vt_]); asm volatile("" : "+v"(O[vt_])); }
#pragma unroll
            for (int st_ = 0; st_ < NST; ++st_) { sv[0] = MFMA32(kf[st_], qf[st_], st_ == 0 ? cinit : sv[0]); asm volatile("" : "+v"(sv[0])); kf[st_] = *(const LAS bf16x8*)(buf + st_ * 4096 + kl0 + 512); }
            __builtin_amdgcn_sched_barrier(0);
            if (t + 1 < A.t1) ATT_LOADG(t + 1, bsel ^ 1);
            __builtin_amdgcn_sched_barrier(0);
            static_assert(NST == 6 || NST == 2, "attn_item slot schedule");
#define ME_(i_) sv[se_][i_] = __builtin_amdgcn_exp2f(sv[se_][i_])
#define MA_(i_) ls_ += sv[se_][i_]
#define MC_(k_) pw_[k_] = cvt_pk(sv[se_][2 * (k_)], sv[se_][2 * (k_) + 1])
#define MGEND_() do { asm volatile("" : "+v"(sv[se_]), "+v"(ls_)); __builtin_amdgcn_sched_barrier(0); } while (0)
#define MS_(st_) do { if (j + 1 < 4 && (st_) < NST) { sv[so_] = MFMA32(kf[st_], qf[st_], (st_) == 0 ? cinit : sv[so_]); asm volatile("" : "+v"(sv[so_])); \
                    if (j + 2 < 4) kf[st_] = *(const LAS bf16x8*)(buf + (st_) * 4096 + kl0 + (j + 2) * 512); } } while (0)
#define MP_(vt_, s2_) do { if (j >= 1) { O[vt_] = MFMA32(vf[0][(vt_) * 2 + (s2_)], __builtin_bit_cast(bf16x8, pb[so_][s2_]), O[vt_]); asm volatile("" : "+v"(O[vt_])); } } while (0)
#pragma unroll
            for (int j = 0; j < 4; ++j) {
                const int se_ = j & 1, so_ = se_ ^ 1;
                if (j >= 1) ATT_RV(j - 1, 0);
                float ls_ = 0.f; unsigned pw_[8];
                MS_(0);       ME_(0); ME_(1); MGEND_();
                MP_(0, 0);    ME_(2); ME_(3); MA_(0); MA_(1); MGEND_();
                MS_(1);       ME_(4); ME_(5); MA_(2); MA_(3); MC_(0); asm volatile("" : "+v"(pw_[0])); MGEND_();
                MP_(1, 0);    ME_(6); ME_(7); MA_(4); MA_(5); MC_(1); asm volatile("" : "+v"(pw_[1])); MGEND_();
                MS_(2);       ME_(8); ME_(9); MA_(6); MA_(7); MC_(2); asm volatile("" : "+v"(pw_[2])); MGEND_();
                MP_(0, 1);    ME_(10); ME_(11); MA_(8); MA_(9); MC_(3); asm volatile("" : "+v"(pw_[3])); MGEND_();
                MS_(3);       ME_(12); ME_(13); MA_(10); MA_(11); MC_(4); asm volatile("" : "+v"(pw_[4])); MGEND_();
                MP_(1, 1);    ME_(14); ME_(15); MA_(12); MA_(13); MC_(5); asm volatile("" : "+v"(pw_[5])); MGEND_();
                MS_(4);       MA_(14); MC_(6); asm volatile("" : "+v"(pw_[6])); MGEND_();
                MS_(5);       MA_(15); MC_(7);
                lsum += ls_; pb[se_][0] = (u32x4){pw_[0], pw_[1], pw_[2], pw_[3]}; pb[se_][1] = (u32x4){pw_[4], pw_[5], pw_[6], pw_[7]};
                asm volatile("" : "+v"(pb[se_][0]), "+v"(pb[se_][1]), "+v"(lsum));
                __builtin_amdgcn_sched_barrier(0);
            }
#undef MP_
#undef MS_
#undef MGEND_
#undef MC_
#undef MA_
#undef ME_
            ATT_RV(3, 1);
#undef ATT_RK
#undef ATT_RV
#undef ATT_S
#undef ATT_PV
#undef ATT_EXP
        }
        }
#undef ATT_LOADG
#pragma unroll
        for (int vt_ = 0; vt_ < 2; ++vt_)
#pragma unroll
            for (int s2_ = 0; s2_ < 2; ++s2_) O[vt_] = MFMA32(vf[1][vt_ * 2 + s2_], __builtin_bit_cast(bf16x8, pb[1][s2_]), O[vt_]);
        inv = LSUM_MFMA ? 1.0f / Lacc[0] : 1.0f / add_xor32(lsum);
        if (DA && m == 0) {
#pragma unroll
            for (int i = 0; i < 8; ++i) { o0p[i] = cvt_pk(O[0][2 * i] * inv, O[0][2 * i + 1] * inv); o0p[8 + i] = cvt_pk(O[1][2 * i] * inv, O[1][2 * i + 1] * inv); }
        }
    }
    bf16_t* yrow = A.y + (size_t)(A.yrow0 + wave * 32 + r) * DM;
    if (DA) {
        float ss = 0.f;
#pragma unroll
        for (int vt = 0; vt < 2; ++vt)
#pragma unroll
            for (int i = 0; i < 16; ++i) { const unsigned w = o0p[vt * 8 + (i >> 1)]; const float o0 = (i & 1) ? bfhi(w) : bflo(w);
                const float o = o0 - A.lam * (O[vt][i] * inv); O[vt][i] = o; ss += o * o; }
        ss = add_xor32(ss);
        const float rs = rsqrtf(ss * (1.0f / 64.0f) + 1e-6f) * A.post;
#pragma unroll
        for (int vt = 0; vt < 2; ++vt)
#pragma unroll
            for (int g = 0; g < 4; ++g) { const int vd = vt * 32 + 8 * g + 4 * hh; const f32x4 sg = *(const f32x4*)(A.subg + vd);
                u32x2 w; w.x = cvt_pk(O[vt][4 * g] * rs * sg[0], O[vt][4 * g + 1] * rs * sg[1]); w.y = cvt_pk(O[vt][4 * g + 2] * rs * sg[2], O[vt][4 * g + 3] * rs * sg[3]);
                *(u32x2*)(yrow + vd) = w; }
    } else {
#pragma unroll
        for (int vt = 0; vt < 2; ++vt)
#pragma unroll
            for (int g = 0; g < 4; ++g) { const int vd = vt * 32 + 8 * g + 4 * hh;
                u32x2 w; w.x = cvt_pk(O[vt][4 * g] * inv, O[vt][4 * g + 1] * inv); w.y = cvt_pk(O[vt][4 * g + 2] * inv, O[vt][4 * g + 3] * inv);
                *(u32x2*)(yrow + vd) = w; }
    }
}

__device__ __forceinline__ void attn_item_da2(const Frame& F, const AttnArgs& A) {
    constexpr int KMAP = 8192, KREG = 2 * KMAP, BUFB = KREG + 16384;
    const int tid = F.tid, lane = F.lane, r = lane & 31, hh = lane >> 5, wave = F.wave;
    const int qk = A.q0 + wave * 32 + r;
    const int kkey = tid & 127, kch0 = (tid >> 7) & 1, km = wave >> 2;
    const char* kbase = (const char*)(km ? A.k1 : A.k0);
    const unsigned kdma = (unsigned)(km * KMAP + kch0 * 2048 + (kkey & 64) * 16);
    const unsigned vdma = (unsigned)(KREG + (tid & ~63) * 16);
    unsigned voffb[2];
#pragma unroll
    for (int j = 0; j < 2; ++j) { const int item = tid + 512 * j, vd = item >> 4, c = (item & 15) ^ (vd & 15); voffb[j] = (unsigned)(vd * SK + c * 8) * 2u; }
#define DA2_LOADG(t, bsel) do { LAS unsigned char* db_ = F.lds + (bsel) * BUFB; \
        _Pragma("unroll") for (int j_ = 0; j_ < 2; ++j_) __builtin_amdgcn_global_load_lds((const unsigned*)(kbase + (size_t)(t) * (128 * 32 * 2) + (unsigned)(kkey * 32 + (kch0 + 2 * j_) * 8) * 2u), \
            (LAS unsigned*)(db_ + __builtin_amdgcn_readfirstlane(kdma) + j_ * 4096), 16, 0, 0); \
        _Pragma("unroll") for (int j_ = 0; j_ < 2; ++j_) __builtin_amdgcn_global_load_lds((const unsigned*)((const char*)A.vt + (size_t)(t) * 256 + voffb[j_]), \
            (LAS unsigned*)(db_ + __builtin_amdgcn_readfirstlane(vdma) + j_ * 8192), 16, 0, 0); } while (0)
    const int kl0 = hh * 2048 + pi32(r) * 16;
    const int vl0 = r * 256, vsw = r & 15;
    f32x16 cinit; f32x16 O[2][2]; float lsum[2] = {0.f, 0.f};
    { const float bound = fmaxf(ldgf(A.qn0 + qk) * A.kmax0, ldgf(A.qn1 + qk) * A.kmax1);
#pragma unroll
      for (int i = 0; i < 16; ++i) { cinit[i] = -bound; O[0][0][i] = 0.f; O[0][1][i] = 0.f; O[1][0][i] = 0.f; O[1][1][i] = 0.f; } }
    bf16x8 qf[2][2];
    bf16x8 kf[2], vf[4]; f32x16 sv[2]; u32x4 pb[2][2];
#pragma unroll
    for (int i = 0; i < 4; ++i) vf[i] = __builtin_bit_cast(bf16x8, (u32x4){0u, 0u, 0u, 0u});
    pb[1][0] = (u32x4){0u, 0u, 0u, 0u}; pb[1][1] = pb[1][0];
#pragma unroll
    for (int i = 0; i < 16; ++i) sv[1][i] = -1.0e30f;
    int vlo[2]; vlo[0] = vl0 + ((hh ^ (r & 3)) << 4); vlo[1] = vl0 + (((2 + hh) ^ (r & 3)) << 4);
    const int vq = (r >> 2) & 3;
    __syncthreads();
    DA2_LOADG(A.t0, 0);
    int t = A.t0;
#pragma nounroll
    for (int seg = 0; seg < 2; ++seg) {
        const int tend = (seg == 0) ? (A.t1 < 128 ? A.t1 : 128) : A.t1;
        if (t >= tend) continue;
#pragma unroll
        for (int m = 0; m < 2; ++m)
#pragma unroll
            for (int st = 0; st < 2; ++st) { const bf16_t* qa = (m == 0) ? A.qr0 : A.qr1; const bf16_t* qb = (m == 0) ? A.qf0 : A.qf1;
                qf[m][st] = __builtin_bit_cast(bf16x8, ldg16((seg ? qb : qa) + (size_t)qk * 32 + st * 16 + hh * 8)); }
#pragma unroll
        for (int m = 0; m < 2; ++m)
#pragma unroll
            for (int st = 0; st < 2; ++st) asm volatile("" : "+v"(qf[m][st]));
        for (; t < tend; ++t) {
            const int bsel = (t - A.t0) & 1;
            LAS unsigned char* buf = F.lds + bsel * BUFB;
            asm volatile("s_waitcnt vmcnt(0)" ::: "memory");
            __syncthreads();
#define DA2_RKJ(m_, jj) do { _Pragma("unroll") for (int st_ = 0; st_ < 2; ++st_) kf[st_] = *(const LAS bf16x8*)(buf + (m_) * KMAP + st_ * 4096 + kl0 + (jj) * 512); } while (0)
#define DA2_RVJ(jj) do { const int vo_ = ((jj) ^ vq) << 6; _Pragma("unroll") for (int vt_ = 0; vt_ < 2; ++vt_) _Pragma("unroll") for (int s2_ = 0; s2_ < 2; ++s2_) \
                vf[vt_ * 2 + s2_] = *(const LAS bf16x8*)(buf + KREG + vt_ * 8192 + (vlo[s2_] + vo_)); } while (0)
#define DA2_RV1(jj, idx_) do { vf[idx_] = *(const LAS bf16x8*)(buf + KREG + ((idx_) >> 1) * 8192 + (vlo[(idx_) & 1] + ((((jj)) ^ vq) << 6))); } while (0)
#define DA2_S(m_) do { sv[m_] = cinit; _Pragma("unroll") for (int st_ = 0; st_ < 2; ++st_) sv[m_] = MFMA32(kf[st_], qf[m_][st_], sv[m_]); } while (0)
#define DA2_PV(m_) do { _Pragma("unroll") for (int vt_ = 0; vt_ < 2; ++vt_) _Pragma("unroll") for (int s2_ = 0; s2_ < 2; ++s2_) \
                O[m_][vt_] = MFMA32(vf[vt_ * 2 + s2_], __builtin_bit_cast(bf16x8, pb[m_][s2_]), O[m_][vt_]); } while (0)
#define DA2_EXP(m_) do { float ls_ = 0.f; _Pragma("unroll") for (int i_ = 0; i_ < 16; ++i_) { sv[m_][i_] = __builtin_amdgcn_exp2f(sv[m_][i_]); ls_ += sv[m_][i_]; } lsum[m_] += ls_; \
                pb[m_][0] = (u32x4){cvt_pk(sv[m_][0], sv[m_][1]), cvt_pk(sv[m_][2], sv[m_][3]), cvt_pk(sv[m_][4], sv[m_][5]), cvt_pk(sv[m_][6], sv[m_][7])}; \
                pb[m_][1] = (u32x4){cvt_pk(sv[m_][8], sv[m_][9]), cvt_pk(sv[m_][10], sv[m_][11]), cvt_pk(sv[m_][12], sv[m_][13]), cvt_pk(sv[m_][14], sv[m_][15])}; } while (0)
            DA2_RKJ(0, 0);
            { float ls_ = 0.f;
              sv[0] = MFMA32(kf[0], qf[0][0], cinit); asm volatile("" : "+v"(sv[0]));
#pragma unroll
              for (int i = 8; i < 12; ++i) sv[1][i] = __builtin_amdgcn_exp2f(sv[1][i]);
              asm volatile("" : "+v"(sv[1])); __builtin_amdgcn_sched_barrier(0);
              sv[0] = MFMA32(kf[1], qf[0][1], sv[0]); asm volatile("" : "+v"(sv[0]));
#pragma unroll
              for (int i = 12; i < 16; ++i) sv[1][i] = __builtin_amdgcn_exp2f(sv[1][i]);
#pragma unroll
              for (int i = 8; i < 16; ++i) ls_ += sv[1][i];
              lsum[1] += ls_;
              pb[1][1] = (u32x4){cvt_pk(sv[1][8], sv[1][9]), cvt_pk(sv[1][10], sv[1][11]), cvt_pk(sv[1][12], sv[1][13]), cvt_pk(sv[1][14], sv[1][15])};
              asm volatile("" : "+v"(pb[1][1]), "+v"(lsum[1])); }
            DA2_RKJ(1, 0);
            __builtin_amdgcn_sched_barrier(0);
            if (t + 1 < A.t1) DA2_LOADG(t + 1, bsel ^ 1);
            __builtin_amdgcn_sched_barrier(0);
#define XE_(i_) sv[me_][i_] = __builtin_amdgcn_exp2f(sv[me_][i_])
#define XA_(i_) ls_ += sv[me_][i_]
#define XC_(k_) pw_[k_] = cvt_pk(sv[me_][2 * (k_)], sv[me_][2 * (k_) + 1])
#define GEND_() do { asm volatile("" : "+v"(sv[me_]), "+v"(ls_)); __builtin_amdgcn_sched_barrier(0); } while (0)
#define DA2_HALF(ME, MO, doS_, PRE_, MID_, VA_, VB_, VC_) do { constexpr int me_ = (ME), mo_ = (MO); PRE_; float ls_ = 0.f; unsigned pw_[8]; \
                if (doS_) { sv[mo_] = MFMA32(kf[0], qf[mo_][0], cinit); asm volatile("" : "+v"(sv[mo_])); } \
                XE_(0); XE_(1); XE_(2); GEND_(); \
                O[mo_][0] = MFMA32(vf[0], __builtin_bit_cast(bf16x8, pb[mo_][0]), O[mo_][0]); asm volatile("" : "+v"(O[mo_][0])); \
                XE_(3); XE_(4); XE_(5); XA_(0); XA_(1); XA_(2); GEND_(); \
                VA_; \
                if (doS_) { sv[mo_] = MFMA32(kf[1], qf[mo_][1], sv[mo_]); asm volatile("" : "+v"(sv[mo_])); } \
                XE_(6); XE_(7); XE_(8); XA_(3); XA_(4); XA_(5); XC_(0); asm volatile("" : "+v"(pw_[0])); GEND_(); \
                MID_; \
                O[mo_][1] = MFMA32(vf[2], __builtin_bit_cast(bf16x8, pb[mo_][0]), O[mo_][1]); asm volatile("" : "+v"(O[mo_][1])); \
                XE_(9); XE_(10); XE_(11); XA_(6); XA_(7); XA_(8); XC_(1); XC_(2); asm volatile("" : "+v"(pw_[1]), "+v"(pw_[2])); GEND_(); \
                VB_; \
                O[mo_][0] = MFMA32(vf[1], __builtin_bit_cast(bf16x8, pb[mo_][1]), O[mo_][0]); asm volatile("" : "+v"(O[mo_][0])); \
                XE_(12); XE_(13); XA_(9); XA_(10); XA_(11); XC_(3); XC_(4); asm volatile("" : "+v"(pw_[3]), "+v"(pw_[4])); GEND_(); \
                VC_; \
                O[mo_][1] = MFMA32(vf[3], __builtin_bit_cast(bf16x8, pb[mo_][1]), O[mo_][1]); asm volatile("" : "+v"(O[mo_][1])); \
                XE_(14); XE_(15); XA_(12); XA_(13); XA_(14); XA_(15); XC_(5); XC_(6); XC_(7); \
                lsum[me_] += ls_; pb[me_][0] = (u32x4){pw_[0], pw_[1], pw_[2], pw_[3]}; pb[me_][1] = (u32x4){pw_[4], pw_[5], pw_[6], pw_[7]}; \
                asm volatile("" : "+v"(pb[me_][0]), "+v"(pb[me_][1]), "+v"(lsum[me_])); __builtin_amdgcn_sched_barrier(0); } while (0)
#pragma unroll
            for (int j = 0; j < 4; ++j) {
                DA2_HALF(0, 1, true, (void)0, if (j < 3) DA2_RKJ(0, j + 1), DA2_RV1(j, 0), DA2_RV1(j, 2), DA2_RV1(j, 1));
                if (j < 3) DA2_HALF(1, 0, true, DA2_RV1(j, 3), DA2_RKJ(1, j + 1), (void)0, (void)0, (void)0);
                else { constexpr int me_ = 1; DA2_RV1(j, 3); float ls_ = 0.f; unsigned pw_[8];
                    O[0][0] = MFMA32(vf[0], __builtin_bit_cast(bf16x8, pb[0][0]), O[0][0]); asm volatile("" : "+v"(O[0][0]));
                    XE_(0); XE_(1); XE_(2); GEND_();
                    O[0][1] = MFMA32(vf[2], __builtin_bit_cast(bf16x8, pb[0][0]), O[0][1]); asm volatile("" : "+v"(O[0][1]));
                    XE_(3); XE_(4); XE_(5); XA_(0); XA_(1); XA_(2); XC_(0); asm volatile("" : "+v"(pw_[0])); GEND_();
                    O[0][0] = MFMA32(vf[1], __builtin_bit_cast(bf16x8, pb[0][1]), O[0][0]); asm volatile("" : "+v"(O[0][0]));
                    XE_(6); XE_(7); XA_(3); XA_(4); XA_(5); XC_(1); XC_(2); asm volatile("" : "+v"(pw_[1]), "+v"(pw_[2])); GEND_();
                    O[0][1] = MFMA32(vf[3], __builtin_bit_cast(bf16x8, pb[0][1]), O[0][1]); asm volatile("" : "+v"(O[0][1]));
                    XA_(6); XA_(7); XC_(3);
                    lsum[1] += ls_; pb[1][0] = (u32x4){pw_[0], pw_[1], pw_[2], pw_[3]};
                    asm volatile("" : "+v"(pb[1][0]), "+v"(lsum[1]), "+v"(sv[1])); __builtin_amdgcn_sched_barrier(0); }
            }
#undef DA2_HALF
#undef GEND_
#undef XC_
#undef XA_
#undef XE_
        }
    }
    { float ls_ = 0.f;
#pragma unroll
      for (int i = 8; i < 16; ++i) { sv[1][i] = __builtin_amdgcn_exp2f(sv[1][i]); ls_ += sv[1][i]; }
      lsum[1] += ls_;
      pb[1][1] = (u32x4){cvt_pk(sv[1][8], sv[1][9]), cvt_pk(sv[1][10], sv[1][11]), cvt_pk(sv[1][12], sv[1][13]), cvt_pk(sv[1][14], sv[1][15])}; }
    DA2_PV(1);
#undef DA2_RKJ
#undef DA2_RVJ
#undef DA2_RV1
#undef DA2_S
#undef DA2_PV
#undef DA2_EXP
#undef DA2_LOADG
    const float inv0 = 1.0f / add_xor32(lsum[0]), inv1 = A.lam / add_xor32(lsum[1]);
    bf16_t* yrow = A.y + (size_t)(A.yrow0 + wave * 32 + r) * DM;
    float ss = 0.f;
#pragma unroll
    for (int vt = 0; vt < 2; ++vt)
#pragma unroll
        for (int i = 0; i < 16; ++i) { const float o = O[0][vt][i] * inv0 - O[1][vt][i] * inv1; O[0][vt][i] = o; ss += o * o; }
    ss = add_xor32(ss);
    const float rs = rsqrtf(ss * (1.0f / 64.0f) + 1e-6f) * A.post;
#pragma unroll
    for (int vt = 0; vt < 2; ++vt)
#pragma unroll
        for (int g = 0; g < 4; ++g) { const int vd = vt * 32 + 8 * g + 4 * hh; const f32x4 sg = *(const f32x4*)(A.subg + vd);
            u32x2 w; w.x = cvt_pk(O[0][vt][4 * g] * rs * sg[0], O[0][vt][4 * g + 1] * rs * sg[1]); w.y = cvt_pk(O[0][vt][4 * g + 2] * rs * sg[2], O[0][vt][4 * g + 3] * rs * sg[3]);
            *(u32x2*)(yrow + vd) = w; }
}

__device__ __forceinline__ int ret_row0(int b, int n) { return n < 2 ? TL + b * CTXL + n * 128 : b * SEQ + (n - 2) * 128; }
__device__ __forceinline__ float log2_gamma(float d) { return -log1pf(__expf(-d)) * LOG2E; }
constexpr int RP = 72;

__device__ __forceinline__ void phase_ret_chunk_states(const Params& p, const Frame& F, int l) {
    LAS bf16_t* kt = (LAS bf16_t*)F.lds; LAS bf16_t* vtile = kt + 128 * RP;
    const int lane = F.lane, r = lane & 31, hh = lane >> 5, wave = F.wave, dir = wave >> 2, dkt = (wave >> 1) & 1, dvt = wave & 1;
    for (int it = (F.bid + F.G / 2) % F.G; it < NB * 4 * NCH; it += F.G) {
        const int n = it % NCH, bh = it / NCH, b = bh >> 2, h = bh & 3;
        const float lg2 = log2_gamma(dir ? p.ret_decay_b[l * 4 + h] : p.ret_decay_f[l * 4 + h]);
        const bf16_t* ksrc = F.retk + ((size_t)bh * SK + n * 128) * 64;
        const bf16_t* vsrc = F.Z + (size_t)ret_row0(b, n) * NINP + ZC_RV + h * 64;
        __syncthreads();
        { u32x4 gk[2], gv[2];
#pragma unroll
          for (int it2 = 0; it2 < 2; ++it2) { const int i = F.tid + 512 * it2, tok = i >> 3, c8 = (i & 7) * 8; gk[it2] = ldg<u32x4>(ksrc + tok * 64 + c8); gv[it2] = ldg<u32x4>(vsrc + (size_t)tok * NINP + c8); }
#pragma unroll
          for (int it2 = 0; it2 < 2; ++it2) { asm volatile("" : "+v"(gk[it2])); asm volatile("" : "+v"(gv[it2])); }
          __builtin_amdgcn_sched_barrier(0);
#pragma unroll
          for (int it2 = 0; it2 < 2; ++it2) { const int i = F.tid + 512 * it2, tok = i >> 3, c8 = (i & 7) * 8; *(LAS u32x4*)(kt + tok * RP + c8) = gk[it2]; *(LAS u32x4*)(vtile + tok * RP + c8) = gv[it2]; } }
        __syncthreads();
        f32x16 acc; for (int i = 0; i < 16; ++i) acc[i] = 0.f;
        const int dk = dkt * 32 + r, dv = dvt * 32 + r;
#pragma unroll
        for (int j = 0; j < 8; ++j) {
            float a[8], bv[8];
#pragma unroll
            for (int e = 0; e < 8; ++e) { const int c = 16 * j + 8 * hh + e;
                const float w = __builtin_amdgcn_exp2f(lg2 * (float)(dir ? c + 1 : 128 - c));
                a[e] = bf2f(kt[c * RP + dk]) * w; bv[e] = bf2f(vtile[c * RP + dv]); }
            const u32x4 af = (u32x4){cvt_pk(a[0], a[1]), cvt_pk(a[2], a[3]), cvt_pk(a[4], a[5]), cvt_pk(a[6], a[7])};
            const u32x4 bf = (u32x4){cvt_pk(bv[0], bv[1]), cvt_pk(bv[2], bv[3]), cvt_pk(bv[4], bv[5]), cvt_pk(bv[6], bv[7])};
            acc = MFMA32(__builtin_bit_cast(bf16x8, af), __builtin_bit_cast(bf16x8, bf), acc);
        }
        float* o = F.ust + ((size_t)(bh * NCH + n) * 2 + dir) * 4096;
#pragma unroll
        for (int i = 0; i < 16; ++i) o[(dkt * 32 + (i & 3) + 8 * (i >> 2) + 4 * hh) * 64 + dvt * 32 + r] = acc[i];
    }
}
__device__ __forceinline__ void phase_ret_scan(const Params& p, const Frame& F, int l) {
    for (int it = F.bid * 512 + F.tid; it < NB * 4 * 2 * 4096; it += F.G * 512) {
        const int e = it & 4095, dir = (it >> 12) & 1, bh = it >> 13, h = bh & 3;
        const float dec = __builtin_amdgcn_exp2f(128.0f * log2_gamma(dir ? p.ret_decay_b[l * 4 + h] : p.ret_decay_f[l * 4 + h]));
        float* base = F.ust + ((size_t)bh * NCH * 2 + dir) * 4096 + e;
        float st = 0.f;
        for (int i0 = 0; i0 < NCH; i0 += 10) {
            float u[10];
#pragma unroll
            for (int j = 0; j < 10; ++j) { const int idx = dir ? (NCH - 1 - (i0 + j)) : (i0 + j); const int n = dir ? (idx < 128 ? idx + 2 : idx - 128) : idx; u[j] = base[(size_t)n * 8192]; }
#pragma unroll
            for (int j = 0; j < 10; ++j) { const int idx = dir ? (NCH - 1 - (i0 + j)) : (i0 + j); const int n = dir ? (idx < 128 ? idx + 2 : idx - 128) : idx; base[(size_t)n * 8192] = st; st = st * dec + u[j]; }
        }
    }
}
__device__ __forceinline__ void ret_out_item(const Params& p, const Frame& F, int l, int it) {
    LAS unsigned char* lq = F.lds;
    LAS unsigned char* lk = F.lds + 16384;
    LAS bf16_t* lv = (LAS bf16_t*)(F.lds + 32768);
    LAS bf16_t* lsf = lv + 128 * RP;
    LAS bf16_t* lrb = lsf + 64 * RP;
    LAS float* lss = (LAS float*)(lrb + 64 * RP);
    const int tid = F.tid, lane = F.lane, r = lane & 31, hh = lane >> 5, wave = F.wave, qb = wave & 3, dt = wave >> 2;
    const int n = it % NCH, bh = it / NCH, b = bh >> 2, h = bh & 3;
    const float lgf = log2_gamma(p.ret_decay_f[l * 4 + h]), lgb = log2_gamma(p.ret_decay_b[l * 4 + h]);
    const int row0 = ret_row0(b, n);
    const bf16_t* qsrc = F.retq + ((size_t)bh * SK + n * 128) * 64; const bf16_t* ksrc = F.retk + ((size_t)bh * SK + n * 128) * 64;
    const bf16_t* vsrc = F.Z + (size_t)row0 * NINP + ZC_RV + h * 64;
    const float* sf = F.ust + ((size_t)(bh * NCH + n) * 2) * 4096; const float* rb = sf + 4096;
    __syncthreads();
    { u32x4 gq[2], gk[2], gv[2]; f32x4 ga[2], gb[2];
#pragma unroll
      for (int it2 = 0; it2 < 2; ++it2) { const int i = tid + 512 * it2, tok = i >> 3, ch = i & 7;
          gq[it2] = ldg<u32x4>(qsrc + tok * 64 + ch * 8); gk[it2] = ldg<u32x4>(ksrc + tok * 64 + ch * 8); gv[it2] = ldg<u32x4>(vsrc + (size_t)tok * NINP + ch * 8);
          const int dk = i >> 4, c4 = (i & 15) * 4; ga[it2] = ldg<f32x4>(sf + dk * 64 + c4); gb[it2] = ldg<f32x4>(rb + dk * 64 + c4); }
#pragma unroll
      for (int it2 = 0; it2 < 2; ++it2) { asm volatile("" : "+v"(gq[it2])); asm volatile("" : "+v"(gk[it2])); asm volatile("" : "+v"(gv[it2])); asm volatile("" : "+v"(ga[it2])); asm volatile("" : "+v"(gb[it2])); }
      __builtin_amdgcn_sched_barrier(0);
#pragma unroll
      for (int it2 = 0; it2 < 2; ++it2) { const int i = tid + 512 * it2, tok = i >> 3, ch = i & 7;
          *(LAS u32x4*)(lq + ch * 2048 + tok * 16) = gq[it2]; *(LAS u32x4*)(lk + ch * 2048 + tok * 16) = gk[it2]; *(LAS u32x4*)(lv + tok * RP + ch * 8) = gv[it2];
          const int dk = i >> 4, c4 = (i & 15) * 4; const f32x4 a = ga[it2], bb = gb[it2];
          *(LAS u32x2*)(lsf + dk * RP + c4) = (u32x2){cvt_pk(a[0], a[1]), cvt_pk(a[2], a[3])};
          *(LAS u32x2*)(lrb + dk * RP + c4) = (u32x2){cvt_pk(bb[0], bb[1]), cvt_pk(bb[2], bb[3])}; } }
    __syncthreads();
    const int cq = qb * 32 + r, dvl = dt * 32 + r;
    bf16x8 qf[4];
#pragma unroll
    for (int st = 0; st < 4; ++st) qf[st] = *(const LAS bf16x8*)(lq + (2 * st + hh) * 2048 + cq * 16);
    f32x16 O; for (int i = 0; i < 16; ++i) O[i] = 0.f;
#pragma unroll
    for (int kb = 0; kb < 4; ++kb) {
        f32x16 s; for (int i = 0; i < 16; ++i) s[i] = 0.f;
#pragma unroll
        for (int st = 0; st < 4; ++st) { const bf16x8 kf = *(const LAS bf16x8*)(lk + (2 * st + hh) * 2048 + (kb * 32 + pi32(r)) * 16); s = MFMA32(kf, qf[st], s); }
#pragma unroll
        for (int i = 0; i < 16; ++i) { const int c = 32 * kb + 16 * (i >> 3) + 8 * hh + (i & 7); const int dl = cq - c;
            s[i] *= __builtin_amdgcn_exp2f(dl >= 0 ? lgf * (float)dl : lgb * (float)(-dl)); }
#pragma unroll
        for (int s2 = 0; s2 < 2; ++s2) {
            const u32x4 pf = (u32x4){cvt_pk(s[8 * s2], s[8 * s2 + 1]), cvt_pk(s[8 * s2 + 2], s[8 * s2 + 3]), cvt_pk(s[8 * s2 + 4], s[8 * s2 + 5]), cvt_pk(s[8 * s2 + 6], s[8 * s2 + 7])};
            unsigned short ve[8];
#pragma unroll
            for (int e = 0; e < 8; ++e) ve[e] = lv[(32 * kb + 16 * s2 + 8 * hh + e) * RP + dvl];
            const u32x4 vf = (u32x4){(unsigned)ve[0] | ((unsigned)ve[1] << 16), (unsigned)ve[2] | ((unsigned)ve[3] << 16), (unsigned)ve[4] | ((unsigned)ve[5] << 16), (unsigned)ve[6] | ((unsigned)ve[7] << 16)};
            O = MFMA32(__builtin_bit_cast(bf16x8, vf), __builtin_bit_cast(bf16x8, pf), O);
        }
    }
    f32x16 xf, xb; for (int i = 0; i < 16; ++i) { xf[i] = 0.f; xb[i] = 0.f; }
#pragma unroll
    for (int st = 0; st < 4; ++st) {
        unsigned short se[8], re[8];
#pragma unroll
        for (int e = 0; e < 8; ++e) { se[e] = lsf[(16 * st + 8 * hh + e) * RP + dvl]; re[e] = lrb[(16 * st + 8 * hh + e) * RP + dvl]; }
        const u32x4 sfv = (u32x4){(unsigned)se[0] | ((unsigned)se[1] << 16), (unsigned)se[2] | ((unsigned)se[3] << 16), (unsigned)se[4] | ((unsigned)se[5] << 16), (unsigned)se[6] | ((unsigned)se[7] << 16)};
        const u32x4 rbv = (u32x4){(unsigned)re[0] | ((unsigned)re[1] << 16), (unsigned)re[2] | ((unsigned)re[3] << 16), (unsigned)re[4] | ((unsigned)re[5] << 16), (unsigned)re[6] | ((unsigned)re[7] << 16)};
        xf = MFMA32(__builtin_bit_cast(bf16x8, sfv), qf[st], xf); xb = MFMA32(__builtin_bit_cast(bf16x8, rbv), qf[st], xb);
    }
    const float wf = __builtin_amdgcn_exp2f(lgf * (float)cq), wb = __builtin_amdgcn_exp2f(lgb * (float)(127 - cq));
    float ss = 0.f;
#pragma unroll
    for (int i = 0; i < 16; ++i) { O[i] += wf * xf[i] + wb * xb[i]; ss += O[i] * O[i]; }
    ss = add_xor32(ss);
    if (hh == 0) lss[wave * 32 + r] = ss;
    __syncthreads();
    ss += lss[(wave ^ 4) * 32 + r];
    const float rs = rsqrtf(ss * (1.0f / 64.0f) + 1e-6f);
    const bf16_t* grow = F.Z + (size_t)(row0 + cq) * NINP + ZC_RG + h * 64;
    bf16_t* yrow = F.H + (size_t)(row0 + cq) * DM + 768 + h * 64;
#pragma unroll
    for (int g = 0; g < 4; ++g) { const int dv = dt * 32 + 8 * g + 4 * hh; const u32x2 gw = *(const u32x2*)(grow + dv);
        const float g0 = bflo(gw.x), g1 = bfhi(gw.x), g2 = bflo(gw.y), g3 = bfhi(gw.y);
        u32x2 w; w.x = cvt_pk(O[4 * g] * rs * siluf(g0), O[4 * g + 1] * rs * siluf(g1)); w.y = cvt_pk(O[4 * g + 2] * rs * siluf(g2), O[4 * g + 3] * rs * siluf(g3));
        *(u32x2*)(yrow + dv) = w; }
}

__device__ __forceinline__ void phase_ln1(const Params& p, const Frame& F, int l) {
    const int lane = F.lane;
    const float* g = p.ln1_g + l * DM; const float* bta = p.ln1_b + l * DM;
    LAS float* wt = (LAS float*)F.lds;
    for (int i = F.bid * 512 + F.tid; i < MAXPAN * 256; i += F.G * 512) F.gidx[i] = 0;
    __syncthreads();
    { f32x4 w[2][4];
#pragma unroll
      for (int it = 0; it < 2; ++it)
#pragma unroll
          for (int q4 = 0; q4 < 4; ++q4) w[it][q4] = ldg<f32x4>(p.router_w + (size_t)(F.tid + 512 * it) * 16 + 4 * q4);
#pragma unroll
      for (int it = 0; it < 2; ++it)
#pragma unroll
          for (int q4 = 0; q4 < 4; ++q4) asm volatile("" : "+v"(w[it][q4]));
      __builtin_amdgcn_sched_barrier(0);
#pragma unroll
      for (int it = 0; it < 2; ++it)
#pragma unroll
          for (int q4 = 0; q4 < 4; ++q4)
#pragma unroll
              for (int e = 0; e < 4; ++e) wt[(4 * q4 + e) * DM + F.tid + 512 * it] = w[it][q4][e]; }
    __syncthreads();
    LAS int* lcnt = (LAS int*)(F.lds + 65536);
    if (F.tid < 32) lcnt[F.tid] = 0;
    __syncthreads();
    float rb = p.router_b[(lane >> 2) & 15];
    const int MT = (l == DEPTH - 1) ? TL : TT;
    LAS float* pv = (LAS float*)(F.lds + 66560);
    { float t[2][8];
#pragma unroll
      for (int it = 0; it < 2; ++it) { const int c = F.tid + 512 * it; t[it][0] = ldgf(g + c); t[it][1] = ldgf(bta + c);
#pragma unroll
          for (int sg = 0; sg < 3; ++sg) { const float* md = F.mods + ((size_t)l * 3 + sg) * 6144; t[it][2 + 2 * sg] = ldgf(md + 3 * DM + c); t[it][3 + 2 * sg] = ldgf(md + 4 * DM + c); } }
#pragma unroll
      for (int it = 0; it < 2; ++it)
#pragma unroll
          for (int k = 0; k < 8; ++k) asm volatile("" : "+v"(t[it][k]));
      __builtin_amdgcn_sched_barrier(0);
#pragma unroll
      for (int it = 0; it < 2; ++it) { const int c = F.tid + 512 * it; pv[c] = t[it][0]; pv[DM + c] = t[it][1];
#pragma unroll
          for (int sg = 0; sg < 3; ++sg) { pv[(2 + 2 * sg) * DM + c] = t[it][2 + 2 * sg]; pv[(3 + 2 * sg) * DM + c] = 1.0f + t[it][3 + 2 * sg]; } } }
    __syncthreads();
    const int stride = F.G * 8;
#pragma nounroll
    for (int seg = 0; seg < 3; ++seg) {
    const int lo = seg * SEQ, hi = (seg < 2) ? lo + SEQ : TT;
    if (lo >= MT) break;
    const LAS float* psh = pv + (2 + 2 * seg) * DM; const LAS float* psc = psh + DM;
    for (int row = lo + F.bid * 8 + F.wave; row < hi; row += stride) {
        float* xr = xrow(p, F, row);
        f32x4 v[4];
#pragma unroll
        for (int j = 0; j < 4; ++j) v[j] = ldg<f32x4>(xr + j * 256 + lane * 4);
        float s = 0.f;
#pragma unroll
        for (int j = 0; j < 4; ++j) s += v[j][0] + v[j][1] + v[j][2] + v[j][3];
        const float mean = wsum(s) * (1.0f / DM); float q = 0.f;
#pragma unroll
        for (int j = 0; j < 4; ++j)
#pragma unroll
            for (int e = 0; e < 4; ++e) { const float d = v[j][e] - mean; q += d * d; }
        const float rstd = rsqrtf(wsum(q) * (1.0f / DM) + 1e-5f);
        float lg[16];
#pragma unroll
        for (int e = 0; e < 16; ++e) lg[e] = 0.f;
#pragma unroll
        for (int j = 0; j < 4; ++j) { const int c = j * 256 + lane * 4;
            f32x4 xn, hv;
            const f32x4 gv = *(const LAS f32x4*)(pv + c), bv = *(const LAS f32x4*)(pv + DM + c), shv = *(const LAS f32x4*)(psh + c), sc1 = *(const LAS f32x4*)(psc + c);
#pragma unroll
            for (int e = 0; e < 4; ++e) { xn[e] = (v[j][e] - mean) * rstd * gv[e] + bv[e]; hv[e] = xn[e] * sc1[e] + shv[e]; }
            stg<f32x4>(xr + c, xn);
            u32x2 w; w.x = cvt_pk(hv[0], hv[1]); w.y = cvt_pk(hv[2], hv[3]); stg<u32x2>(F.H + (size_t)row * DM + c, w);
#pragma unroll
            for (int e = 0; e < 16; ++e) { const f32x4 wv = *(const LAS f32x4*)(wt + e * DM + c); lg[e] += hv[0] * wv[0] + hv[1] * wv[1] + hv[2] * wv[2] + hv[3] * wv[3];
                if (e == 7) __builtin_amdgcn_sched_barrier(0); }
            __builtin_amdgcn_sched_barrier(0);
        }
#pragma unroll
        for (int e = 0; e < 8; ++e) { const auto r2 = __builtin_amdgcn_permlane32_swap(__float_as_uint(lg[e]), __float_as_uint(lg[e + 8]), false, false); lg[e] = __uint_as_float(r2[0]) + __uint_as_float(r2[1]); }
#pragma unroll
        for (int e = 0; e < 4; ++e) { const auto r2 = __builtin_amdgcn_permlane16_swap(__float_as_uint(lg[e]), __float_as_uint(lg[e + 4]), false, false); lg[e] = __uint_as_float(r2[0]) + __uint_as_float(r2[1]); }
#pragma unroll
        for (int e = 0; e < 2; ++e) { const bool up = lane & 8; const float keep = up ? lg[e + 2] : lg[e], give = up ? lg[e] : lg[e + 2]; lg[e] = keep + dppf<0x128>(give); }
        { const bool up = lane & 4; const float keep = up ? lg[1] : lg[0], give = up ? lg[0] : lg[1]; lg[0] = keep + dppf<0x141>(dppf<0x1B>(give)); }
        float lgt = lg[0]; lgt += dppf<0x4E>(lgt); lgt += dppf<0xB1>(lgt);
        const float mysc = 1.0f / (1.0f + __expf(-lgt)), mych = mysc + rb;
        float gsum;
        { const float cb = dppf<0x124>(mych), cc = dppf<0x128>(mych), cd = dppf<0x12C>(mych);
          const float h1 = fmaxf(mych, cb), l1 = fminf(mych, cb), h2 = fmaxf(cc, cd), l2 = fminf(cc, cd);
          gsum = fmaxf(h1, h2) + fmaxf(fminf(h1, h2), fmaxf(l1, l2)); }
        int bg = 0; float bgs = rdlane(gsum, 0);
        { const float g1 = rdlane(gsum, 16), g2 = rdlane(gsum, 32), g3 = rdlane(gsum, 48);
          if (g1 > bgs) { bgs = g1; bg = 1; } if (g2 > bgs) { bgs = g2; bg = 2; } if (g3 > bgs) { bgs = g3; bg = 3; } }
        bg = __builtin_amdgcn_readfirstlane(bg);
        int e0 = 0, e1 = 0; float c0 = -1e30f, c1 = -1e30f, s0 = 0.f, s1 = 0.f;
#pragma unroll
        for (int k = 0; k < 4; ++k) { const float c = rdlane(mych, bg * 16 + 4 * k), s2 = rdlane(mysc, bg * 16 + 4 * k); const int ee = bg * 4 + k;
            if (c > c0) { c1 = c0; e1 = e0; s1 = s0; c0 = c; e0 = ee; s0 = s2; } else if (c > c1) { c1 = c; e1 = ee; s1 = s2; } }
        if (lane == 0) {
            const float inv = 1.0f / (s0 + s1);
            const int p0 = __hip_atomic_fetch_add(lcnt + e0, 1, __ATOMIC_RELAXED, __HIP_MEMORY_SCOPE_WORKGROUP), p1 = __hip_atomic_fetch_add(lcnt + e1, 1, __ATOMIC_RELAXED, __HIP_MEMORY_SCOPE_WORKGROUP);
            int* rt = F.route + (size_t)row * 8; stg<u32x4>(rt, (u32x4){(unsigned)e0, (unsigned)e1, (unsigned)p0, (unsigned)p1}); stg<u32x2>(rt + 4, (u32x2){__float_as_uint(s0 * inv), __float_as_uint(s1 * inv)});
        }
    }
    }
    __syncthreads();
    if (F.tid < 16) lcnt[16 + F.tid] = atomicAdd(F.cnt + l * 16 + F.tid, lcnt[F.tid]);
    asm volatile("s_waitcnt vmcnt(0)" ::: "memory");
    __syncthreads();
#pragma nounroll
    for (int seg = 0; seg < 3; ++seg) { const int lo = seg * SEQ, hi = (seg < 2) ? lo + SEQ : TT; if (lo >= MT) break;
        for (int row = lo + F.bid * 8 + F.wave + lane * stride; row < hi; row += 64 * stride) { int* rt = F.route + (size_t)row * 8;
            const u32x4 r = ldg<u32x4>(rt); stg<u32x2>(rt + 2, (u32x2){r.z + (unsigned)lcnt[16 + r.x], r.w + (unsigned)lcnt[16 + r.y]}); } }
    __syncthreads();
}
__device__ __forceinline__ void phase_perm(const Params& p, const Frame& F, int l) {
    LAS int* off = (LAS int*)F.lds; LAS int* cn = off + 32;
    __syncthreads();
    if (F.tid < 16) cn[F.tid] = ldg<int>(F.cnt + l * 16 + F.tid);
    __syncthreads();
    if (F.tid == 0) { int a = 0; for (int e = 0; e < 16; ++e) { off[e] = a; a += (cn[e] + 255) & ~255; } off[16] = a;
        if (F.bid == 0) { F.misc[0] = a >> 8; for (int e = 0; e < 16; ++e) for (int q = off[e] >> 8; q < (off[e + 1 < 17 ? e + 1 : 16] >> 8); ++q) F.misc[16 + q] = e; } }
    __syncthreads();
    const int MT = (l == DEPTH - 1) ? TL : TT;
    for (int row = (F.bid * 8 + F.wave) * 64 + F.lane; row < MT; row += F.G * 8 * 64) {
        int* rt = F.route + (size_t)row * 8;
        const u32x4 r = ldg<u32x4>(rt);
        const int d0 = off[r.x] + (int)r.z, d1 = off[r.y] + (int)r.w;
        stg<u32x2>(rt + 6, (u32x2){(unsigned)d0, (unsigned)d1});
        stg<int>(F.gidx + d0, row); stg<int>(F.gidx + d1, row);
    }
}
__device__ __forceinline__ void phase_ln2(const Params& p, const Frame& F, int l) {
    const int lane = F.lane;
    const float* g = p.ln2_g + l * DM; const float* bta = p.ln2_b + l * DM;
    const int MT = (l == DEPTH - 1) ? TL : TT;
    const bool hasn = (l + 1 < DEPTH);
    f32x4 gv[4], bv[4];
#pragma unroll
    for (int j = 0; j < 4; ++j) { gv[j] = ldg<f32x4>(g + j * 256 + lane * 4); bv[j] = ldg<f32x4>(bta + j * 256 + lane * 4); }
    const int stride = F.G * 8;
#define LN2_LOADROW(rw, rt_, X, A_, B_) do { const float* xs_ = xrow(p, F, (rw)); \
        const bf16_t* f0_ = F.Fs + (size_t)__builtin_amdgcn_readfirstlane((int)(rt_)[2]) * DM; const bf16_t* f1_ = F.Fs + (size_t)__builtin_amdgcn_readfirstlane((int)(rt_)[3]) * DM; \
        _Pragma("unroll") for (int j_ = 0; j_ < 4; ++j_) { const int c_ = j_ * 256 + lane * 4; X[j_] = ldg<f32x4>(xs_ + c_); A_[j_] = ldg<u32x2>(f0_ + c_); B_[j_] = ldg<u32x2>(f1_ + c_); } } while (0)
#pragma nounroll
    for (int seg = 0; seg < 3; ++seg) {
    const int lo = seg * SEQ, hi = (seg < 2) ? lo + SEQ : TT;
    if (lo >= MT) break;
    const float* md = F.mods + ((size_t)l * 3 + seg) * 6144;
    const float* mdn = F.mods + ((size_t)(hasn ? l + 1 : l) * 3 + seg) * 6144;
    f32x4 gt[4], nsh[4], nsc1[4];
#pragma unroll
    for (int j = 0; j < 4; ++j) { const int c = j * 256 + lane * 4; gt[j] = ldg<f32x4>(md + 5 * DM + c); nsh[j] = ldg<f32x4>(mdn + c); nsc1[j] = ldg<f32x4>(mdn + DM + c) + 1.0f; }
    int row = lo + F.bid * 8 + F.wave;
    u32x4 rc = (u32x4){0u, 0u, 0u, 0u}, rn = rc;
    f32x4 xv[4]; u32x2 fa[4], fb[4];
#pragma unroll
    for (int j = 0; j < 4; ++j) { xv[j] = (f32x4){0.f, 0.f, 0.f, 0.f}; fa[j] = (u32x2){0u, 0u}; fb[j] = fa[j]; }
    if (row < hi) { rc = ldg<u32x4>(F.route + (size_t)row * 8 + 4); LN2_LOADROW(row, rc, xv, fa, fb); }
    if (row + stride < hi) rn = ldg<u32x4>(F.route + (size_t)(row + stride) * 8 + 4);
    for (; row < hi; row += stride) {
        float* xr = xrow(p, F, row);
        f32x4 xvn[4]; u32x2 fan[4], fbn[4]; u32x4 rn2 = rn;
#pragma unroll
        for (int j = 0; j < 4; ++j) { xvn[j] = xv[j]; fan[j] = fa[j]; fbn[j] = fb[j]; }
        if (row + stride < hi) { LN2_LOADROW(row + stride, rn, xvn, fan, fbn);
            if (row + 2 * stride < hi) rn2 = ldg<u32x4>(F.route + (size_t)(row + 2 * stride) * 8 + 4); }
        const float w0 = __uint_as_float(rc[0]), w1 = __uint_as_float(rc[1]);
        f32x4 v[4]; float s = 0.f;
#pragma unroll
        for (int j = 0; j < 4; ++j) { const u32x2 a = fa[j], b = fb[j];
            f32x4 f; f[0] = w0 * bflo(a.x) + w1 * bflo(b.x); f[1] = w0 * bfhi(a.x) + w1 * bfhi(b.x); f[2] = w0 * bflo(a.y) + w1 * bflo(b.y); f[3] = w0 * bfhi(a.y) + w1 * bfhi(b.y);
            v[j] = xv[j] * ALPHA + gt[j] * f; s += v[j][0] + v[j][1] + v[j][2] + v[j][3]; }
        const float mean = wsum(s) * (1.0f / DM); float q = 0.f;
#pragma unroll
        for (int j = 0; j < 4; ++j)
#pragma unroll
            for (int e = 0; e < 4; ++e) { const float d = v[j][e] - mean; q += d * d; }
        const float rstd = rsqrtf(wsum(q) * (1.0f / DM) + 1e-5f);
#pragma unroll
        for (int j = 0; j < 4; ++j) { const int c = j * 256 + lane * 4;
            f32x4 xn;
#pragma unroll
            for (int e = 0; e < 4; ++e) xn[e] = (v[j][e] - mean) * rstd * gv[j][e] + bv[j][e];
            stg<f32x4>(xr + c, xn);
            if (hasn) { u32x2 w; w.x = cvt_pk(xn[0] * nsc1[j][0] + nsh[j][0], xn[1] * nsc1[j][1] + nsh[j][1]); w.y = cvt_pk(xn[2] * nsc1[j][2] + nsh[j][2], xn[3] * nsc1[j][3] + nsh[j][3]);
                stg<u32x2>(F.H + (size_t)row * DM + c, w); }
        }
#pragma unroll
        for (int j = 0; j < 4; ++j) { xv[j] = xvn[j]; fa[j] = fan[j]; fb[j] = fbn[j]; }
        rc = rn; rn = rn2;
    }
    }
#undef LN2_LOADROW
}

__device__ __forceinline__ Frame make_frame(const Params& p, unsigned char* lds_raw, int wave_s);
__device__ __forceinline__ void phase_attn(const Params& p, const Frame& F, int l) {
    const bool last = (l == DEPTH - 1);
    float lam, post;
    { const float* lv = p.da_lambda + l * 128; const int i = F.lane & 31;
      const float a = wsum(F.lane < 32 ? lv[i] * lv[32 + i] : 0.f), b = wsum(F.lane < 32 ? lv[64 + i] * lv[96 + i] : 0.f);
      const float li = 0.8f - 0.6f * expf(-0.3f * (float)l); lam = expf(a) - expf(b) + li; post = 1.0f - li;
      lam = __uint_as_float(__builtin_amdgcn_readfirstlane(__float_as_uint(lam))); post = __uint_as_float(__builtin_amdgcn_readfirstlane(__float_as_uint(post))); }
    const int nDA = 768 + (last ? 0 : 12);
#ifndef ATT_MASK
#define ATT_MASK 7
#endif
    if (ATT_MASK & 1) for (int i = 0;; ++i) {
        const int L = i * F.G + F.bid; if (L >= nDA) break;
        int bh, qt; if (L < 768) { const int w = L & 255, xcd = w & 7; bh = (L >> 8) * 4 + (xcd >> 1); qt = (xcd & 1) * 32 + (w >> 3); } else { bh = L - 768; qt = 64; }
        const int b = bh / 6, h = bh - b * 6;
        AttnArgs A;
        { const size_t o = (size_t)(b * 12 + h * 2) * SK; A.qr0 = F.QRDA + o * 32; A.qf0 = F.QFDA + o * 32; A.k0 = F.KDA + o * 32; A.qn0 = F.qn_da + o;
          A.qr1 = A.qr0 + (size_t)SK * 32; A.qf1 = A.qf0 + (size_t)SK * 32; A.k1 = A.k0 + (size_t)SK * 32; A.qn1 = A.qn0 + SK;
          A.kmax0 = sqrtf(__uint_as_float(F.kmax_da[l * 24 + b * 12 + h * 2])); A.kmax1 = sqrtf(__uint_as_float(F.kmax_da[l * 24 + b * 12 + h * 2 + 1])); }
        A.qpe = nullptr; A.vt = F.VTDA + (size_t)(b * 6 + h) * 64 * SK;
        if (qt < 64) { A.q0 = qt * 256; A.t0 = 0; A.t1 = 130; A.yrow0 = b * SEQ + qt * 256; } else { A.q0 = SEQ; A.t0 = 128; A.t1 = 130; A.yrow0 = TL + b * CTXL; }
        A.y = F.H + h * 64; A.lam = lam; A.post = post; A.subg = p.da_subln + l * 64;
        attn_item_da2(F, A);
    }
    if (ATT_MASK & 2) for (int i = 0;; ++i) {
        const int L = i * F.G + F.bid; if (L >= nDA) break;
        int bh, qt; if (L < 768) { const int w = L & 255, xcd = w & 7; bh = (L >> 8) * 4 + (xcd >> 1); qt = (xcd & 1) * 32 + (w >> 3); } else { bh = L - 768; qt = 64; }
        const int b = bh / 6, h = bh - b * 6;
        AttnArgs A; const size_t o = (size_t)(b * 6 + h) * SK;
        A.qr0 = F.QRMLA + o * 96; A.qr1 = A.qr0; A.qf0 = A.qr0; A.qf1 = A.qr0; A.qpe = F.QPE + o * 32; A.k0 = F.KMLA + o * 96; A.k1 = A.k0; A.qn0 = F.qn_mla + o; A.qn1 = A.qn0;
        A.kmax0 = sqrtf(__uint_as_float(F.kmax_mla[l * 12 + b * 6 + h])); A.kmax1 = A.kmax0;
        A.vt = F.VTMLA + o * 64;
        if (qt < 64) { A.q0 = qt * 256; A.t0 = 0; A.t1 = 130; A.yrow0 = b * SEQ + qt * 256; } else { A.q0 = SEQ; A.t0 = 128; A.t1 = 130; A.yrow0 = TL + b * CTXL; }
        A.y = F.H + 384 + h * 64; A.lam = 0.f; A.post = 1.f; A.subg = nullptr;
        attn_item<96, false>(F, A);
    }
    LAS int* qs = (LAS int*)(F.lds + LDS_MAIN + 64);
    int* qctr = F.cnt + 192 + l * 2;
    if (ATT_MASK & 4) for (;;) {
        __syncthreads();
        if (F.tid == 0) *qs = atomicAdd(qctr, 1);
        __syncthreads();
        const int it = __builtin_amdgcn_readfirstlane(*qs);
        if (it >= NB * 4 * NCH) break;
        if (last && (it % NCH) < 2) continue;
        const Frame F2 = make_frame(p, (unsigned char*)F.lds, F.wave); ret_out_item(p, F2, l, it);
    }
    for (;;) {
        __syncthreads();
        if (F.tid == 0) *qs = atomicAdd(qctr + 1, 1);
        __syncthreads();
        const int c = __builtin_amdgcn_readfirstlane(*qs);
        if (c >= CVT_TILES / 8) break;
        { const Frame F2 = make_frame(p, (unsigned char*)F.lds, F.wave); convert_expert_chunk(p, F2, l, c); }
    }
}

__device__ __forceinline__ int sig_plain(int r) { return 16 * ((r >> 2) & 1) + 4 * (r >> 3) + (r & 3); }
__device__ __forceinline__ int sig_swiglu(int r) { return 8 * ((r >> 4) + 2 * ((r >> 2) & 1)) + 4 * ((r >> 3) & 1) + (r & 3); }
template <int MR>
__device__ __forceinline__ void small_mma(const bf16_t* wp, const bf16_t* const (&ap)[MR], int nk16, f32x16 (&acc)[MR]) {
    bf16x8 wc[4], ac[MR][4];
#pragma unroll
    for (int j = 0; j < 4; ++j) { wc[j] = __builtin_bit_cast(bf16x8, ldg16(wp + 16 * j));
#pragma unroll
        for (int m = 0; m < MR; ++m) ac[m][j] = __builtin_bit_cast(bf16x8, ldg16(ap[m] + 16 * j)); }
#pragma nounroll
    for (int ks = 0; ks < nk16; ks += 4) {
        bf16x8 wn[4], an[MR][4];
#pragma unroll
        for (int j = 0; j < 4; ++j) { wn[j] = wc[j];
#pragma unroll
            for (int m = 0; m < MR; ++m) an[m][j] = ac[m][j]; }
        if (ks + 4 < nk16) {
#pragma unroll
            for (int j = 0; j < 4; ++j) { wn[j] = __builtin_bit_cast(bf16x8, ldg16(wp + 16 * (ks + 4 + j)));
#pragma unroll
                for (int m = 0; m < MR; ++m) an[m][j] = __builtin_bit_cast(bf16x8, ldg16(ap[m] + 16 * (ks + 4 + j))); } }
#pragma unroll
        for (int j = 0; j < 4; ++j)
#pragma unroll
            for (int m = 0; m < MR; ++m) acc[m] = MFMA32(wc[j], ac[m][j], acc[m]);
#pragma unroll
        for (int j = 0; j < 4; ++j) { wc[j] = wn[j];
#pragma unroll
            for (int m = 0; m < MR; ++m) ac[m][j] = an[m][j]; }
    }
}
__device__ __forceinline__ void small_store16(bf16_t* o, const f32x16& a) {
    stg<u32x4>(o, (u32x4){cvt_pk(a[0], a[1]), cvt_pk(a[2], a[3]), cvt_pk(a[4], a[5]), cvt_pk(a[6], a[7])});
    stg<u32x4>(o + 8, (u32x4){cvt_pk(a[8], a[9]), cvt_pk(a[10], a[11]), cvt_pk(a[12], a[13]), cvt_pk(a[14], a[15])});
}
#define SMALL_ZERO(acc, MR_) do { _Pragma("unroll") for (int m_ = 0; m_ < (MR_); ++m_) _Pragma("unroll") for (int i_ = 0; i_ < 16; ++i_) acc[m_][i_] = 0.f; } while (0)
__device__ __forceinline__ void small_g1(const Frame& F) {
    const int r = F.lane & 31, hh = F.lane >> 5, sg = sig_plain(r), nw = F.G * 8;
    for (int u = F.wave * F.G + F.bid; u < 512 + 8 * 81; u += nw) {
        int n0, row0;
        if (u < 512) { n0 = 2560; row0 = u * 64; } else { const int v = u - 512; n0 = (v % 81) * 32; row0 = TL + (v / 81) * 64; }
        const bf16_t* wp = F.WinT + (size_t)(n0 + sg) * DM + 8 * hh;
        const bf16_t* const ap[2] = { F.H + (size_t)(row0 + r) * DM + 8 * hh, F.H + (size_t)(row0 + 32 + r) * DM + 8 * hh };
        f32x16 acc[2]; SMALL_ZERO(acc, 2);
        small_mma<2>(wp, ap, DM / 16, acc);
#pragma unroll
        for (int m = 0; m < 2; ++m) small_store16(F.Z + (size_t)(row0 + 32 * m + r) * NINP + n0 + 16 * hh, acc[m]);
    }
}
__device__ __forceinline__ void small_g2(const Frame& F) {
    const int r = F.lane & 31, hh = F.lane >> 5, sg = sig_plain(r), nw = F.G * 8;
    for (int u = F.wave * F.G + F.bid; u < 8 * 42; u += nw) {
        const int nb = u % 42, n0 = (nb < 18 ? nb : nb + 6) * 32, row0 = TL + (u / 42) * 64;
        const int koff = n0 < KVC0 ? 0 : 256, nk16 = n0 < KVC0 ? 16 : 8;
        const bf16_t* wp = F.W2m + (size_t)(n0 + sg) * K2 + koff + 8 * hh;
        const bf16_t* const ap[2] = { F.Z + ZC_CQ + (size_t)(row0 + r) * NINP + koff + 8 * hh, F.Z + ZC_CQ + (size_t)(row0 + 32 + r) * NINP + koff + 8 * hh };
        f32x16 acc[2]; SMALL_ZERO(acc, 2);
        small_mma<2>(wp, ap, nk16, acc);
#pragma unroll
        for (int m = 0; m < 2; ++m) small_store16(F.Z2 + (size_t)(row0 + 32 * m + r) * N2P + n0 + 16 * hh, acc[m]);
    }
}
__device__ __forceinline__ void small_g3(const Frame& F, int l) {
    const int r = F.lane & 31, hh = F.lane >> 5, sg = sig_plain(r), nw = F.G * 8;
    const float* gate = F.mods + ((size_t)l * 3 + 2) * 6144 + 2 * DM;
    for (int u = F.wave * F.G + F.bid; u < 16 * 32; u += nw) {
        const int n0 = (u & 31) * 32, row0 = (u >> 5) * 32;
        const bf16_t* wp = F.WoutT + (size_t)(n0 + sg) * DM + 8 * hh;
        const bf16_t* const ap[1] = { F.H + (size_t)(TL + row0 + r) * DM + 8 * hh };
        f32x16 acc[1]; SMALL_ZERO(acc, 1);
        small_mma<1>(wp, ap, DM / 16, acc);
        float* xp = F.xc + (size_t)(row0 + r) * DM + n0 + 16 * hh; const float* gp = gate + n0 + 16 * hh;
#pragma unroll
        for (int q = 0; q < 4; ++q) { const f32x4 gv = ldg<f32x4>(gp + 4 * q), xv = ldg<f32x4>(xp + 4 * q);
            f32x4 a; a[0] = acc[0][4 * q]; a[1] = acc[0][4 * q + 1]; a[2] = acc[0][4 * q + 2]; a[3] = acc[0][4 * q + 3];
            stg<f32x4>(xp + 4 * q, xv * ALPHA + gv * a); }
    }
}
constexpr int PBIG = 256;
__device__ __forceinline__ void small_g4(const Frame& F, int npan) {
    const int r = F.lane & 31, hh = F.lane >> 5, sg = sig_swiglu(r), nw = F.G * 8;
    for (int u = F.wave * F.G + F.bid; u < (npan - PBIG) * 128; u += nw) {
        const int pm = PBIG + (u >> 7), v = u & 127, n0 = (v & 31) * 32, row0 = pm * 256 + (v >> 5) * 64;
        const int e = F.misc[16 + pm];
        const bf16_t* wp = F.W13 + (size_t)e * 1024 * 1024 + (size_t)(n0 + sg) * DM + 8 * hh;
        const bf16_t* const ap[2] = { F.H + (size_t)ldg<int>(F.gidx + row0 + r) * DM + 8 * hh, F.H + (size_t)ldg<int>(F.gidx + row0 + 32 + r) * DM + 8 * hh };
        f32x16 acc[2]; SMALL_ZERO(acc, 2);
        small_mma<2>(wp, ap, DM / 16, acc);
#pragma unroll
        for (int m = 0; m < 2; ++m) { float h[8];
#pragma unroll
            for (int t = 0; t < 8; ++t) { const float a = acc[m][8 * (t >> 2) + (t & 3)], b = acc[m][8 * (t >> 2) + 4 + (t & 3)]; h[t] = a / (1.0f + __expf(-a)) * b; }
            stg<u32x4>(F.Uact + (size_t)(row0 + 32 * m + r) * DEXP + (n0 >> 1) + 8 * hh, (u32x4){cvt_pk(h[0], h[1]), cvt_pk(h[2], h[3]), cvt_pk(h[4], h[5]), cvt_pk(h[6], h[7])}); }
    }
}
__device__ __forceinline__ void small_g5(const Frame& F, int npan) {
    const int r = F.lane & 31, hh = F.lane >> 5, sg = sig_plain(r), nw = F.G * 8;
    for (int u = F.wave * F.G + F.bid; u < (npan - PBIG) * 128; u += nw) {
        const int pm = PBIG + (u >> 7), v = u & 127, n0 = (v & 31) * 32, row0 = pm * 256 + (v >> 5) * 64;
        const int e = F.misc[16 + pm];
        const bf16_t* wp = F.W2e + (size_t)e * 1024 * 512 + (size_t)(n0 + sg) * DEXP + 8 * hh;
        const bf16_t* const ap[2] = { F.Uact + (size_t)(row0 + r) * DEXP + 8 * hh, F.Uact + (size_t)(row0 + 32 + r) * DEXP + 8 * hh };
        f32x16 acc[2]; SMALL_ZERO(acc, 2);
        small_mma<2>(wp, ap, DEXP / 16, acc);
#pragma unroll
        for (int m = 0; m < 2; ++m) small_store16(F.Fs + (size_t)(row0 + 32 * m + r) * DM + n0 + 16 * hh, acc[m]);
    }
}

typedef const __attribute__((address_space(4))) Params* KParams;
__device__ __forceinline__ Params load_params() {
    Params r;
#if defined(__HIP_DEVICE_COMPILE__)
    static_assert(sizeof(Params) == 28 * 8, "Params layout");
    const __attribute__((address_space(4))) unsigned long long* kp = (const __attribute__((address_space(4))) unsigned long long*)__builtin_amdgcn_kernarg_segment_ptr();
    asm volatile("" : "+s"(kp));
    unsigned long long* d = (unsigned long long*)&r;
#pragma unroll
    for (int i = 0; i < 28; ++i) d[i] = kp[i];
#endif
    return r;
}
__device__ __forceinline__ int lane_id() { int l; asm volatile("v_mbcnt_lo_u32_b32 %0, -1, 0\n\tv_mbcnt_hi_u32_b32 %0, -1, %0" : "=v"(l)); return l; }
__device__ __forceinline__ Frame make_frame(const Params& p, unsigned char* lds_raw, int wave_s) {
    int tid = wave_s * 64 + lane_id(); asm volatile("" : "+v"(tid));
    Frame F;
    int G = gridDim.x, bid = blockIdx.x; asm volatile("" : "+s"(G), "+s"(bid));
    F.lds = (LAS unsigned char*)lds_raw; F.tid = tid; F.lane = F.tid & 63; F.wave = __builtin_amdgcn_readfirstlane(F.tid >> 6); F.G = G; F.bid = bid;
    unsigned char* ws = p.ws; asm volatile("" : "+s"(ws)); F.ws = ws;
    F.cnt = (int*)(ws + WS_CTL); F.kmax_da = (unsigned*)(ws + WS_CTL + 256); F.kmax_mla = (unsigned*)(ws + WS_CTL + 1024); F.misc = (int*)(ws + WS_MISC);
    F.modp = (float*)(ws + WS_MODP); F.mods = (float*)(ws + WS_MODS); F.rope = (float*)(ws + WS_ROPE); F.xc = (float*)(ws + WS_XC); F.route = (int*)(ws + WS_ROUTE); F.gidx = (int*)(ws + WS_GIDX);
    F.qn_da = (float*)(ws + WS_QN); F.qn_mla = F.qn_da + (size_t)NB * 12 * SK;
    F.WinT = (bf16_t*)(ws + WS_WIN); F.W2m = (bf16_t*)(ws + WS_W2M); F.WoutT = (bf16_t*)(ws + WS_WOUT); F.H = (bf16_t*)(ws + WS_H);
    F.retq = (bf16_t*)(ws + WS_RETQ); F.retk = (bf16_t*)(ws + WS_RETK); F.ust = (float*)(ws + WS_UST);
    F.Z = (bf16_t*)(ws + WS_A); F.Hs = F.Z; F.Z2 = (bf16_t*)(ws + WS_B); F.Uact = F.Z2;
    unsigned char* rc = ws + WS_C;
    F.QRDA = (bf16_t*)(rc + WC_QRDA); F.QFDA = (bf16_t*)(rc + WC_QFDA); F.KDA = (bf16_t*)(rc + WC_KDA); F.VTDA = (bf16_t*)(rc + WC_VTDA);
    F.QRMLA = (bf16_t*)(rc + WC_QRMLA); F.QPE = (bf16_t*)(rc + WC_QPE); F.KMLA = (bf16_t*)(rc + WC_KMLA); F.VTMLA = (bf16_t*)(rc + WC_VTMLA);
    F.Fs = (bf16_t*)(rc + WC_FS); F.W13 = (bf16_t*)(ws + WS_W13); F.W2e = (bf16_t*)(ws + WS_W2E);

    return F;
}
constexpr int PH_PER_LAYER = 12, PH_PRE = 3, NPH = PH_PRE + DEPTH * PH_PER_LAYER;
__global__ void __launch_bounds__(512, 2) mk_fwd(Params p_arg) {
    extern __shared__ __attribute__((aligned(16))) unsigned char lds_raw[];
    const LAS unsigned char* const lds_c = (const LAS unsigned char*)lds_raw; (void)lds_c;
    unsigned char* ws = p_arg.ws;
    const int wave_s = __builtin_amdgcn_readfirstlane((int)threadIdx.x >> 6);
#define IS_T0 (wave_s == 0 && lane_id() == 0)
    volatile LAS unsigned* xbw = (volatile LAS unsigned*)((LAS unsigned char*)lds_raw + LDS_MAIN);
    if (threadIdx.x < 4) xbw[threadIdx.x] = 0u;
    __syncthreads();
    const int lo = p_arg.ph_lo, hi = p_arg.ph_hi;
    XcdBarrier bar; bar.bar = (unsigned*)(ws + WS_BAR); bar.x = 0; bar.st = xbw;
    if (hi - lo > 1) bar = xcd_barrier_post((unsigned*)(ws + WS_BAR), xbw, IS_T0);
#ifndef PH_MASK
#define PH_MASK 0xFFF
#endif
#ifndef PRE_MASK
#define PRE_MASK 7
#endif
#define IN(k) (lo <= (k) && (k) < hi)
#define INP(k) (((PRE_MASK >> (k)) & 1) && IN(k))
#define INL(j) (((PH_MASK >> (j)) & 1) && IN(pb + (j)))
#ifndef REP_MASK
#define REP_MASK 0
#endif
#define REPS(j) ((((REP_MASK) >> (j)) & 1) ? 2 : 1)
#define SEAM(k) do { if (IN(k) && IN((k) + 1)) xcd_barrier(bar, IS_T0); } while (0)

    if (INP(0)) { const Params p = load_params(); const Frame F = make_frame(p, lds_raw, wave_s); phase_prologue(p, F); } SEAM(0);
    if (INP(1)) { const Params p = load_params(); const Frame F = make_frame(p, lds_raw, wave_s); phase_mods(p, F); } SEAM(1);
    if (INP(2)) { const Params p = load_params(); const Frame F = make_frame(p, lds_raw, wave_s); phase_modulate(p, F, 0, 0); } SEAM(2);
    for (int l = 0; l < DEPTH; ++l) {
        const int pb = PH_PRE + l * PH_PER_LAYER;
        if (INL(0)) for (int rep_ = 0; rep_ < REPS(0); ++rep_) { const Params p = load_params(); const Frame F = make_frame(p, lds_raw, wave_s);
            pg8::Gemm g{F.H, F.WinT, TL, 2560, DM, DM, DM, nullptr, 0, -1, 0, 0, 0, 0, nullptr}; pg8::StaticOrder S; S.init(TL, 2560, F.G, F.bid);
            pg8::EpiStoreBf16 E{F.Z, NINP}; pg8::gemm_phase(F.lds, F.tid, g, S, E); small_g1(F); }
        SEAM(pb + 0);
        if (INL(1)) for (int rep_ = 0; rep_ < REPS(1); ++rep_) { const Params p = load_params(); const Frame F = make_frame(p, lds_raw, wave_s); phase_post1(p, F, l); } SEAM(pb + 1);
        if (INL(2)) for (int rep_ = 0; rep_ < REPS(2); ++rep_) { const Params p = load_params(); const Frame F = make_frame(p, lds_raw, wave_s);
            pg8::Gemm g{F.Z + ZC_CQ, F.W2m, TT, N2P, K2, NINP, K2, nullptr, 0, 3, 0, 4, 256, 2, nullptr};
            pg8::StaticOrder S; S.init(TL, N2P, F.G, F.bid);
            pg8::EpiStoreBf16 E{F.Z2, N2P}; pg8::gemm_phase(F.lds, F.tid, g, S, E); small_g2(F); }
        SEAM(pb + 2);
        if (INL(3)) for (int rep_ = 0; rep_ < REPS(3); ++rep_) { const Params p = load_params(); const Frame F = make_frame(p, lds_raw, wave_s); phase_post2(p, F, l); phase_ret_chunk_states(p, F, l); } SEAM(pb + 3);
        if (INL(4)) for (int rep_ = 0; rep_ < REPS(4); ++rep_) { const Params p = load_params(); const Frame F = make_frame(p, lds_raw, wave_s); phase_ret_scan(p, F, l); } SEAM(pb + 4);
        if (INL(5)) for (int rep_ = 0; rep_ < REPS(5); ++rep_) { const Params p = load_params(); const Frame F = make_frame(p, lds_raw, wave_s); phase_attn(p, F, l); } SEAM(pb + 5);
        if (INL(6)) for (int rep_ = 0; rep_ < REPS(6); ++rep_) { const Params p = load_params(); const Frame F = make_frame(p, lds_raw, wave_s);
            pg8::Gemm g{F.H, F.WoutT, TL, DM, DM, DM, DM, nullptr, 0, -1, 0, 0, 0, 0, nullptr}; pg8::StaticOrder S; S.init(TL, DM, F.G, F.bid);
            pg8::EpiResGate E{p.out, F.xc, F.mods + (size_t)l * 3 * 6144 + 2 * DM}; pg8::gemm_phase(F.lds, F.tid, g, S, E);
            if (l != DEPTH - 1) small_g3(F, l); }
        SEAM(pb + 6);
        if (INL(7)) for (int rep_ = 0; rep_ < REPS(7); ++rep_) { const Params p = load_params(); const Frame F = make_frame(p, lds_raw, wave_s); phase_ln1(p, F, l);
        } SEAM(pb + 7);
        if (INL(8)) for (int rep_ = 0; rep_ < REPS(8); ++rep_) { const Params p = load_params(); const Frame F = make_frame(p, lds_raw, wave_s); phase_perm(p, F, l); } SEAM(pb + 8);
        if (INL(9)) for (int rep_ = 0; rep_ < REPS(9); ++rep_) { const Params p = load_params(); const Frame F = make_frame(p, lds_raw, wave_s);
            const int npan = F.misc[0];
            const int nbig = npan < PBIG ? npan : PBIG;
            pg8::Gemm g{F.H, F.W13, nbig * 256, DM, DM, DM, DM, F.misc + 16, (size_t)1024 * 1024, -1, 0, 0, 0, 0, F.gidx}; pg8::MoeOrder S; S.init(nbig * 256, F.G, F.bid);
            pg8::EpiSwiGLU E{F.Uact}; pg8::gemm_phase<pg8::EpiSwiGLU, pg8::MoeOrder, true>(F.lds, F.tid, g, S, E); small_g4(F, npan); }
        SEAM(pb + 9);
        if (INL(10)) for (int rep_ = 0; rep_ < REPS(10); ++rep_) { const Params p = load_params(); const Frame F = make_frame(p, lds_raw, wave_s);
            const int npan = F.misc[0];
            const int nbig = npan < PBIG ? npan : PBIG;
            pg8::Gemm g{F.Uact, F.W2e, nbig * 256, DM, DEXP, DEXP, DEXP, F.misc + 16, (size_t)1024 * 512, -1, 0, 0, 0, 0, nullptr}; pg8::MoeOrder S; S.init(nbig * 256, F.G, F.bid);
            pg8::EpiStoreBf16 E{F.Fs, DM}; pg8::gemm_phase(F.lds, F.tid, g, S, E); small_g5(F, npan); }
        SEAM(pb + 10);
        if (INL(11)) for (int rep_ = 0; rep_ < REPS(11); ++rep_) { const Params p = load_params(); const Frame F = make_frame(p, lds_raw, wave_s); phase_ln2(p, F, l); if (l + 1 < DEPTH) convert_small_weights(p, F, l + 1); }
        SEAM(pb + 11);
    }
}

extern "C" void kernel_launch(void* const* d_in, const int* in_sizes, int n_in, void* d_out, int out_size, void* d_ws, size_t ws_size, hipStream_t stream) {
    static int grid = 0;
    if (grid == 0) {
        if (n_in != 25 || out_size != TL * DM || ws_size < WS_END) { fprintf(stderr, "kernel_launch: unexpected shapes / workspace (%d inputs, out %d, ws %zu < %zu)\n", n_in, out_size, ws_size, (size_t)WS_END); grid = -1; return; }
        int dev = 0, cus = 0;
        if (hipGetDevice(&dev) != hipSuccess || hipDeviceGetAttribute(&cus, hipDeviceAttributeMultiprocessorCount, dev) != hipSuccess) { grid = -1; return; }
        if (hipFuncSetAttribute((const void*)mk_fwd, hipFuncAttributeMaxDynamicSharedMemorySize, LDS_BYTES) != hipSuccess) { fprintf(stderr, "kernel_launch: hipFuncSetAttribute failed\n"); grid = -1; return; }
        int per_cu = 0;
        if (hipOccupancyMaxActiveBlocksPerMultiprocessor(&per_cu, (const void*)mk_fwd, 512, LDS_BYTES) != hipSuccess || per_cu < 1) { fprintf(stderr, "kernel_launch: occupancy query says %d\n", per_cu); }
        (void)hipGetLastError();
        grid = cus;
    }
    if (grid < 0) return;
    (void)hipMemsetAsync(d_ws, 0, WS_ZERO_BYTES, stream);
    Params p{};
    const float** pin = (const float**)&p;
    for (int i = 0; i < 25; ++i) pin[i] = (const float*)d_in[i];
    p.out = (float*)d_out; p.ws = (unsigned char*)d_ws;
#if MK_ONE_LAUNCH
    p.ph_lo = 0; p.ph_hi = NPH;
    hipLaunchKernelGGL(mk_fwd, dim3(grid), dim3(512), LDS_BYTES, stream, p);
#else
#ifndef PROBE_NPH
#define PROBE_NPH NPH
#endif
    for (int ph = 0; ph < PROBE_NPH; ++ph) { p.ph_lo = ph; p.ph_hi = ph + 1; hipLaunchKernelGGL(mk_fwd, dim3(grid), dim3(512), LDS_BYTES, stream, p); }
#endif
}
```

```cpp
#include <hip/hip_runtime.h>
#include <cstdio>
#include <cstdint>

#define LAS __attribute__((address_space(3)))
typedef unsigned short bf16_t;
typedef short bf16x8 __attribute__((ext_vector_type(8)));
typedef float f32x4 __attribute__((ext_vector_type(4)));
typedef float f32x16 __attribute__((ext_vector_type(16)));
typedef unsigned u32x4 __attribute__((ext_vector_type(4)));
typedef unsigned u32x2 __attribute__((ext_vector_type(2)));

#ifndef MK_ONE_LAUNCH
#define MK_ONE_LAUNCH 1
#endif

constexpr int DM = 1024, NB = 2, SEQ = 16384, DEPTH = 4, CTXL = 256;
constexpr int TL = NB * SEQ, TC = NB * CTXL, TT = TL + TC;
constexpr int SK = SEQ + CTXL;
constexpr int NIN = 2592, NINP = 2816;
constexpr int N2P = 1536, K2 = 384, KVC0 = 768;
constexpr int ZC_DAQ = 0, ZC_DAK = 384, ZC_DAV = 768, ZC_CQ = 1152, ZC_CKV = 1408, ZC_KPE = 1536, ZC_RQ = 1568, ZC_RK = 1824, ZC_RV = 2080, ZC_RG = 2336;
constexpr int NEXP = 16, DEXP = 512, MAXPAN = 276;
constexpr int NCH = SK / 128;
constexpr float ALPHA = 1.681792830507429f;
constexpr float LOG2E = 1.4426950408889634f;
constexpr float C2_DA = 0.17677669529663687f * LOG2E;
constexpr float C2_MLA = 0.10206207261596575f * LOG2E;

constexpr size_t al256(size_t x) { return (x + 255) & ~(size_t)255; }
constexpr size_t XCD_BAR_BYTES = 16384;
constexpr size_t WS_BAR = 0;
constexpr size_t WS_CTL = WS_BAR + XCD_BAR_BYTES;
constexpr size_t CTL_BYTES = 4096;
constexpr size_t WS_ZERO_BYTES = WS_CTL + CTL_BYTES;
constexpr size_t WS_MISC = WS_ZERO_BYTES;
constexpr size_t WS_MODP = WS_MISC + 4096;
constexpr size_t WS_MODS = WS_MODP + al256((size_t)DEPTH * 8 * 3 * 6144 * 4);
constexpr size_t WS_ROPE = WS_MODS + al256((size_t)DEPTH * 3 * 6144 * 4);
constexpr size_t WS_XC = WS_ROPE + al256((size_t)256 * 48 * 4);
constexpr size_t WS_ROUTE = WS_XC + al256((size_t)TC * DM * 4);
constexpr size_t WS_GIDX = WS_ROUTE + al256((size_t)TT * 8 * 4);
constexpr size_t WS_QN = WS_GIDX + al256((size_t)MAXPAN * 256 * 4);
constexpr size_t WS_WIN = WS_QN + al256((size_t)NB * 18 * SK * 4);
constexpr size_t WS_W2M = WS_WIN + al256((size_t)NINP * DM * 2);
constexpr size_t WS_WOUT = WS_W2M + al256((size_t)N2P * K2 * 2);
constexpr size_t WS_H = WS_WOUT + al256((size_t)DM * DM * 2);
constexpr size_t WS_RETQ = WS_H + al256((size_t)TT * DM * 2);
constexpr size_t WS_RETK = WS_RETQ + al256((size_t)NB * 4 * SK * 64 * 2);
constexpr size_t WS_UST = WS_RETK + al256((size_t)NB * 4 * SK * 64 * 2);
constexpr size_t WS_A = WS_UST + al256((size_t)NB * 4 * NCH * 2 * 4096 * 4);
constexpr size_t WS_B = WS_A + al256((size_t)TT * NINP * 2);
constexpr size_t WS_C = WS_B + al256((size_t)TT * N2P * 2);
constexpr size_t SZ_QDA = (size_t)NB * 12 * SK * 32 * 2, SZ_VT = (size_t)NB * 6 * 64 * SK * 2, SZ_QMLA = (size_t)NB * 6 * SK * 96 * 2, SZ_QPE = (size_t)NB * 6 * SK * 32 * 2;
constexpr size_t WC_QRDA = 0, WC_QFDA = WC_QRDA + SZ_QDA, WC_KDA = WC_QFDA + SZ_QDA, WC_VTDA = WC_KDA + SZ_QDA, WC_QRMLA = WC_VTDA + SZ_VT,
                 WC_QPE = WC_QRMLA + SZ_QMLA, WC_KMLA = WC_QPE + SZ_QPE, WC_VTMLA = WC_KMLA + SZ_QMLA, WC_END = WC_VTMLA + SZ_VT;
constexpr size_t WC_FS = 0, WC_W13 = (size_t)144 << 20, WC_W2E = WC_W13 + (size_t)NEXP * 1024 * 1024 * 2, WC_MOE_END = WC_W2E + (size_t)NEXP * 1024 * 512 * 2;
static_assert((size_t)MAXPAN * 256 * 1024 * 2 <= WC_W13 && WC_MOE_END <= WC_END, "region C aliasing");
static_assert((size_t)MAXPAN * 256 * 1024 * 2 <= (size_t)TT * NINP * 2 && (size_t)MAXPAN * 256 * 512 * 2 <= (size_t)TT * N2P * 2, "regions A/B aliasing");
constexpr size_t WS_W13 = WS_C + al256(WC_END);
constexpr size_t WS_W2E = WS_B + al256((size_t)MAXPAN * 256 * DEXP * 2);
static_assert(WS_W2E + (size_t)NEXP * 1024 * 512 * 2 <= WS_C, "W2e fits behind Uact in region B");
constexpr size_t WS_END = WS_W13 + al256((size_t)NEXP * 1024 * 1024 * 2);

typedef __bf16 bf16v2_t __attribute__((ext_vector_type(2)));
__device__ __forceinline__ unsigned cvt_pk(float lo, float hi) { bf16v2_t v; v[0] = (__bf16)lo; v[1] = (__bf16)hi; return __builtin_bit_cast(unsigned, v); }
__device__ __forceinline__ bf16_t f2bf(float f) { return (bf16_t)(cvt_pk(f, f) & 0xffffu); }
__device__ __forceinline__ float bf2f(bf16_t b) { return __uint_as_float(((unsigned)b) << 16); }
__device__ __forceinline__ float bflo(unsigned w) { return __uint_as_float(w << 16); }
__device__ __forceinline__ float bfhi(unsigned w) { return __uint_as_float(w & 0xffff0000u); }
template <int CTRL> __device__ __forceinline__ float dppf(float v) { return __builtin_bit_cast(float, __builtin_amdgcn_update_dpp(0, __builtin_bit_cast(int, v), CTRL, 0xF, 0xF, true)); }
__device__ __forceinline__ float rdlane(float v, int l) { return __builtin_bit_cast(float, __builtin_amdgcn_readlane(__builtin_bit_cast(int, v), l)); }
__device__ __forceinline__ float rsum16(float v) { v += dppf<0xB1>(v); v += dppf<0x4E>(v); v += dppf<0x141>(v); v += dppf<0x140>(v); return v; }
__device__ __forceinline__ float add_xor16(float v) { const auto r2 = __builtin_amdgcn_permlane16_swap(__float_as_uint(v), __float_as_uint(v), false, false); return __uint_as_float(r2[0]) + __uint_as_float(r2[1]); }
__device__ __forceinline__ float add_xor32(float v) { const auto r2 = __builtin_amdgcn_permlane32_swap(__float_as_uint(v), __float_as_uint(v), false, false); return __uint_as_float(r2[0]) + __uint_as_float(r2[1]); }
__device__ __forceinline__ float wsum(float v) {
    v += dppf<0xB1>(v);
    v += dppf<0x4E>(v);
    v += dppf<0x141>(v);
    v += dppf<0x140>(v);
    return ((rdlane(v, 0) + rdlane(v, 16)) + rdlane(v, 32)) + rdlane(v, 48); }
__device__ __forceinline__ float siluf(float v) { return v / (1.0f + __expf(-v)); }
__device__ __forceinline__ u32x4 ldg16(const void* p) { return *(const __attribute__((address_space(1))) u32x4*)p; }
__device__ __forceinline__ float ldgf(const float* p) { return *(const __attribute__((address_space(1))) float*)p; }
template <class T> __device__ __forceinline__ T ldg(const void* p) { return *(const __attribute__((address_space(1))) T*)p; }
template <class T> __device__ __forceinline__ void stg(void* p, T v) { *(__attribute__((address_space(1))) T*)p = v; }
__device__ __forceinline__ int pi32(int r) { return (r & ~12) | ((r & 4) << 1) | ((r & 8) >> 1); }

#define XB_TMO      128
#define XB_XCNT(j)  (256  + 64 * (j))
#define XB_XSUB(j)  (1280 + 64 * (j))
#define XB_XGEN(j)  (2304 + 64 * (j))
#define XB_TOP      3328
#define XB_TOPGEN   3392
#define XCD_BAR_WORDS 3456
#define XB_SPIN_CAP (1u << 22)
static_assert(XCD_BAR_WORDS * 4 <= XCD_BAR_BYTES, "barrier words");

__device__ __forceinline__ unsigned xb_ld(unsigned* p)              { return __hip_atomic_load(p, __ATOMIC_RELAXED, __HIP_MEMORY_SCOPE_AGENT); }
__device__ __forceinline__ unsigned xb_add(unsigned* p, unsigned v) { return __hip_atomic_fetch_add(p, v, __ATOMIC_RELAXED, __HIP_MEMORY_SCOPE_AGENT); }
__device__ __forceinline__ unsigned xb_xcc_id() { return (unsigned)__builtin_amdgcn_s_getreg((3 << 11) | 20) & 0xFu; }
#define XB_SPIN(cond, bar) do { unsigned _sp = 0; while (cond) { __builtin_amdgcn_s_sleep(1); \
    if ((++_sp & 255u) == 0u) { if (xb_ld(&(bar)[XB_TMO])) break; if (_sp > XB_SPIN_CAP) { atomicAdd(&(bar)[XB_TMO], 1u); break; } } } } while (0)

struct XcdBarrier { unsigned* bar; unsigned x; volatile LAS unsigned* st; };

__device__ __forceinline__ XcdBarrier xcd_barrier_post(unsigned* bar, volatile LAS unsigned* st, bool is_t0) {
    XcdBarrier b; b.bar = bar; b.x = xb_xcc_id(); b.st = st;
    if (is_t0) (void)xb_add(&bar[XB_XCNT(b.x)], 1u);
    return b;
}
__device__ __forceinline__ void xcd_barrier_complete(unsigned* bar, unsigned x, unsigned& nloc, unsigned& nx) {
    const unsigned G = gridDim.x * gridDim.y * gridDim.z;
    unsigned sum, cnt, mine, sp = 0u;
    for (;;) {
        sum = 0u; cnt = 0u; mine = 0u;
#pragma unroll
        for (unsigned j = 0; j < 16; ++j) { const unsigned c = xb_ld(&bar[XB_XCNT(j)]); sum += c; cnt += (c > 0u) ? 1u : 0u; }
        if (sum == G) { mine = xb_ld(&bar[XB_XCNT(x)]); break; }
        __builtin_amdgcn_s_sleep(1);
        if ((++sp & 255u) == 0u) { if (xb_ld(&bar[XB_TMO])) break; if (sp > XB_SPIN_CAP) { atomicAdd(&bar[XB_TMO], 1u); break; } }
    }
    nloc = mine > 0u ? mine : 1u; nx = cnt > 0u ? cnt : 1u;
}
__device__ __forceinline__ void xcd_barrier(const XcdBarrier& b, bool is_t0) {
    asm volatile("s_waitcnt vmcnt(0)" ::: "memory");
    __syncthreads();
    if (is_t0) {
        unsigned* bar = b.bar; asm volatile("" : "+s"(bar));
        __builtin_amdgcn_s_waitcnt(0);
        unsigned nloc = b.st[0], nx = b.st[1];
        if (nloc == 0u) { xcd_barrier_complete(bar, b.x, nloc, nx); b.st[0] = nloc; b.st[1] = nx; }
        const unsigned old = xb_add(&bar[XB_XSUB(b.x)], 1u);
        const unsigned gen = old / nloc;
        if (old + 1u == (gen + 1u) * nloc) {
            __builtin_amdgcn_fence(__ATOMIC_RELEASE, "agent");
            asm volatile("s_waitcnt vmcnt(0)" ::: "memory");
            const unsigned og = xb_add(&bar[XB_TOP], 1u);
            const unsigned tg = og / nx;
            if (og + 1u == (tg + 1u) * nx) xb_add(&bar[XB_TOPGEN], 1u);
            else XB_SPIN(xb_ld(&bar[XB_TOPGEN]) == tg, bar);
            __builtin_amdgcn_fence(__ATOMIC_ACQUIRE, "agent");
            xb_add(&bar[XB_XGEN(b.x)], 1u);
            asm volatile("s_waitcnt vmcnt(0)" ::: "memory");
        } else {
            XB_SPIN(xb_ld(&bar[XB_XGEN(b.x)]) == gen, bar);
            __builtin_amdgcn_fence(__ATOMIC_ACQUIRE, "agent");
            asm volatile("s_waitcnt vmcnt(0)" ::: "memory");
        }
    }
    __syncthreads();
}

namespace pg8 {
constexpr int BM = 256, BK = 64, HALF = 128, HTB = HALF * BK * 2, STAGE_BYTES = 8 * HTB, NXCD = 8, WGM = 8;
__host__ __device__ __forceinline__ int lds_byte(int r, int c) { const int st = (r >> 4) * 2 + (c >> 5), rr = r & 15, cc = c & 31, ob = rr * 64 + cc * 2; return st * 1024 + (ob ^ (((ob >> 9) & 1) << 5)); }
__host__ __device__ __forceinline__ void stage_rc(int b, int& R, int& C) { const int st = b / 1024, sb = b % 1024, swz = sb ^ (((sb >> 9) & 1) << 5); R = (st >> 1) * 16 + swz / 64; C = (st & 1) * 32 + (swz % 64) / 2; }
__host__ __device__ __forceinline__ int perm32(int rho) { const int n = rho >> 4, i = rho & 15; return 8 * (i >> 2) + 4 * n + (i & 3); }

struct Unit { int pm, pn; };
struct Gemm { const bf16_t* A; const bf16_t* Bt; int M, N, K, lda, ldb; const int* bsel; size_t bstride;
              int ks_pn, k0a, nta, k0b, ntb;
              const int* gidx; };

struct StaticOrder {
    int nM, nN, nwg, G, c;
    __host__ __device__ void init(int M, int N, int G_, int c_) { nM = M / BM; nN = N / BM; nwg = nM * nN; G = G_; c = c_; }
    __host__ __device__ bool next(int i, Unit& u) const {
        const long L = (long)i * G + c; if (L >= nwg) return false;
        int wgid = (int)L; { const int q = nwg / NXCD, r = nwg % NXCD, xcd = wgid % NXCD, off = wgid / NXCD; wgid = (xcd < r ? xcd * (q + 1) : r * (q + 1) + (xcd - r) * q) + off; }
        const int nig = WGM * nN, gid = wgid / nig, fm = gid * WGM, gsz = (nM - fm) < WGM ? (nM - fm) : WGM;
        u.pm = fm + ((wgid % nig) % gsz); u.pn = (wgid % nig) / gsz; return true;
    }
    __device__ __forceinline__ void a_ready(const Unit&) const {}
    __device__ __forceinline__ void done(const Unit&) const {}
};

struct MoeOrder {
    int nM, G, c;
    __host__ __device__ void init(int M, int G_, int c_) { nM = M / BM; G = G_; c = c_; }
    __host__ __device__ bool next(int i, Unit& u) const {
        if (G == 256) { const int slot = c >> 3; u.pm = ((i * 8 + (c & 7)) << 3) + (slot & 7); u.pn = slot >> 3; return u.pm < nM; }
        const int L = i * G + c; u.pm = L >> 2; u.pn = L & 3; return u.pm < nM;
    }
    __device__ __forceinline__ void a_ready(const Unit&) const {}
    __device__ __forceinline__ void done(const Unit&) const {}
};

template <class Epi, class Sched, bool GATHER = false>
__device__ __forceinline__ void gemm_phase(LAS unsigned char* lds, const int tid, const Gemm g, const Sched& S, const Epi& E) {
    const int wid = __builtin_amdgcn_readfirstlane(tid >> 6), lane = tid & 63, wr = wid >> 2, wc = wid & 3, fr = lane & 15, fq = lane >> 4;
    const int K = g.K;
#define PG8_KOFF(u) ((size_t)(g.ks_pn < 0 ? 0 : ((u).pn < g.ks_pn ? g.k0a : g.k0b)) * 2)
#define PG8_NT(u) (g.ks_pn < 0 ? K / BK : ((u).pn < g.ks_pn ? g.nta : g.ntb))
    unsigned voffA[2], voffB[2]; int Rrow[2], Ccol[2];
#pragma unroll
    for (int i = 0; i < 2; ++i) { int R, C; stage_rc(tid * 16 + i * 8192, R, C); const int Rb = Epi::PERM ? ((R & ~31) + perm32(R & 31)) : R; Rrow[i] = R; Ccol[i] = C;
        voffA[i] = (unsigned)(R * g.lda + C) * 2u; voffB[i] = (unsigned)(Rb * g.ldb + C) * 2u; }
    unsigned gc[2][2] = {{0u, 0u}, {0u, 0u}}, gn[2][2] = {{0u, 0u}, {0u, 0u}};
#define PG8_GLOAD(dst, u) do { _Pragma("unroll") for (int h_ = 0; h_ < 2; ++h_) _Pragma("unroll") for (int i_ = 0; i_ < 2; ++i_) \
        dst[h_][i_] = (unsigned)(ldg<int>(g.gidx + (u).pm * BM + h_ * HALF + Rrow[i_]) * g.lda + Ccol[i_]) * 2u; \
        _Pragma("unroll") for (int h_ = 0; h_ < 2; ++h_) _Pragma("unroll") for (int i_ = 0; i_ < 2; ++i_) asm volatile("" : "+v"(dst[h_][i_])); } while (0)
#define PG8_STAGE_A(bufoff, gbase, hh_, ARR) do { if (GATHER) PG8_STAGE(bufoff, gbase, ARR[hh_]); else PG8_STAGE(bufoff, (gbase) + (hh_) * hstepA, voffA); } while (0)
    const size_t kstep = (size_t)(BK * 2);
    const size_t hstepA = (size_t)HALF * g.lda * 2, hstepB = (size_t)HALF * g.ldb * 2;
    const size_t tstepA = 2 * hstepA, tstepB = 2 * hstepB;
    const unsigned ldsw = (unsigned)wid * 1024u;
    const int aoff = lds_byte(wr * 64 + fr, fq * 8), boff = lds_byte(wc * 32 + fr, fq * 8);
#define PG8_SA(b, h) (((b) * 2 + (h)) * HTB)
#define PG8_SB(b, h) ((4 + (b) * 2 + (h)) * HTB)
#define PG8_STAGE(bufoff, gbase, voff) do { _Pragma("unroll") for (int _i = 0; _i < 2; ++_i) \
        __builtin_amdgcn_global_load_lds((const unsigned*)((const char*)(gbase) + (voff)[_i]), (LAS unsigned*)(lds + (bufoff) + ldsw + _i * 8192), 16, 0, 0); } while (0)
#define PG8_LDA(dst, b, h) do { _Pragma("unroll") for (int m = 0; m < 4; ++m) _Pragma("unroll") for (int k = 0; k < 2; ++k) dst[m][k] = *(const LAS bf16x8*)(lds + PG8_SA(b, h) + aoff + m * 2048 + k * 1024); } while (0)
#define PG8_LDB(dst, b, h) do { _Pragma("unroll") for (int n = 0; n < 2; ++n) _Pragma("unroll") for (int k = 0; k < 2; ++k) dst[n][k] = *(const LAS bf16x8*)(lds + PG8_SB(b, h) + boff + n * 2048 + k * 1024); } while (0)
#define PG8_MMA(ai, bj, At, Bt) do { __builtin_amdgcn_s_setprio(1); _Pragma("unroll") for (int m = 0; m < 4; ++m) _Pragma("unroll") for (int n = 0; n < 2; ++n) _Pragma("unroll") for (int k = 0; k < 2; ++k) \
        acc[ai][bj][m][n] = __builtin_amdgcn_mfma_f32_16x16x32_bf16(Bt[n][k], At[m][k], acc[ai][bj][m][n], 0, 0, 0); __builtin_amdgcn_s_setprio(0); } while (0)
#define PG8_WAIT_V(n) asm volatile("s_waitcnt vmcnt(" #n ")" ::: "memory")
#define PG8_WAIT_L(n) asm volatile("s_waitcnt lgkmcnt(" #n ")" ::: "memory")
#define PG8_BAR __builtin_amdgcn_s_barrier()
#define PG8_SCHED __builtin_amdgcn_sched_barrier(0)
#define PG8_BBASE(u) ((const char*)g.Bt + (g.bsel ? (size_t)g.bsel[(u).pm] * g.bstride * 2 : (size_t)0) + (size_t)(u).pn * tstepB)
    Unit cur, nxt; int ui = 0;
    if (!S.next(0, cur)) return;
    f32x4 acc[2][2][4][2];
#pragma unroll
    for (int a = 0; a < 2; ++a)
#pragma unroll
        for (int b = 0; b < 2; ++b)
#pragma unroll
            for (int m = 0; m < 4; ++m)
#pragma unroll
                for (int n = 0; n < 2; ++n) acc[a][b][m][n] = (f32x4){0.f, 0.f, 0.f, 0.f};
    bf16x8 At[4][2], B0[2][2], B1[2][2];
    const char* cA = (const char*)g.A + (GATHER ? (size_t)0 : (size_t)cur.pm * tstepA) + PG8_KOFF(cur); const char* cB = PG8_BBASE(cur) + PG8_KOFF(cur);
    int nt = PG8_NT(cur);
    S.a_ready(cur);
    if (GATHER) PG8_GLOAD(gc, cur);
    PG8_STAGE(PG8_SB(0, 0), cB, voffB); PG8_STAGE_A(PG8_SA(0, 0), cA, 0, gc); PG8_STAGE(PG8_SB(0, 1), cB + hstepB, voffB); PG8_STAGE_A(PG8_SA(0, 1), cA, 1, gc);
    if (wr == 1) PG8_BAR;
    PG8_WAIT_V(4); PG8_BAR;
    PG8_STAGE(PG8_SB(1, 0), cB + kstep, voffB); PG8_STAGE_A(PG8_SA(1, 0), cA + kstep, 0, gc); PG8_STAGE(PG8_SB(1, 1), cB + hstepB + kstep, voffB);
    PG8_WAIT_V(6); PG8_BAR;
    for (;;) {
        const bool has_next = S.next(ui + 1, nxt);
        const char* nA = has_next ? (const char*)g.A + (GATHER ? (size_t)0 : (size_t)nxt.pm * tstepA) + PG8_KOFF(nxt) : cA; const char* nB = has_next ? PG8_BBASE(nxt) + PG8_KOFF(nxt) : cB;
        if (GATHER) { if (has_next) PG8_GLOAD(gn, nxt); else { _Pragma("unroll") for (int h_ = 0; h_ < 2; ++h_) _Pragma("unroll") for (int i_ = 0; i_ < 2; ++i_) gn[h_][i_] = gc[h_][i_]; } }
#pragma nounroll
        for (int t = 0; t < nt; t += 2) {
            const bool last = (t == nt - 2);
            const char* a1 = cA + (size_t)(t + 1) * kstep;
            const char* a2 = last ? nA : cA + (size_t)(t + 2) * kstep; const char* b2 = last ? nB : cB + (size_t)(t + 2) * kstep;
            const char* a3 = a2 + kstep; const char* b3 = b2 + kstep;
            if (last && has_next) S.a_ready(nxt);
            unsigned g2[2][2];
#pragma unroll
            for (int h_ = 0; h_ < 2; ++h_)
#pragma unroll
                for (int i_ = 0; i_ < 2; ++i_) g2[h_][i_] = last ? gn[h_][i_] : gc[h_][i_];
            PG8_LDB(B0, 0, 0); PG8_SCHED; PG8_LDA(At, 0, 0); PG8_STAGE_A(PG8_SA(1, 1), a1, 1, gc);
            PG8_WAIT_L(8); PG8_BAR; PG8_WAIT_L(0); PG8_MMA(0, 0, At, B0); PG8_BAR; PG8_SCHED;
            PG8_LDB(B1, 0, 1); PG8_STAGE(PG8_SB(0, 0), b2, voffB);
            PG8_BAR; PG8_WAIT_L(0); PG8_MMA(0, 1, At, B1); PG8_BAR;
            PG8_LDA(At, 0, 1); PG8_STAGE_A(PG8_SA(0, 0), a2, 0, g2);
            PG8_BAR; PG8_WAIT_L(0); PG8_MMA(1, 0, At, B0); PG8_BAR; PG8_SCHED;
            PG8_STAGE(PG8_SB(0, 1), b2 + hstepB, voffB);
            PG8_WAIT_V(6); PG8_BAR; PG8_MMA(1, 1, At, B1); PG8_BAR;
            PG8_LDB(B0, 1, 0); PG8_SCHED; PG8_LDA(At, 1, 0); PG8_STAGE_A(PG8_SA(0, 1), a2, 1, g2);
            PG8_WAIT_L(8); PG8_BAR; PG8_WAIT_L(0); PG8_MMA(0, 0, At, B0); PG8_BAR; PG8_SCHED;
            PG8_LDB(B1, 1, 1); PG8_STAGE(PG8_SB(1, 0), b3, voffB);
            PG8_BAR; PG8_WAIT_L(0); PG8_MMA(0, 1, At, B1); PG8_BAR;
            PG8_LDA(At, 1, 1); PG8_STAGE_A(PG8_SA(1, 0), a3, 0, g2);
            PG8_BAR; PG8_WAIT_L(0); PG8_MMA(1, 0, At, B0); PG8_BAR; PG8_SCHED;
            PG8_STAGE(PG8_SB(1, 1), b3 + hstepB, voffB);
            PG8_WAIT_V(6); PG8_BAR; PG8_MMA(1, 1, At, B1); PG8_BAR;
        }
        E(acc, cur, wr, wc, fr, fq);
        if (!has_next) break;
#pragma unroll
        for (int a = 0; a < 2; ++a)
#pragma unroll
            for (int b = 0; b < 2; ++b)
#pragma unroll
                for (int m = 0; m < 4; ++m)
#pragma unroll
                    for (int n = 0; n < 2; ++n) acc[a][b][m][n] = (f32x4){0.f, 0.f, 0.f, 0.f};
        cur = nxt; cA = nA; cB = nB; ++ui; nt = PG8_NT(cur);
        if (GATHER) { _Pragma("unroll") for (int h_ = 0; h_ < 2; ++h_) _Pragma("unroll") for (int i_ = 0; i_ < 2; ++i_) gc[h_][i_] = gn[h_][i_]; }
    }
    PG8_WAIT_V(0);
    if (wr == 0) PG8_BAR;
    PG8_BAR;
#undef PG8_SA
#undef PG8_SB
#undef PG8_STAGE
#undef PG8_LDA
#undef PG8_LDB
#undef PG8_MMA
#undef PG8_WAIT_V
#undef PG8_WAIT_L
#undef PG8_BAR
#undef PG8_SCHED
#undef PG8_BBASE
#undef PG8_KOFF
#undef PG8_NT
#undef PG8_GLOAD
#undef PG8_STAGE_A
}

struct EpiStoreBf16 {
    static constexpr bool PERM = true;
    bf16_t* O; int ldc;
    __device__ __forceinline__ void operator()(const f32x4 (&acc)[2][2][4][2], const Unit& u, int wr, int wc, int fr, int fq) const {
        const int row0 = u.pm * BM + wr * 64 + fr, col0 = u.pn * BM + wc * 32 + 8 * fq;
#pragma unroll
        for (int ai = 0; ai < 2; ++ai)
#pragma unroll
            for (int m = 0; m < 4; ++m) { bf16_t* rowp = O + (size_t)(row0 + ai * HALF + m * 16) * ldc + col0;
#pragma unroll
                for (int bj = 0; bj < 2; ++bj) { const f32x4 v0 = acc[ai][bj][m][0], v1 = acc[ai][bj][m][1];
                    u32x4 w; w.x = cvt_pk(v0[0], v0[1]); w.y = cvt_pk(v0[2], v0[3]); w.z = cvt_pk(v1[0], v1[1]); w.w = cvt_pk(v1[2], v1[3]);
                    *(u32x4*)(rowp + bj * HALF) = w; } }
    }
};
struct EpiResGate {
    static constexpr bool PERM = false;
    float* xl; float* xc; const float* gate;
    __device__ __forceinline__ void operator()(const f32x4 (&acc)[2][2][4][2], const Unit& u, int wr, int wc, int fr, int fq) const {
        const int row0 = u.pm * BM + wr * 64 + fr, col0 = u.pn * BM + wc * 32 + 4 * fq;
        const int ms = row0 < TL ? (row0 >> 14) : 2;
        float* const base = (row0 < TL ? xl + (size_t)row0 * DM : xc + (size_t)(row0 - TL) * DM) + col0;
        const float* gp = gate + (size_t)ms * 6144 + col0;
        f32x4 gv[2][2];
#pragma unroll
        for (int bj = 0; bj < 2; ++bj)
#pragma unroll
            for (int n = 0; n < 2; ++n) gv[bj][n] = ldg<f32x4>(gp + bj * HALF + n * 16);
        f32x4 xb[3][2][2];
#define ERG_LOAD(q_) do { const float* rp_ = base + (size_t)(((q_) >> 2) * HALF + ((q_) & 3) * 16) * DM; \
            _Pragma("unroll") for (int bj = 0; bj < 2; ++bj) _Pragma("unroll") for (int n = 0; n < 2; ++n) xb[(q_) % 3][bj][n] = ldg<f32x4>(rp_ + bj * HALF + n * 16); } while (0)
        ERG_LOAD(0); ERG_LOAD(1);
#pragma unroll
        for (int q = 0; q < 8; ++q) {
            if (q + 2 < 8) ERG_LOAD(q + 2);
            float* rp = base + (size_t)((q >> 2) * HALF + (q & 3) * 16) * DM;
#pragma unroll
            for (int bj = 0; bj < 2; ++bj)
#pragma unroll
                for (int n = 0; n < 2; ++n) stg<f32x4>(rp + bj * HALF + n * 16, xb[q % 3][bj][n] * ALPHA + gv[bj][n] * acc[q >> 2][bj][q & 3][n]);
            __builtin_amdgcn_sched_barrier(0);
        }
#undef ERG_LOAD
    }
};
struct EpiSwiGLU {
    static constexpr bool PERM = true;
    bf16_t* U;
    __device__ __forceinline__ void operator()(const f32x4 (&acc)[2][2][4][2], const Unit& u, int wr, int wc, int fr, int fq) const {
        const int row0 = u.pm * BM + wr * 64 + fr, col0 = u.pn * BM + wc * 32 + 8 * fq;
#pragma unroll
        for (int ai = 0; ai < 2; ++ai)
#pragma unroll
            for (int m = 0; m < 4; ++m) { bf16_t* rowp = U + (size_t)(row0 + ai * HALF + m * 16) * DEXP + (col0 >> 1);
#pragma unroll
                for (int bj = 0; bj < 2; ++bj) { const f32x4 a = acc[ai][bj][m][0], b = acc[ai][bj][m][1];
                    float r[4];
#pragma unroll
                    for (int j = 0; j < 4; ++j) r[j] = a[j] / (1.0f + __expf(-a[j])) * b[j];
                    u32x2 w; w.x = cvt_pk(r[0], r[1]); w.y = cvt_pk(r[2], r[3]);
                    *(u32x2*)(rowp + bj * (HALF / 2)) = w; } }
    }
};
}

struct Params {
    const float *x, *c, *ctx, *c_ctx, *w_ada, *b_ada, *w_in, *da_lambda, *da_subln, *mla_q_norm, *mla_w_uq, *mla_kv_norm, *mla_w_ukv,
                *ret_decay_f, *ret_decay_b, *w_out, *ln1_g, *ln1_b, *router_w, *router_b, *exp_w1, *exp_w3, *exp_w2, *ln2_g, *ln2_b;
    float* out; unsigned char* ws; int ph_lo, ph_hi;
};
struct Frame {
    LAS unsigned char* lds; int tid, lane, wave, G, bid;
    unsigned char* ws;
    int* cnt; unsigned* kmax_da; unsigned* kmax_mla; int* misc;
    float *modp, *mods, *rope, *xc; int* route; int* gidx; float *qn_da, *qn_mla;
    bf16_t *WinT, *W2m, *WoutT, *H, *retq, *retk; float* ust;
    bf16_t *Z, *Hs, *Z2, *Uact, *QRDA, *QFDA, *KDA, *VTDA, *QRMLA, *QPE, *KMLA, *VTMLA, *Fs, *W13, *W2e;
};
constexpr int LDS_MAIN = 131072;
constexpr int LDS_BYTES = LDS_MAIN + 256;

__device__ __forceinline__ float* xrow(const Params& p, const Frame& F, int row) { return row < TL ? p.out + (size_t)row * DM : F.xc + (size_t)(row - TL) * DM; }
__device__ __forceinline__ int msel_of(int row) { return row < TL ? (row >> 14) : 2; }

template <bool ILV>
__device__ __forceinline__ void cvt_tile(const Frame& F, const float* srcA, const float* srcB, int validA, int validB, int ldsrc, int k0, bf16_t* dst, int ldd, int n0) {
    LAS float* tile = (LAS float*)F.lds;
    const int t = F.tid, kk = t >> 3, j = t & 7;
    const float* sp = (j < 4 ? srcA + 8 * j : srcB + 8 * (j - 4)) + (size_t)(k0 + kk) * ldsrc;
    const bool ok = (j < 4) ? (8 * j < validA) : (8 * (j - 4) < validB);
    f32x4 v0 = (f32x4){0.f, 0.f, 0.f, 0.f}, v1 = v0;
    if (ok) { v0 = *(const f32x4*)sp; v1 = *(const f32x4*)(sp + 4); }
    __syncthreads();
#pragma unroll
    for (int i = 0; i < 4; ++i) { tile[kk * 65 + 8 * j + i] = v0[i]; tile[kk * 65 + 8 * j + 4 + i] = v1[i]; }
    __syncthreads();
    const int nn = t >> 3, ks = t & 7;
    int col = nn; if (ILV) { const int q = nn >> 3, i = nn & 7; col = (i < 4) ? 4 * q + i : 32 + 4 * q + (i - 4); }
    float r[8];
#pragma unroll
    for (int i = 0; i < 8; ++i) r[i] = tile[(ks * 8 + i) * 65 + col];
    u32x4 w; w.x = cvt_pk(r[0], r[1]); w.y = cvt_pk(r[2], r[3]); w.z = cvt_pk(r[4], r[5]); w.w = cvt_pk(r[6], r[7]);
    *(u32x4*)(dst + (size_t)(n0 + nn) * ldd + k0 + ks * 8) = w;
}
__device__ __forceinline__ void convert_small_weights(const Params& p, const Frame& F, int l) {
    const float* win = p.w_in + (size_t)l * DM * NIN;
    const float* wout = p.w_out + (size_t)l * DM * DM;
    constexpr int T_IN = (NINP / 64) * 16, T_OUT = 16 * 16;
    for (int u = F.bid; u < T_IN + T_OUT; u += F.G) {
        if (u < T_IN) { const int tn = u >> 4, tk = u & 15, n0 = tn * 64; int vA = NIN - n0; vA = vA < 0 ? 0 : (vA > 32 ? 32 : vA); int vB = NIN - n0 - 32; vB = vB < 0 ? 0 : (vB > 32 ? 32 : vB);
            const int nc = n0 < NIN - 64 ? n0 : (n0 < NIN ? n0 : 0);
            cvt_tile<false>(F, win + nc, win + (nc + 32 < NIN ? nc + 32 : 0), vA, vB, NIN, tk * 64, F.WinT, DM, n0); }
        else { const int v = u - T_IN, tn = v >> 4, tk = v & 15;
            cvt_tile<false>(F, wout + tn * 64, wout + tn * 64 + 32, 32, 32, DM, tk * 64, F.WoutT, DM, tn * 64); }
    }
    const float* wuq = p.mla_w_uq + (size_t)l * 256 * 576; const float* wukv = p.mla_w_ukv + (size_t)l * 128 * 768;
    const float* gq = p.mla_q_norm + l * 256; const float* gkv = p.mla_kv_norm + l * 128;
    for (int i = F.bid * 512 + F.tid; i < N2P * (K2 / 8); i += F.G * 512) {
        const int n = i / (K2 / 8), k0 = (i % (K2 / 8)) * 8; float r[8];
#pragma unroll
        for (int j = 0; j < 8; ++j) { const int k = k0 + j; float v = 0.f;
            if (n < 576) { if (k < 256) v = wuq[(size_t)k * 576 + n] * gq[k] * C2_MLA; }
            else if (n >= KVC0) { if (k >= 256) v = wukv[(size_t)(k - 256) * 768 + (n - KVC0)] * gkv[k - 256]; }
            r[j] = v; }
        u32x4 w; w.x = cvt_pk(r[0], r[1]); w.y = cvt_pk(r[2], r[3]); w.z = cvt_pk(r[4], r[5]); w.w = cvt_pk(r[6], r[7]);
        *(u32x4*)(F.W2m + (size_t)n * K2 + k0) = w;
    }
}
constexpr int CVT_T13 = NEXP * 16 * 16, CVT_T2 = NEXP * 16 * 8, CVT_TILES = CVT_T13 + CVT_T2;
__device__ __forceinline__ void convert_expert_tile(const Params& p, const Frame& F, int l, int u) {
    if (u < CVT_T13) { const int e = u >> 8, tn = (u >> 4) & 15, tk = u & 15;
        const float* w1 = p.exp_w1 + ((size_t)(l * NEXP + e) * DM) * DEXP + tn * 32; const float* w3 = p.exp_w3 + ((size_t)(l * NEXP + e) * DM) * DEXP + tn * 32;
        cvt_tile<true>(F, w1, w3, 32, 32, DEXP, tk * 64, F.W13 + (size_t)e * 1024 * 1024, DM, tn * 64); }
    else { const int v = u - CVT_T13, e = v >> 7, tn = (v >> 3) & 15, tk = v & 7;
        const float* w2 = p.exp_w2 + ((size_t)(l * NEXP + e) * DEXP) * DM + tn * 64;
        cvt_tile<false>(F, w2, w2 + 32, 32, 32, DM, tk * 64, F.W2e + (size_t)e * 1024 * 512, DEXP, tn * 64); }
}

__device__ __forceinline__ void convert_expert_chunk(const Params& p, const Frame& F, int l, int c) {
    LAS float* tile = (LAS float*)F.lds;
    const int t = F.tid, kk = t >> 3, j = t & 7;
    const bool w13 = (c * 8 < CVT_T13);
    f32x4 v0[8], v1[8];
#pragma unroll
    for (int k = 0; k < 8; ++k) { const int u = c * 8 + k;
        const float* sp;
        if (w13) { const int e = u >> 8, tn = (u >> 4) & 15, tk = u & 15;
            const float* w1 = p.exp_w1 + ((size_t)(l * NEXP + e) * DM) * DEXP + tn * 32; const float* w3 = p.exp_w3 + ((size_t)(l * NEXP + e) * DM) * DEXP + tn * 32;
            sp = (j < 4 ? w1 + 8 * j : w3 + 8 * (j - 4)) + (size_t)(tk * 64 + kk) * DEXP; }
        else { const int v = u - CVT_T13, e = v >> 7, tn = (v >> 3) & 15, tk = v & 7;
            const float* w2 = p.exp_w2 + ((size_t)(l * NEXP + e) * DEXP) * DM + tn * 64;
            sp = (j < 4 ? w2 + 8 * j : w2 + 32 + 8 * (j - 4)) + (size_t)(tk * 64 + kk) * DM; }
        v0[k] = ldg<f32x4>(sp); v1[k] = ldg<f32x4>(sp + 4); }
#pragma unroll
    for (int k = 0; k < 8; ++k) { asm volatile("" : "+v"(v0[k])); asm volatile("" : "+v"(v1[k])); }
    __builtin_amdgcn_sched_barrier(0);
#pragma unroll
    for (int k = 0; k < 8; ++k) { const int u = c * 8 + k;
        __syncthreads();
#pragma unroll
        for (int i = 0; i < 4; ++i) { tile[kk * 65 + 8 * j + i] = v0[k][i]; tile[kk * 65 + 8 * j + 4 + i] = v1[k][i]; }
        __syncthreads();
        const int nn = t >> 3, ks = t & 7;
        int col = nn; if (w13) { const int q = nn >> 3, i = nn & 7; col = (i < 4) ? 4 * q + i : 32 + 4 * q + (i - 4); }
        float r[8];
#pragma unroll
        for (int i = 0; i < 8; ++i) r[i] = tile[(ks * 8 + i) * 65 + col];
        u32x4 w; w.x = cvt_pk(r[0], r[1]); w.y = cvt_pk(r[2], r[3]); w.z = cvt_pk(r[4], r[5]); w.w = cvt_pk(r[6], r[7]);
        if (w13) { const int e = u >> 8, tn = (u >> 4) & 15, tk = u & 15; stg<u32x4>(F.W13 + (size_t)e * 1024 * 1024 + (size_t)(tn * 64 + nn) * DM + tk * 64 + ks * 8, w); }
        else { const int v = u - CVT_T13, e = v >> 7, tn = (v >> 3) & 15, tk = v & 7; stg<u32x4>(F.W2e + (size_t)e * 1024 * 512 + (size_t)(tn * 64 + nn) * DEXP + tk * 64 + ks * 8, w); }
    }
}

__device__ __forceinline__ void phase_prologue(const Params& p, const Frame& F) {
    LAS float* sv = (LAS float*)(F.lds + 32768);
    for (int i = F.tid; i < 3 * DM; i += 512) { const float v = i < 2 * DM ? p.c[i] : p.c_ctx[i - 2 * DM]; sv[i] = siluf(v); }
    __syncthreads();
    for (int it = F.bid * 512 + F.tid; it < DEPTH * 8 * 6144; it += F.G * 512) {
        const int n = it % 6144, ks = (it / 6144) & 7, l = it / (6144 * 8);
        const float* w = p.w_ada + ((size_t)l * DM + ks * 128) * 6144 + n;
        float a0 = 0.f, a1 = 0.f, a2 = 0.f;
#pragma unroll 8
        for (int k = 0; k < 128; ++k) { const float wv = w[(size_t)k * 6144]; a0 += sv[ks * 128 + k] * wv; a1 += sv[DM + ks * 128 + k] * wv; a2 += sv[2 * DM + ks * 128 + k] * wv; }
        float* o = F.modp + ((size_t)(l * 8 + ks) * 3) * 6144 + n; o[0] = a0; o[6144] = a1; o[2 * 6144] = a2;
    }
    for (int it = F.bid * 512 + F.tid; it < 256 * 24; it += F.G * 512) {
        const int idx = it / 24, f = it % 24; const bool ret = f >= 8; const int fi = ret ? f - 8 : f, nf = ret ? 16 : 8;
        const double freq = exp2(-(double)fi / (double)nf * 13.287712379549449);
        double ang = (double)idx * freq; const double k = rint(ang * 0.15915494309189535); ang = ang - k * 6.283185307179586 ;
        const float a = (float)ang; const float cs = cosf(a), sn = sinf(a);
        float* rp = F.rope + idx * 48;
        if (ret) { rp[16 + fi] = cs; rp[32 + fi] = sn; } else { rp[fi] = cs; rp[8 + fi] = sn; }
    }
    for (size_t i = (size_t)F.bid * 512 + F.tid; i < (size_t)TL * DM / 4; i += (size_t)F.G * 512) ((f32x4*)p.out)[i] = ((const f32x4*)p.x)[i];
    for (size_t i = (size_t)F.bid * 512 + F.tid; i < (size_t)TC * DM / 4; i += (size_t)F.G * 512) ((f32x4*)F.xc)[i] = ((const f32x4*)p.ctx)[i];
    convert_small_weights(p, F, 0);
}
__device__ __forceinline__ void phase_mods(const Params& p, const Frame& F) {
    for (int it = F.bid * 512 + F.tid; it < DEPTH * 3 * 6144; it += F.G * 512) {
        const int n = it % 6144, v = (it / 6144) % 3, l = it / (3 * 6144);
        float a = p.b_ada[l * 6144 + n];
#pragma unroll
        for (int ks = 0; ks < 8; ++ks) a += F.modp[((size_t)(l * 8 + ks) * 3 + v) * 6144 + n];
        F.mods[it] = a;
    }
}
__device__ __forceinline__ void phase_modulate(const Params& p, const Frame& F, int l, int shift_idx) {
    for (int row = F.bid * 8 + F.wave; row < TT; row += F.G * 8) {
        const float* xr = xrow(p, F, row); const float* md = F.mods + ((size_t)l * 3 + msel_of(row)) * 6144;
#pragma unroll
        for (int j = 0; j < 4; ++j) { const int c = j * 256 + F.lane * 4; const f32x4 xv = ldg<f32x4>(xr + c), sh = ldg<f32x4>(md + shift_idx * DM + c), sc = ldg<f32x4>(md + (shift_idx + 1) * DM + c);
            const f32x4 h = xv * (sc + 1.0f) + sh; u32x2 w; w.x = cvt_pk(h[0], h[1]); w.y = cvt_pk(h[2], h[3]); stg<u32x2>(F.H + (size_t)row * DM + c, w); }
    }
}

struct TokTile { int r0, b, isctx, pos0, kidx0, pF0, n; };
constexpr int NU_LAT = TL / 32, NU_POST = NU_LAT + TC / 2;
constexpr int PT = 32;
__device__ __forceinline__ TokTile tok_tile(int u) {
    TokTile t;
    if (u < NU_LAT) { t.r0 = u * PT; t.isctx = 0; t.b = t.r0 >> 14; t.pos0 = t.r0 & (SEQ - 1); t.kidx0 = t.pos0; t.pF0 = CTXL + t.pos0; t.n = PT; }
    else { const int c0 = (u - NU_LAT) * 2; t.r0 = TL + c0; t.isctx = 1; t.b = c0 >> 8; t.pos0 = c0 & 255; t.kidx0 = SEQ + t.pos0; t.pF0 = t.pos0; t.n = 2; }
    return t;
}
constexpr int VT_PITCH = 68;
__device__ __forceinline__ void vt_writeout(const Frame& F, bf16_t* dst_b  , int kidx0, int n) {
    const LAS bf16_t* vt = (const LAS bf16_t*)F.lds;
    if (n == PT) {
        for (int idx = F.tid; idx < 384 * (PT / 4); idx += 512) { const int col = idx / (PT / 4), seg = idx % (PT / 4);
            const u32x2 w = *(const LAS u32x2*)(vt + col * VT_PITCH + seg * 4);
            stg<u32x2>(dst_b + (size_t)col * SK + kidx0 + seg * 4, w); }
    } else {
        for (int col = F.tid; col < 384; col += 512) stg<unsigned>(dst_b + (size_t)col * SK + kidx0, *(const LAS unsigned*)(vt + col * VT_PITCH));
    }
}
__device__ __forceinline__ void phase_post1(const Params& p, const Frame& F, int l) {
    LAS bf16_t* vt = (LAS bf16_t*)F.lds;
    LAS unsigned* lmax = (LAS unsigned*)(F.lds + 65536);
    const int lane = F.lane;
    for (int u = F.bid; u < NU_POST; u += F.G) {
        const TokTile tt = tok_tile(u);
        float kmx[3] = {0.f, 0.f, 0.f};
        if (F.tid < 12) lmax[F.tid] = 0u;
        __syncthreads();
        unsigned wqS[PT / 8][3], wkS[PT / 8][3], wvS[PT / 8][3], wrqS[PT / 8][2], wrkS[PT / 8][2]; float csaS[PT / 8][3], snaS[PT / 8][3], csrS[PT / 8][2], snrS[PT / 8][2];
#pragma unroll
        for (int i = 0; i < PT / 8; ++i) {
            const int tok = F.wave * (PT / 8) + i, row = tt.r0 + tok, pos = tt.pos0 + tok;
#pragma unroll
            for (int j = 0; j < 3; ++j) { wqS[i][j] = 0u; wkS[i][j] = 0u; wvS[i][j] = 0u; csaS[i][j] = 0.f; snaS[i][j] = 0.f; }
#pragma unroll
            for (int j = 0; j < 2; ++j) { wrqS[i][j] = 0u; wrkS[i][j] = 0u; csrS[i][j] = 0.f; snrS[i][j] = 0.f; }
            if (tok < tt.n) {
                const bf16_t* z = F.Z + (size_t)row * NINP;
                const float* rr = F.rope + (pos >> 6) * 48; const float* rc = F.rope + (pos & 63) * 48;
#pragma unroll
                for (int j = 0; j < 3; ++j) { const int pr = lane + 64 * j, i16 = pr & 15; const float* rp = (i16 < 8) ? rr : rc;
                    wqS[i][j] = ldg<unsigned>(z + ZC_DAQ + 2 * pr); wkS[i][j] = ldg<unsigned>(z + ZC_DAK + 2 * pr); wvS[i][j] = ldg<unsigned>(z + ZC_DAV + 2 * lane + 128 * j);
                    csaS[i][j] = ldgf(rp + (i16 & 7)); snaS[i][j] = ldgf(rp + 8 + (i16 & 7)); }
#pragma unroll
                for (int j = 0; j < 2; ++j) { const int pr = lane + 64 * j, i32 = pr & 31; const float* rp = (i32 < 16) ? rr : rc;
                    wrqS[i][j] = ldg<unsigned>(z + ZC_RQ + 2 * pr); wrkS[i][j] = ldg<unsigned>(z + ZC_RK + 2 * pr);
                    csrS[i][j] = ldgf(rp + 16 + (i32 & 15)); snrS[i][j] = ldgf(rp + 32 + (i32 & 15)); }
            }
        }
        __builtin_amdgcn_sched_barrier(0);
#pragma unroll
        for (int i = 0; i < PT / 8; ++i) {
            const int tok = F.wave * (PT / 8) + i, kidx = tt.kidx0 + tok, pF = tt.pF0 + tok;
            if (tok >= tt.n) break;
            unsigned wq[3], wk[3], wv[3], wrq[2], wrk[2]; float csa[3], sna[3], csr[2], snr[2];
#pragma unroll
            for (int j = 0; j < 3; ++j) { wq[j] = wqS[i][j]; wk[j] = wkS[i][j]; wv[j] = wvS[i][j]; csa[j] = csaS[i][j]; sna[j] = snaS[i][j]; }
#pragma unroll
            for (int j = 0; j < 2; ++j) { wrq[j] = wrqS[i][j]; wrk[j] = wrkS[i][j]; csr[j] = csrS[i][j]; snr[j] = snrS[i][j]; }
#pragma unroll
            for (int j = 0; j < 3; ++j) {
                const int pr = lane + 64 * j, hm = pr >> 4, i16 = pr & 15;
                const float cs = tt.isctx ? 1.f : csa[j], sn = tt.isctx ? 0.f : sna[j];
                const size_t o = ((size_t)(tt.b * 12 + hm) * SK + kidx) * 32 + 2 * i16;
                { const unsigned w = wq[j]; const float x1 = bflo(w) * C2_DA, x2 = bfhi(w) * C2_DA;
                  stg<unsigned>(F.QFDA + o, cvt_pk(x1, x2));
                  stg<unsigned>(F.QRDA + o, cvt_pk(x1 * cs - x2 * sn, x1 * sn + x2 * cs));
                  const float n2 = rsum16(x1 * x1 + x2 * x2);
                  if (i16 == 0) stg<float>(F.qn_da + (size_t)(tt.b * 12 + hm) * SK + kidx, sqrtf(n2)); }
                { const unsigned w = wk[j]; const float x1 = bflo(w), x2 = bfhi(w);
                  stg<unsigned>(F.KDA + o, cvt_pk(x1 * cs - x2 * sn, x1 * sn + x2 * cs));
                  const float n2 = rsum16(x1 * x1 + x2 * x2);
                  kmx[j] = fmaxf(kmx[j], n2); }
            }
#pragma unroll
            for (int j = 0; j < 3; ++j) { const int col = 2 * lane + 128 * j; const unsigned w = wv[j];
                vt[col * VT_PITCH + tok] = (bf16_t)(w & 0xffffu); vt[(col + 1) * VT_PITCH + tok] = (bf16_t)(w >> 16); }
#pragma unroll
            for (int j = 0; j < 2; ++j) {
                const int pr = lane + 64 * j, h = pr >> 5, i32 = pr & 31;
                const float cs = tt.isctx ? 1.f : csr[j], sn = tt.isctx ? 0.f : snr[j];
                const size_t o = ((size_t)(tt.b * 4 + h) * SK + pF) * 64 + 2 * i32;
                { const unsigned w = wrq[j]; const float x1 = bflo(w), x2 = bfhi(w);
                  stg<unsigned>(F.retq + o, cvt_pk(x1 * cs - x2 * sn, x1 * sn + x2 * cs)); }
                { const unsigned w = wrk[j]; const float x1 = bflo(w) * 0.125f, x2 = bfhi(w) * 0.125f;
                  stg<unsigned>(F.retk + o, cvt_pk(x1 * cs - x2 * sn, x1 * sn + x2 * cs)); }
            }
        }
        if ((lane & 15) == 0) {
#pragma unroll
            for (int j = 0; j < 3; ++j) __hip_atomic_fetch_max(lmax + ((lane + 64 * j) >> 4), __float_as_uint(kmx[j]), __ATOMIC_RELAXED, __HIP_MEMORY_SCOPE_WORKGROUP);
        }
        __syncthreads();
        if (F.tid < 12) atomicMax(F.kmax_da + l * 24 + tt.b * 12 + F.tid, lmax[F.tid]);
        vt_writeout(F, F.VTDA + (size_t)tt.b * 384 * SK, tt.kidx0, tt.n);
    }
}

__device__ __forceinline__ void phase_post2(const Params& p, const Frame& F, int l) {
    LAS bf16_t* vt = (LAS bf16_t*)F.lds;
    LAS unsigned* lmax = (LAS unsigned*)(F.lds + 65536);
    const int lane = F.lane;
    for (int u = F.bid; u < NU_POST; u += F.G) {
        const TokTile tt = tok_tile(u);
        float kmx[6] = {0.f, 0.f, 0.f, 0.f, 0.f, 0.f};
        if (F.tid < 6) lmax[F.tid] = 0u;
        __syncthreads();
        u32x2 wcqS[PT / 8]; unsigned wckvS[PT / 8], wqS[PT / 8][5], wknS[PT / 8][3], wvvS[PT / 8][3], wpeS[PT / 8]; float csqS[PT / 8][5], snqS[PT / 8][5], cspeS[PT / 8], snpeS[PT / 8];
#pragma unroll
        for (int i = 0; i < PT / 8; ++i) {
            const int tok = F.wave * (PT / 8) + i, row = tt.r0 + tok, pos = tt.pos0 + tok;
            wcqS[i] = (u32x2){0u, 0u}; wckvS[i] = 0u; wpeS[i] = 0u; cspeS[i] = 0.f; snpeS[i] = 0.f;
#pragma unroll
            for (int j = 0; j < 5; ++j) { wqS[i][j] = 0u; csqS[i][j] = 0.f; snqS[i][j] = 0.f; }
#pragma unroll
            for (int j = 0; j < 3; ++j) { wknS[i][j] = 0u; wvvS[i][j] = 0u; }
            if (tok < tt.n) {
                const bf16_t* z = F.Z + (size_t)row * NINP; const bf16_t* z2 = F.Z2 + (size_t)row * N2P;
                const float* rr = F.rope + (pos >> 6) * 48; const float* rc = F.rope + (pos & 63) * 48;
                wcqS[i] = ldg<u32x2>(z + ZC_CQ + 4 * lane); wckvS[i] = ldg<unsigned>(z + ZC_CKV + 2 * lane);
#pragma unroll
                for (int j = 0; j < 5; ++j) { const int pr = lane + 64 * j; wqS[i][j] = (pr < 288) ? ldg<unsigned>(z2 + 2 * pr) : 0u; }
#pragma unroll
                for (int j = 0; j < 3; ++j) { const int pr = lane + 64 * j, h = pr >> 5, i32 = pr & 31; wknS[i][j] = ldg<unsigned>(z2 + KVC0 + h * 128 + 2 * i32); wvvS[i][j] = ldg<unsigned>(z2 + KVC0 + h * 128 + 64 + 2 * i32); }
                wpeS[i] = ldg<unsigned>(z + ZC_KPE + 2 * (lane & 15));
#pragma unroll
                for (int j = 0; j < 5; ++j) { const int pr = lane + 64 * j, i48 = pr % 48, i16 = (i48 - 32) & 15; const float* rp = (i16 < 8) ? rr : rc; csqS[i][j] = ldgf(rp + (i16 & 7)); snqS[i][j] = ldgf(rp + 8 + (i16 & 7)); }
                { const int i16 = lane & 15; const float* rp = (i16 < 8) ? rr : rc; cspeS[i] = ldgf(rp + (i16 & 7)); snpeS[i] = ldgf(rp + 8 + (i16 & 7)); }
            }
        }
        __builtin_amdgcn_sched_barrier(0);
#pragma unroll
        for (int i = 0; i < PT / 8; ++i) {
            const int tok = F.wave * (PT / 8) + i, kidx = tt.kidx0 + tok;
            if (tok >= tt.n) break;
            const u32x2 wcq = wcqS[i]; const unsigned wckv = wckvS[i], wpe = wpeS[i]; const float cspe = cspeS[i], snpe = snpeS[i];
            unsigned wq[5], wkn[3], wvv[3]; float csq[5], snq[5];
#pragma unroll
            for (int j = 0; j < 5; ++j) { wq[j] = wqS[i][j]; csq[j] = csqS[i][j]; snq[j] = snqS[i][j]; }
#pragma unroll
            for (int j = 0; j < 3; ++j) { wkn[j] = wknS[i][j]; wvv[j] = wvvS[i][j]; }
            float rinv_q, rinv_kv;
            { const float a = bflo(wcq.x), b = bfhi(wcq.x), c = bflo(wcq.y), d = bfhi(wcq.y);
              rinv_q = rsqrtf(wsum(a * a + b * b + c * c + d * d) * (1.0f / 256.0f) + 1e-6f); }
            { const float a = bflo(wckv), b = bfhi(wckv);
              rinv_kv = rsqrtf(wsum(a * a + b * b) * (1.0f / 128.0f) + 1e-6f); }
            float qs[6] = {0.f, 0.f, 0.f, 0.f, 0.f, 0.f};
#pragma unroll
            for (int j = 0; j < 5; ++j) {
                const int pr = lane + 64 * j;
                if (pr < 288) {
                    const int h = pr / 48, i48 = pr - h * 48;
                    const unsigned w = wq[j]; const float x1 = bflo(w) * rinv_q, x2 = bfhi(w) * rinv_q;
                    const size_t qo = ((size_t)(tt.b * 6 + h) * SK + kidx);
                    if (i48 < 32) stg<unsigned>(F.QRMLA + qo * 96 + 2 * i48, cvt_pk(x1, x2));
                    else { const int i16 = i48 - 32; const float cs = tt.isctx ? 1.f : csq[j], sn = tt.isctx ? 0.f : snq[j];
                        stg<unsigned>(F.QPE + qo * 32 + 2 * i16, cvt_pk(x1, x2));
                        stg<unsigned>(F.QRMLA + qo * 96 + 64 + 2 * i16, cvt_pk(x1 * cs - x2 * sn, x1 * sn + x2 * cs)); }
                    const float n2 = x1 * x1 + x2 * x2;
#pragma unroll
                    for (int hh = 0; hh < 6; ++hh) qs[hh] += (h == hh) ? n2 : 0.f;
                }
            }
#pragma unroll
            for (int hh = 0; hh < 6; ++hh) { const float s = wsum(qs[hh]); if (lane == hh) stg<float>(F.qn_mla + (size_t)(tt.b * 6 + hh) * SK + kidx, sqrtf(s)); }
            float pe2 = 0.f;
            { const int i16 = lane & 15; const unsigned w = wpe; const float x1 = bflo(w), x2 = bfhi(w);
              const float cs = tt.isctx ? 1.f : cspe, sn = tt.isctx ? 0.f : snpe;
              const unsigned pk = cvt_pk(x1 * cs - x2 * sn, x1 * sn + x2 * cs);
              if (lane < 16) {
#pragma unroll
                  for (int h = 0; h < 6; ++h) stg<unsigned>(F.KMLA + ((size_t)(tt.b * 6 + h) * SK + kidx) * 96 + 64 + 2 * i16, pk); }
              pe2 = rsum16(x1 * x1 + x2 * x2); }
#pragma unroll
            for (int j = 0; j < 3; ++j) {
                const int pr = lane + 64 * j, h = pr >> 5, i32 = pr & 31;
                const unsigned w = wkn[j]; const float x1 = bflo(w) * rinv_kv, x2 = bfhi(w) * rinv_kv;
                stg<unsigned>(F.KMLA + ((size_t)(tt.b * 6 + h) * SK + kidx) * 96 + 2 * i32, cvt_pk(x1, x2));
                const float n2 = add_xor16(rsum16(x1 * x1 + x2 * x2));
                kmx[2 * j] = fmaxf(kmx[2 * j], (lane < 32) ? n2 + pe2 : 0.f); kmx[2 * j + 1] = fmaxf(kmx[2 * j + 1], (lane >= 32) ? n2 + pe2 : 0.f);
                const unsigned wv = wvv[j];
                const unsigned pv = cvt_pk(bflo(wv) * rinv_kv, bfhi(wv) * rinv_kv);
                const int col = h * 64 + 2 * i32;
                vt[col * VT_PITCH + tok] = (bf16_t)(pv & 0xffffu); vt[(col + 1) * VT_PITCH + tok] = (bf16_t)(pv >> 16);
            }
        }
        if (lane == 0 || lane == 32) {
#pragma unroll
            for (int j = 0; j < 3; ++j) { const int h = 2 * j + (lane >> 5); __hip_atomic_fetch_max(lmax + h, __float_as_uint(lane == 0 ? kmx[2 * j] : kmx[2 * j + 1]), __ATOMIC_RELAXED, __HIP_MEMORY_SCOPE_WORKGROUP); }
        }
        __syncthreads();
        if (F.tid < 6) atomicMax(F.kmax_mla + l * 12 + tt.b * 6 + F.tid, lmax[F.tid]);
        vt_writeout(F, F.VTMLA + (size_t)tt.b * 384 * SK, tt.kidx0, tt.n);
    }
}

#define MFMA32(a, b, c) __builtin_amdgcn_mfma_f32_32x32x16_bf16(a, b, c, 0, 0, 0)
struct AttnArgs {
    const bf16_t *qr0, *qr1, *qf0, *qf1;
    const bf16_t* qpe;
    const bf16_t *k0, *k1;
    const bf16_t* vt;
    const float *qn0, *qn1; float kmax0, kmax1;
    int q0, t0, t1;
    bf16_t* y; int yrow0;
    float lam, post; const float* subg;
};
template <int DQK, bool DA>
__device__ __forceinline__ void attn_item(const Frame& F, const AttnArgs& A) {
    constexpr int NST = DQK / 16, NKC = DQK / 8, KREG = NKC * 2048, BUFB = KREG + 16384, NKL = NKC / 4;
    const int tid = F.tid, lane = F.lane, r = lane & 31, hh = lane >> 5, wave = F.wave;
    const int qk = A.q0 + wave * 32 + r;
    const int kkey = tid & 127, kch0 = tid >> 7;
    unsigned voffb[2];
#pragma unroll
    for (int j = 0; j < 2; ++j) { const int item = tid + 512 * j, vd = item >> 4, c = (item & 15) ^ (vd & 15); voffb[j] = (unsigned)(vd * SK + c * 8) * 2u; }
    const int kl0 = hh * 2048 + pi32(r) * 16;
    const int vl0 = r * 256, vsw = r & 15;
    unsigned o0p[16];
#pragma unroll
    for (int i = 0; i < 16; ++i) o0p[i] = 0u;
    f32x16 O[2]; float inv = 0.f;
#pragma nounroll
    for (int m = 0; m < (DA ? 2 : 1); ++m) {
        const bf16_t* qrp = (DA && m) ? A.qr1 : A.qr0; const bf16_t* qfp = (DA && m) ? A.qf1 : A.qf0;
        const char* kbase = (const char*)((DA && m) ? A.k1 : A.k0);
        const float bound = ldgf(((DA && m) ? A.qn1 : A.qn0) + qk) * ((DA && m) ? A.kmax1 : A.kmax0);
        f32x16 cinit;
#pragma unroll
        for (int i = 0; i < 16; ++i) { cinit[i] = -bound; O[0][i] = 0.f; O[1][i] = 0.f; }
        float lsum = 0.f;
        constexpr bool LSUM_MFMA = false;
        const bf16x8 ones8 = __builtin_bit_cast(bf16x8, (u32x4){0x3F803F80u, 0x3F803F80u, 0x3F803F80u, 0x3F803F80u});
        f32x16 Lacc;
#pragma unroll
        for (int i = 0; i < 16; ++i) Lacc[i] = 0.f;
        bf16x8 qf[NST];
        const unsigned kdma = (unsigned)((kch0) * 2048 + (kkey & 64) * 16);
        const unsigned vdma = (unsigned)(KREG + (tid & ~63) * 16);
#define ATT_LOADG(t, bsel) do { LAS unsigned char* db_ = F.lds + (bsel) * BUFB; \
            _Pragma("unroll") for (int j_ = 0; j_ < NKL; ++j_) __builtin_amdgcn_global_load_lds((const unsigned*)(kbase + (size_t)(t) * (128 * DQK * 2) + (unsigned)(kkey * DQK + (kch0 + 4 * j_) * 8) * 2u), \
                (LAS unsigned*)(db_ + __builtin_amdgcn_readfirstlane(kdma) + j_ * 8192), 16, 0, 0); \
            _Pragma("unroll") for (int j_ = 0; j_ < 2; ++j_) __builtin_amdgcn_global_load_lds((const unsigned*)((const char*)A.vt + (size_t)(t) * 256 + voffb[j_]), \
                (LAS unsigned*)(db_ + __builtin_amdgcn_readfirstlane(vdma) + j_ * 8192), 16, 0, 0); } while (0)
        bf16x8 kf[NST], vf[2][4]; f32x16 sv[2]; u32x4 pb[2][2];
#pragma unroll
        for (int i = 0; i < 4; ++i) vf[1][i] = __builtin_bit_cast(bf16x8, (u32x4){0u, 0u, 0u, 0u});
        pb[1][0] = (u32x4){0u, 0u, 0u, 0u}; pb[1][1] = pb[1][0];
        __syncthreads();
        ATT_LOADG(A.t0, 0);
        int t = A.t0;
#pragma nounroll
        for (int seg = 0; seg < 2; ++seg) {
            const int tend = (seg == 0) ? (A.t1 < 128 ? A.t1 : 128) : A.t1;
            if (t >= tend) continue;
#pragma unroll
            for (int st = 0; st < NST; ++st) {
                const bf16_t* src;
                if (DQK == 32) src = (seg ? qfp : qrp) + (size_t)qk * 32 + st * 16 + hh * 8;
                else src = (seg && st >= 4) ? A.qpe + (size_t)qk * 32 + (st - 4) * 16 + hh * 8 : qrp + (size_t)qk * 96 + st * 16 + hh * 8;
                qf[st] = __builtin_bit_cast(bf16x8, ldg16(src)); }
#pragma unroll
            for (int st = 0; st < NST; ++st) asm volatile("" : "+v"(qf[st]));
        for (; t < tend; ++t) {
            const int bsel = (t - A.t0) & 1;
            LAS unsigned char* buf = F.lds + bsel * BUFB;
            asm volatile("s_waitcnt vmcnt(0)" ::: "memory");
            __syncthreads();
#define ATT_RK(j) do { _Pragma("unroll") for (int st_ = 0; st_ < NST; ++st_) kf[st_] = *(const LAS bf16x8*)(buf + st_ * 4096 + kl0 + (j) * 512); } while (0)
#define ATT_RV(j, set) do { _Pragma("unroll") for (int vt_ = 0; vt_ < 2; ++vt_) _Pragma("unroll") for (int s2_ = 0; s2_ < 2; ++s2_) \
                vf[set][vt_ * 2 + s2_] = *(const LAS bf16x8*)(buf + KREG + vt_ * 8192 + vl0 + (((4 * (j) + 2 * s2_ + hh) ^ vsw) << 4)); } while (0)
#define ATT_S(set) do { sv[set] = cinit; _Pragma("unroll") for (int st_ = 0; st_ < NST; ++st_) sv[set] = MFMA32(kf[st_], qf[st_], sv[set]); } while (0)
#define ATT_PV(set, vset) do { _Pragma("unroll") for (int vt_ = 0; vt_ < 2; ++vt_) _Pragma("unroll") for (int s2_ = 0; s2_ < 2; ++s2_) \
                O[vt_] = MFMA32(vf[vset][vt_ * 2 + s2_], __builtin_bit_cast(bf16x8, pb[set][s2_]), O[vt_]); \
                if (LSUM_MFMA) { _Pragma("unroll") for (int s2_ = 0; s2_ < 2; ++s2_) Lacc = MFMA32(ones8, __builtin_bit_cast(bf16x8, pb[set][s2_]), Lacc); } } while (0)
#define ATT_EXP(set) do { float ls_ = 0.f; _Pragma("unroll") for (int i_ = 0; i_ < 16; ++i_) { sv[set][i_] = __builtin_amdgcn_exp2f(sv[set][i_]); if (!LSUM_MFMA) ls_ += sv[set][i_]; } lsum += ls_; \
                pb[set][0] = (u32x4){cvt_pk(sv[set][0], sv[set][1]), cvt_pk(sv[set][2], sv[set][3]), cvt_pk(sv[set][4], sv[set][5]), cvt_pk(sv[set][6], sv[set][7])}; \
                pb[set][1] = (u32x4){cvt_pk(sv[set][8], sv[set][9]), cvt_pk(sv[set][10], sv[set][11]), cvt_pk(sv[set][12], sv[set][13]), cvt_pk(sv[set][14], sv[set][15])}; } while (0)
            ATT_RK(0);
#pragma unroll
            for (int vt_ = 0; vt_ < 2; ++vt_)
#pragma unroll
                for (int s2_ = 0; s2_ < 2; ++s2_) { O[vt_] = MFMA32(vf[1][vt_ * 2 + s2_], __builtin_bit_cast(bf16x8, pb[1][s2_]), O[vt_]); asm volatile("" : "+v"(O[vt_])); }
#pragma unroll
            for (int st_ = 0; st_ < NST; ++st_) { sv[0] = MFMA32(kf[st_], qf[st_], st_ == 0 ? cinit : sv[0]); asm volatile("" : "+v"(sv[0])); kf[st_] = *(const LAS bf16x8*)(buf + st_ * 4096 + kl0 + 512); }
            __builtin_amdgcn_sched_barrier(0);
            if (t + 1 < A.t1) ATT_LOADG(t + 1, bsel ^ 1);
            __builtin_amdgcn_sched_barrier(0);
            static_assert(NST == 6 || NST == 2, "attn_item slot schedule");
#define ME_(i_) sv[se_][i_] = __builtin_amdgcn_exp2f(sv[se_][i_])
#define MA_(i_) ls_ += sv[se_][i_]
#define MC_(k_) pw_[k_] = cvt_pk(sv[se_][2 * (k_)], sv[se_][2 * (k_) + 1])
#define MGEND_() do { asm volatile("" : "+v"(sv[se_]), "+v"(ls_)); __builtin_amdgcn_sched_barrier(0); } while (0)
#define MS_(st_) do { if (j + 1 < 4 && (st_) < NST) { sv[so_] = MFMA32(kf[st_], qf[st_], (st_) == 0 ? cinit : sv[so_]); asm volatile("" : "+v"(sv[so_])); \
                    if (j + 2 < 4) kf[st_] = *(const LAS bf16x8*)(buf + (st_) * 4096 + kl0 + (j + 2) * 512); } } while (0)
#define MP_(vt_, s2_) do { if (j >= 1) { O[vt_] = MFMA32(vf[0][(vt_) * 2 + (s2_)], __builtin_bit_cast(bf16x8, pb[so_][s2_]), O[vt_]); asm volatile("" : "+v"(O[vt_])); } } while (0)
#pragma unroll
            for (int j = 0; j < 4; ++j) {
                const int se_ = j & 1, so_ = se_ ^ 1;
                if (j >= 1) ATT_RV(j - 1, 0);
                float ls_ = 0.f; unsigned pw_[8];
                MS_(0);       ME_(0); ME_(1); MGEND_();
                MP_(0, 0);    ME_(2); ME_(3); MA_(0); MA_(1); MGEND_();
                MS_(1);       ME_(4); ME_(5); MA_(2); MA_(3); MC_(0); asm volatile("" : "+v"(pw_[0])); MGEND_();
                MP_(1, 0);    ME_(6); ME_(7); MA_(4); MA_(5); MC_(1); asm volatile("" : "+v"(pw_[1])); MGEND_();
                MS_(2);       ME_(8); ME_(9); MA_(6); MA_(7); MC_(2); asm volatile("" : "+v"(pw_[2])); MGEND_();
                MP_(0, 1);    ME_(10); ME_(11); MA_(8); MA_(9); MC_(3); asm volatile("" : "+v"(pw_[3])); MGEND_();
                MS_(3);       ME_(12); ME_(13); MA_(10); MA_(11); MC_(4); asm volatile("" : "+v"(pw_[4])); MGEND_();
                MP_(1, 1);    ME_(14); ME_(15); MA_(12); MA_(13); MC_(5); asm volatile("" : "+v"(pw_[5])); MGEND_();
                MS_(4);       MA_(14); MC_(6); asm volatile("" : "+v"(pw_[6])); MGEND_();
                MS_(5);       MA_(15); MC_(7);
                lsum += ls_; pb[se_][0] = (u32x4){pw_[0], pw_[1], pw_[2], pw_[3]}; pb[se_][1] = (u32x4){pw_[4], pw_[5], pw_[6], pw_[7]};
                asm volatile("" : "+v"(pb[se_][0]), "+v"(pb[se_][1]), "+v"(lsum));
                __builtin_amdgcn_sched_barrier(0);
            }
#undef MP_
#undef MS_
#undef MGEND_
#undef MC_
#undef MA_
#undef ME_
            ATT_RV(3, 1);
#undef ATT_RK
#undef ATT_RV
#undef ATT_S
#undef ATT_PV
#undef ATT_EXP
        }
        }
#undef ATT_LOADG
#pragma unroll
        for (int vt_ = 0; vt_ < 2; ++vt_)
#pragma unroll
            for (int s2_ = 0; s2_ < 2; ++s2_) O[vt_] = MFMA32(vf[1][vt_ * 2 + s2_], __builtin_bit_cast(bf16x8, pb[1][s2_]), O[vt_]);
        inv = LSUM_MFMA ? 1.0f / Lacc[0] : 1.0f / add_xor32(lsum);
        if (DA && m == 0) {
#pragma unroll
            for (int i = 0; i < 8; ++i) { o0p[i] = cvt_pk(O[0][2 * i] * inv, O[0][2 * i + 1] * inv); o0p[8 + i] = cvt_pk(O[1][2 * i] * inv, O[1][2 * i + 1] * inv); }
        }
    }
    bf16_t* yrow = A.y + (size_t)(A.yrow0 + wave * 32 + r) * DM;
    if (DA) {
        float ss = 0.f;
#pragma unroll
        for (int vt = 0; vt < 2; ++vt)
#pragma unroll
            for (int i = 0; i < 16; ++i) { const unsigned w = o0p[vt * 8 + (i >> 1)]; const float o0 = (i & 1) ? bfhi(w) : bflo(w);
                const float o = o0 - A.lam * (O[vt][i] * inv); O[vt][i] = o; ss += o * o; }
        ss = add_xor32(ss);
        const float rs = rsqrtf(ss * (1.0f / 64.0f) + 1e-6f) * A.post;
#pragma unroll
        for (int vt = 0; vt < 2; ++vt)
#pragma unroll
            for (int g = 0; g < 4; ++g) { const int vd = vt * 32 + 8 * g + 4 * hh; const f32x4 sg = *(const f32x4*)(A.subg + vd);
                u32x2 w; w.x = cvt_pk(O[vt][4 * g] * rs * sg[0], O[vt][4 * g + 1] * rs * sg[1]); w.y = cvt_pk(O[vt][4 * g + 2] * rs * sg[2], O[vt][4 * g + 3] * rs * sg[3]);
                *(u32x2*)(yrow + vd) = w; }
    } else {
#pragma unroll
        for (int vt = 0; vt < 2; ++vt)
#pragma unroll
            for (int g = 0; g < 4; ++g) { const int vd = vt * 32 + 8 * g + 4 * hh;
                u32x2 w; w.x = cvt_pk(O[vt][4 * g] * inv, O[vt][4 * g + 1] * inv); w.y = cvt_pk(O[vt][4 * g + 2] * inv, O[vt][4 * g + 3] * inv);
                *(u32x2*)(yrow + vd) = w; }
    }
}

__device__ __forceinline__ void attn_item_da2(const Frame& F, const AttnArgs& A) {
    constexpr int KMAP = 8192, KREG = 2 * KMAP, BUFB = KREG + 16384;
    const int tid = F.tid, lane = F.lane, r = lane & 31, hh = lane >> 5, wave = F.wave;
    const int qk = A.q0 + wave * 32 + r;
    const int kkey = tid & 127, kch0 = (tid >> 7) & 1, km = wave >> 2;
    const char* kbase = (const char*)(km ? A.k1 : A.k0);
    const unsigned kdma = (unsigned)(km * KMAP + kch0 * 2048 + (kkey & 64) * 16);
    const unsigned vdma = (unsigned)(KREG + (tid & ~63) * 16);
    unsigned voffb[2];
#pragma unroll
    for (int j = 0; j < 2; ++j) { const int item = tid + 512 * j, vd = item >> 4, c = (item & 15) ^ (vd & 15); voffb[j] = (unsigned)(vd * SK + c * 8) * 2u; }
#define DA2_LOADG(t, bsel) do { LAS unsigned char* db_ = F.lds + (bsel) * BUFB; \
        _Pragma("unroll") for (int j_ = 0; j_ < 2; ++j_) __builtin_amdgcn_global_load_lds((const unsigned*)(kbase + (size_t)(t) * (128 * 32 * 2) + (unsigned)(kkey * 32 + (kch0 + 2 * j_) * 8) * 2u), \
            (LAS unsigned*)(db_ + __builtin_amdgcn_readfirstlane(kdma) + j_ * 4096), 16, 0, 0); \
        _Pragma("unroll") for (int j_ = 0; j_ < 2; ++j_) __builtin_amdgcn_global_load_lds((const unsigned*)((const char*)A.vt + (size_t)(t) * 256 + voffb[j_]), \
            (LAS unsigned*)(db_ + __builtin_amdgcn_readfirstlane(vdma) + j_ * 8192), 16, 0, 0); } while (0)
    const int kl0 = hh * 2048 + pi32(r) * 16;
    const int vl0 = r * 256, vsw = r & 15;
    f32x16 cinit; f32x16 O[2][2]; float lsum[2] = {0.f, 0.f};
    { const float bound = fmaxf(ldgf(A.qn0 + qk) * A.kmax0, ldgf(A.qn1 + qk) * A.kmax1);
#pragma unroll
      for (int i = 0; i < 16; ++i) { cinit[i] = -bound; O[0][0][i] = 0.f; O[0][1][i] = 0.f; O[1][0][i] = 0.f; O[1][1][i] = 0.f; } }
    bf16x8 qf[2][2];
    bf16x8 kf[2], vf[4]; f32x16 sv[2]; u32x4 pb[2][2];
#pragma unroll
    for (int i = 0; i < 4; ++i) vf[i] = __builtin_bit_cast(bf16x8, (u32x4){0u, 0u, 0u, 0u});
    pb[1][0] = (u32x4){0u, 0u, 0u, 0u}; pb[1][1] = pb[1][0];
#pragma unroll
    for (int i = 0; i < 16; ++i) sv[1][i] = -1.0e30f;
    int vlo[2]; vlo[0] = vl0 + ((hh ^ (r & 3)) << 4); vlo[1] = vl0 + (((2 + hh) ^ (r & 3)) << 4);
    const int vq = (r >> 2) & 3;
    __syncthreads();
    DA2_LOADG(A.t0, 0);
    int t = A.t0;
#pragma nounroll
    for (int seg = 0; seg < 2; ++seg) {
        const int tend = (seg == 0) ? (A.t1 < 128 ? A.t1 : 128) : A.t1;
        if (t >= tend) continue;
#pragma unroll
        for (int m = 0; m < 2; ++m)
#pragma unroll
            for (int st = 0; st < 2; ++st) { const bf16_t* qa = (m == 0) ? A.qr0 : A.qr1; const bf16_t* qb = (m == 0) ? A.qf0 : A.qf1;
                qf[m][st] = __builtin_bit_cast(bf16x8, ldg16((seg ? qb : qa) + (size_t)qk * 32 + st * 16 + hh * 8)); }
#pragma unroll
        for (int m = 0; m < 2; ++m)
#pragma unroll
            for (int st = 0; st < 2; ++st) asm volatile("" : "+v"(qf[m][st]));
        for (; t < tend; ++t) {
            const int bsel = (t - A.t0) & 1;
            LAS unsigned char* buf = F.lds + bsel * BUFB;
            asm volatile("s_waitcnt vmcnt(0)" ::: "memory");
            __syncthreads();
#define DA2_RKJ(m_, jj) do { _Pragma("unroll") for (int st_ = 0; st_ < 2; ++st_) kf[st_] = *(const LAS bf16x8*)(buf + (m_) * KMAP + st_ * 4096 + kl0 + (jj) * 512); } while (0)
#define DA2_RVJ(jj) do { const int vo_ = ((jj) ^ vq) << 6; _Pragma("unroll") for (int vt_ = 0; vt_ < 2; ++vt_) _Pragma("unroll") for (int s2_ = 0; s2_ < 2; ++s2_) \
                vf[vt_ * 2 + s2_] = *(const LAS bf16x8*)(buf + KREG + vt_ * 8192 + (vlo[s2_] + vo_)); } while (0)
#define DA2_RV1(jj, idx_) do { vf[idx_] = *(const LAS bf16x8*)(buf + KREG + ((idx_) >> 1) * 8192 + (vlo[(idx_) & 1] + ((((jj)) ^ vq) << 6))); } while (0)
#define DA2_S(m_) do { sv[m_] = cinit; _Pragma("unroll") for (int st_ = 0; st_ < 2; ++st_) sv[m_] = MFMA32(kf[st_], qf[m_][st_], sv[m_]); } while (0)
#define DA2_PV(m_) do { _Pragma("unroll") for (int vt_ = 0; vt_ < 2; ++vt_) _Pragma("unroll") for (int s2_ = 0; s2_ < 2; ++s2_) \
                O[m_][vt_] = MFMA32(vf[vt_ * 2 + s2_], __builtin_bit_cast(bf16x8, pb[m_][s2_]), O[m_][vt_]); } while (0)
#define DA2_EXP(m_) do { float ls_ = 0.f; _Pragma("unroll") for (int i_ = 0; i_ < 16; ++i_) { sv[m_][i_] = __builtin_amdgcn_exp2f(sv[m_][i_]); ls_ += sv[m_][i_]; } lsum[m_] += ls_; \
                pb[m_][0] = (u32x4){cvt_pk(sv[m_][0], sv[m_][1]), cvt_pk(sv[m_][2], sv[m_][3]), cvt_pk(sv[m_][4], sv[m_][5]), cvt_pk(sv[m_][6], sv[m_][7])}; \
                pb[m_][1] = (u32x4){cvt_pk(sv[m_][8], sv[m_][9]), cvt_pk(sv[m_][10], sv[m_][11]), cvt_pk(sv[m_][12], sv[m_][13]), cvt_pk(sv[m_][14], sv[m_][15])}; } while (0)
            DA2_RKJ(0, 0);
            { float ls_ = 0.f;
              sv[0] = MFMA32(kf[0], qf[0][0], cinit); asm volatile("" : "+v"(sv[0]));
#pragma unroll
              for (int i = 8; i < 12; ++i) sv[1][i] = __builtin_amdgcn_exp2f(sv[1][i]);
              asm volatile("" : "+v"(sv[1])); __builtin_amdgcn_sched_barrier(0);
              sv[0] = MFMA32(kf[1], qf[0][1], sv[0]); asm volatile("" : "+v"(sv[0]));
#pragma unroll
              for (int i = 12; i < 16; ++i) sv[1][i] = __builtin_amdgcn_exp2f(sv[1][i]);
#pragma unroll
              for (int i = 8; i < 16; ++i) ls_ += sv[1][i];
              lsum[1] += ls_;
              pb[1][1] = (u32x4){cvt_pk(sv[1][8], sv[1][9]), cvt_pk(sv[1][10], sv[1][11]), cvt_pk(sv[1][12], sv[1][13]), cvt_pk(sv[1][14], sv[1][15])};
              asm volatile("" : "+v"(pb[1][1]), "+v"(lsum[1])); }
            DA2_RKJ(1, 0);
            __builtin_amdgcn_sched_barrier(0);
#define XE_(i_) sv[me_][i_] = __builtin_amdgcn_exp2f(sv[me_][i_])
#define XA_(i_) ls_ += sv[me_][i_]
#define XC_(k_) pw_[k_] = cvt_pk(sv[me_][2 * (k_)], sv[me_][2 * (k_) + 1])
#define GEND_() do { asm volatile("" : "+v"(sv[me_]), "+v"(ls_)); __builtin_amdgcn_sched_barrier(0); } while (0)
#define DA2_HALF(ME, MO, doS_, PRE_, MID_, VA_, VB_, VC_) do { constexpr int me_ = (ME), mo_ = (MO); PRE_; float ls_ = 0.f; unsigned pw_[8]; \
                if (doS_) { sv[mo_] = MFMA32(kf[0], qf[mo_][0], cinit); asm volatile("" : "+v"(sv[mo_])); } \
                XE_(0); XE_(1); XE_(2); GEND_(); \
                O[mo_][0] = MFMA32(vf[0], __builtin_bit_cast(bf16x8, pb[mo_][0]), O[mo_][0]); asm volatile("" : "+v"(O[mo_][0])); \
                XE_(3); XE_(4); XE_(5); XA_(0); XA_(1); XA_(2); GEND_(); \
                VA_; \
                if (doS_) { sv[mo_] = MFMA32(kf[1], qf[mo_][1], sv[mo_]); asm volatile("" : "+v"(sv[mo_])); } \
                XE_(6); XE_(7); XE_(8); XA_(3); XA_(4); XA_(5); XC_(0); asm volatile("" : "+v"(pw_[0])); GEND_(); \
                MID_; \
                O[mo_][1] = MFMA32(vf[2], __builtin_bit_cast(bf16x8, pb[mo_][0]), O[mo_][1]); asm volatile("" : "+v"(O[mo_][1])); \
                XE_(9); XE_(10); XE_(11); XA_(6); XA_(7); XA_(8); XC_(1); XC_(2); asm volatile("" : "+v"(pw_[1]), "+v"(pw_[2])); GEND_(); \
                VB_; \
                O[mo_][0] = MFMA32(vf[1], __builtin_bit_cast(bf16x8, pb[mo_][1]), O[mo_][0]); asm volatile("" : "+v"(O[mo_][0])); \
                XE_(12); XE_(13); XA_(9); XA_(10); XA_(11); XC_(3); XC_(4); asm volatile("" : "+v"(pw_[3]), "+v"(pw_[4])); GEND_(); \
                VC_; \
                O[mo_][1] = MFMA32(vf[3], __builtin_bit_cast(bf16x8, pb[mo_][1]), O[mo_][1]); asm volatile("" : "+v"(O[mo_][1])); \
                XE_(14); XE_(15); XA_(12); XA_(13); XA_(14); XA_(15); XC_(5); XC_(6); XC_(7); \
                lsum[me_] += ls_; pb[me_][0] = (u32x4){pw_[0], pw_[1], pw_[2], pw_[3]}; pb[me_][1] = (u32x4){pw_[4], pw_[5], pw_[6], pw_[7]}; \
                asm volatile("" : "+v"(pb[me_][0]), "+v"(pb[me_][1]), "+v"(lsum[me_])); __builtin_amdgcn_sched_barrier(0); } while (0)
#pragma unroll
            for (int j = 0; j < 4; ++j) {
                DA2_HALF(0, 1, true, (void)0, if (j < 3) DA2_RKJ(0, j + 1), DA2_RV1(j, 0), DA2_RV1(j, 2), DA2_RV1(j, 1));
                if (j == 0) { if (t + 1 < A.t1) DA2_LOADG(t + 1, bsel ^ 1); __builtin_amdgcn_sched_barrier(0); }
                if (j < 3) DA2_HALF(1, 0, true, DA2_RV1(j, 3), DA2_RKJ(1, j + 1), (void)0, (void)0, (void)0);
                else { constexpr int me_ = 1; DA2_RV1(j, 3); float ls_ = 0.f; unsigned pw_[8];
                    O[0][0] = MFMA32(vf[0], __builtin_bit_cast(bf16x8, pb[0][0]), O[0][0]); asm volatile("" : "+v"(O[0][0]));
                    XE_(0); XE_(1); XE_(2); GEND_();
                    O[0][1] = MFMA32(vf[2], __builtin_bit_cast(bf16x8, pb[0][0]), O[0][1]); asm volatile("" : "+v"(O[0][1]));
                    XE_(3); XE_(4); XE_(5); XA_(0); XA_(1); XA_(2); XC_(0); asm volatile("" : "+v"(pw_[0])); GEND_();
                    O[0][0] = MFMA32(vf[1], __builtin_bit_cast(bf16x8, pb[0][1]), O[0][0]); asm volatile("" : "+v"(O[0][0]));
                    XE_(6); XE_(7); XA_(3); XA_(4); XA_(5); XC_(1); XC_(2); asm volatile("" : "+v"(pw_[1]), "+v"(pw_[2])); GEND_();
                    O[0][1] = MFMA32(vf[3], __builtin_bit_cast(bf16x8, pb[0][1]), O[0][1]); asm volatile("" : "+v"(O[0][1]));
                    XA_(6); XA_(7); XC_(3);
                    lsum[1] += ls_; pb[1][0] = (u32x4){pw_[0], pw_[1], pw_[2], pw_[3]};
                    asm volatile("" : "+v"(pb[1][0]), "+v"(lsum[1]), "+v"(sv[1])); __builtin_amdgcn_sched_barrier(0); }
            }
#undef DA2_HALF
#undef GEND_
#undef XC_
#undef XA_
#undef XE_
        }
    }
    { float ls_ = 0.f;
#pragma unroll
      for (int i = 8; i < 16; ++i) { sv[1][i] = __builtin_amdgcn_exp2f(sv[1][i]); ls_ += sv[1][i]; }
      lsum[1] += ls_;
      pb[1][1] = (u32x4){cvt_pk(sv[1][8], sv[1][9]), cvt_pk(sv[1][10], sv[1][11]), cvt_pk(sv[1][12], sv[1][13]), cvt_pk(sv[1][14], sv[1][15])}; }
    DA2_PV(1);
#undef DA2_RKJ
#undef DA2_RVJ
#undef DA2_RV1
#undef DA2_S
#undef DA2_PV
#undef DA2_EXP
#undef DA2_LOADG
    const float inv0 = 1.0f / add_xor32(lsum[0]), inv1 = A.lam / add_xor32(lsum[1]);
    bf16_t* yrow = A.y + (size_t)(A.yrow0 + wave * 32 + r) * DM;
    float ss = 0.f;
#pragma unroll
    for (int vt = 0; vt < 2; ++vt)
#pragma unroll
        for (int i = 0; i < 16; ++i) { const float o = O[0][vt][i] * inv0 - O[1][vt][i] * inv1; O[0][vt][i] = o; ss += o * o; }
    ss = add_xor32(ss);
    const float rs = rsqrtf(ss * (1.0f / 64.0f) + 1e-6f) * A.post;
#pragma unroll
    for (int vt = 0; vt < 2; ++vt)
#pragma unroll
        for (int g = 0; g < 4; ++g) { const int vd = vt * 32 + 8 * g + 4 * hh; const f32x4 sg = *(const f32x4*)(A.subg + vd);
            u32x2 w; w.x = cvt_pk(O[0][vt][4 * g] * rs * sg[0], O[0][vt][4 * g + 1] * rs * sg[1]); w.y = cvt_pk(O[0][vt][4 * g + 2] * rs * sg[2], O[0][vt][4 * g + 3] * rs * sg[3]);
            *(u32x2*)(yrow + vd) = w; }
}

__device__ __forceinline__ int ret_row0(int b, int n) { return n < 2 ? TL + b * CTXL + n * 128 : b * SEQ + (n - 2) * 128; }
__device__ __forceinline__ float log2_gamma(float d) { return -log1pf(__expf(-d)) * LOG2E; }
constexpr int RP = 72;

__device__ __forceinline__ void phase_ret_chunk_states(const Params& p, const Frame& F, int l) {
    LAS bf16_t* kt = (LAS bf16_t*)F.lds; LAS bf16_t* vtile = kt + 128 * RP;
    const int lane = F.lane, r = lane & 31, hh = lane >> 5, wave = F.wave, dir = wave >> 2, dkt = (wave >> 1) & 1, dvt = wave & 1;
    for (int it = (F.bid + F.G / 2) % F.G; it < NB * 4 * NCH; it += F.G) {
        const int n = it % NCH, bh = it / NCH, b = bh >> 2, h = bh & 3;
        const float lg2 = log2_gamma(dir ? p.ret_decay_b[l * 4 + h] : p.ret_decay_f[l * 4 + h]);
        const bf16_t* ksrc = F.retk + ((size_t)bh * SK + n * 128) * 64;
        const bf16_t* vsrc = F.Z + (size_t)ret_row0(b, n) * NINP + ZC_RV + h * 64;
        __syncthreads();
        { u32x4 gk[2], gv[2];
#pragma unroll
          for (int it2 = 0; it2 < 2; ++it2) { const int i = F.tid + 512 * it2, tok = i >> 3, c8 = (i & 7) * 8; gk[it2] = ldg<u32x4>(ksrc + tok * 64 + c8); gv[it2] = ldg<u32x4>(vsrc + (size_t)tok * NINP + c8); }
#pragma unroll
          for (int it2 = 0; it2 < 2; ++it2) { asm volatile("" : "+v"(gk[it2])); asm volatile("" : "+v"(gv[it2])); }
          __builtin_amdgcn_sched_barrier(0);
#pragma unroll
          for (int it2 = 0; it2 < 2; ++it2) { const int i = F.tid + 512 * it2, tok = i >> 3, c8 = (i & 7) * 8; *(LAS u32x4*)(kt + tok * RP + c8) = gk[it2]; *(LAS u32x4*)(vtile + tok * RP + c8) = gv[it2]; } }
        __syncthreads();
        f32x16 acc; for (int i = 0; i < 16; ++i) acc[i] = 0.f;
        const int dk = dkt * 32 + r, dv = dvt * 32 + r;
#pragma unroll
        for (int j = 0; j < 8; ++j) {
            float a[8], bv[8];
#pragma unroll
            for (int e = 0; e < 8; ++e) { const int c = 16 * j + 8 * hh + e;
                const float w = __builtin_amdgcn_exp2f(lg2 * (float)(dir ? c + 1 : 128 - c));
                a[e] = bf2f(kt[c * RP + dk]) * w; bv[e] = bf2f(vtile[c * RP + dv]); }
            const u32x4 af = (u32x4){cvt_pk(a[0], a[1]), cvt_pk(a[2], a[3]), cvt_pk(a[4], a[5]), cvt_pk(a[6], a[7])};
            const u32x4 bf = (u32x4){cvt_pk(bv[0], bv[1]), cvt_pk(bv[2], bv[3]), cvt_pk(bv[4], bv[5]), cvt_pk(bv[6], bv[7])};
            acc = MFMA32(__builtin_bit_cast(bf16x8, af), __builtin_bit_cast(bf16x8, bf), acc);
        }
        float* o = F.ust + ((size_t)(bh * NCH + n) * 2 + dir) * 4096;
#pragma unroll
        for (int i = 0; i < 16; ++i) o[(dkt * 32 + (i & 3) + 8 * (i >> 2) + 4 * hh) * 64 + dvt * 32 + r] = acc[i];
    }
}
__device__ __forceinline__ void phase_ret_scan(const Params& p, const Frame& F, int l) {
    for (int it = F.bid * 512 + F.tid; it < NB * 4 * 2 * 4096; it += F.G * 512) {
        const int e = it & 4095, dir = (it >> 12) & 1, bh = it >> 13, h = bh & 3;
        const float dec = __builtin_amdgcn_exp2f(128.0f * log2_gamma(dir ? p.ret_decay_b[l * 4 + h] : p.ret_decay_f[l * 4 + h]));
        float* base = F.ust + ((size_t)bh * NCH * 2 + dir) * 4096 + e;
        float st = 0.f;
        for (int i0 = 0; i0 < NCH; i0 += 10) {
            float u[10];
#pragma unroll
            for (int j = 0; j < 10; ++j) { const int idx = dir ? (NCH - 1 - (i0 + j)) : (i0 + j); const int n = dir ? (idx < 128 ? idx + 2 : idx - 128) : idx; u[j] = base[(size_t)n * 8192]; }
#pragma unroll
            for (int j = 0; j < 10; ++j) { const int idx = dir ? (NCH - 1 - (i0 + j)) : (i0 + j); const int n = dir ? (idx < 128 ? idx + 2 : idx - 128) : idx; base[(size_t)n * 8192] = st; st = st * dec + u[j]; }
        }
    }
}
__device__ __forceinline__ void ret_out_item(const Params& p, const Frame& F, int l, int it) {
    LAS unsigned char* lq = F.lds;
    LAS unsigned char* lk = F.lds + 16384;
    LAS bf16_t* lv = (LAS bf16_t*)(F.lds + 32768);
    LAS bf16_t* lsf = lv + 128 * RP;
    LAS bf16_t* lrb = lsf + 64 * RP;
    LAS float* lss = (LAS float*)(lrb + 64 * RP);
    const int tid = F.tid, lane = F.lane, r = lane & 31, hh = lane >> 5, wave = F.wave, qb = wave & 3, dt = wave >> 2;
    const int n = it % NCH, bh = it / NCH, b = bh >> 2, h = bh & 3;
    const float lgf = log2_gamma(p.ret_decay_f[l * 4 + h]), lgb = log2_gamma(p.ret_decay_b[l * 4 + h]);
    const int row0 = ret_row0(b, n);
    const bf16_t* qsrc = F.retq + ((size_t)bh * SK + n * 128) * 64; const bf16_t* ksrc = F.retk + ((size_t)bh * SK + n * 128) * 64;
    const bf16_t* vsrc = F.Z + (size_t)row0 * NINP + ZC_RV + h * 64;
    const float* sf = F.ust + ((size_t)(bh * NCH + n) * 2) * 4096; const float* rb = sf + 4096;
    __syncthreads();
    { u32x4 gq[2], gk[2], gv[2]; f32x4 ga[2], gb[2];
#pragma unroll
      for (int it2 = 0; it2 < 2; ++it2) { const int i = tid + 512 * it2, tok = i >> 3, ch = i & 7;
          gq[it2] = ldg<u32x4>(qsrc + tok * 64 + ch * 8); gk[it2] = ldg<u32x4>(ksrc + tok * 64 + ch * 8); gv[it2] = ldg<u32x4>(vsrc + (size_t)tok * NINP + ch * 8);
          const int dk = i >> 4, c4 = (i & 15) * 4; ga[it2] = ldg<f32x4>(sf + dk * 64 + c4); gb[it2] = ldg<f32x4>(rb + dk * 64 + c4); }
#pragma unroll
      for (int it2 = 0; it2 < 2; ++it2) { asm volatile("" : "+v"(gq[it2])); asm volatile("" : "+v"(gk[it2])); asm volatile("" : "+v"(gv[it2])); asm volatile("" : "+v"(ga[it2])); asm volatile("" : "+v"(gb[it2])); }
      __builtin_amdgcn_sched_barrier(0);
#pragma unroll
      for (int it2 = 0; it2 < 2; ++it2) { const int i = tid + 512 * it2, tok = i >> 3, ch = i & 7;
          *(LAS u32x4*)(lq + ch * 2048 + tok * 16) = gq[it2]; *(LAS u32x4*)(lk + ch * 2048 + tok * 16) = gk[it2]; *(LAS u32x4*)(lv + tok * RP + ch * 8) = gv[it2];
          const int dk = i >> 4, c4 = (i & 15) * 4; const f32x4 a = ga[it2], bb = gb[it2];
          *(LAS u32x2*)(lsf + dk * RP + c4) = (u32x2){cvt_pk(a[0], a[1]), cvt_pk(a[2], a[3])};
          *(LAS u32x2*)(lrb + dk * RP + c4) = (u32x2){cvt_pk(bb[0], bb[1]), cvt_pk(bb[2], bb[3])}; } }
    __syncthreads();
    const int cq = qb * 32 + r, dvl = dt * 32 + r;
    bf16x8 qf[4];
#pragma unroll
    for (int st = 0; st < 4; ++st) qf[st] = *(const LAS bf16x8*)(lq + (2 * st + hh) * 2048 + cq * 16);
    f32x16 O; for (int i = 0; i < 16; ++i) O[i] = 0.f;
#pragma unroll
    for (int kb = 0; kb < 4; ++kb) {
        f32x16 s; for (int i = 0; i < 16; ++i) s[i] = 0.f;
#pragma unroll
        for (int st = 0; st < 4; ++st) { const bf16x8 kf = *(const LAS bf16x8*)(lk + (2 * st + hh) * 2048 + (kb * 32 + pi32(r)) * 16); s = MFMA32(kf, qf[st], s); }
#pragma unroll
        for (int i = 0; i < 16; ++i) { const int c = 32 * kb + 16 * (i >> 3) + 8 * hh + (i & 7); const int dl = cq - c;
            s[i] *= __builtin_amdgcn_exp2f(dl >= 0 ? lgf * (float)dl : lgb * (float)(-dl)); }
#pragma unroll
        for (int s2 = 0; s2 < 2; ++s2) {
            const u32x4 pf = (u32x4){cvt_pk(s[8 * s2], s[8 * s2 + 1]), cvt_pk(s[8 * s2 + 2], s[8 * s2 + 3]), cvt_pk(s[8 * s2 + 4], s[8 * s2 + 5]), cvt_pk(s[8 * s2 + 6], s[8 * s2 + 7])};
            unsigned short ve[8];
#pragma unroll
            for (int e = 0; e < 8; ++e) ve[e] = lv[(32 * kb + 16 * s2 + 8 * hh + e) * RP + dvl];
            const u32x4 vf = (u32x4){(unsigned)ve[0] | ((unsigned)ve[1] << 16), (unsigned)ve[2] | ((unsigned)ve[3] << 16), (unsigned)ve[4] | ((unsigned)ve[5] << 16), (unsigned)ve[6] | ((unsigned)ve[7] << 16)};
            O = MFMA32(__builtin_bit_cast(bf16x8, vf), __builtin_bit_cast(bf16x8, pf), O);
        }
    }
    f32x16 xf, xb; for (int i = 0; i < 16; ++i) { xf[i] = 0.f; xb[i] = 0.f; }
#pragma unroll
    for (int st = 0; st < 4; ++st) {
        unsigned short se[8], re[8];
#pragma unroll
        for (int e = 0; e < 8; ++e) { se[e] = lsf[(16 * st + 8 * hh + e) * RP + dvl]; re[e] = lrb[(16 * st + 8 * hh + e) * RP + dvl]; }
        const u32x4 sfv = (u32x4){(unsigned)se[0] | ((unsigned)se[1] << 16), (unsigned)se[2] | ((unsigned)se[3] << 16), (unsigned)se[4] | ((unsigned)se[5] << 16), (unsigned)se[6] | ((unsigned)se[7] << 16)};
        const u32x4 rbv = (u32x4){(unsigned)re[0] | ((unsigned)re[1] << 16), (unsigned)re[2] | ((unsigned)re[3] << 16), (unsigned)re[4] | ((unsigned)re[5] << 16), (unsigned)re[6] | ((unsigned)re[7] << 16)};
        xf = MFMA32(__builtin_bit_cast(bf16x8, sfv), qf[st], xf); xb = MFMA32(__builtin_bit_cast(bf16x8, rbv), qf[st], xb);
    }
    const float wf = __builtin_amdgcn_exp2f(lgf * (float)cq), wb = __builtin_amdgcn_exp2f(lgb * (float)(127 - cq));
    float ss = 0.f;
#pragma unroll
    for (int i = 0; i < 16; ++i) { O[i] += wf * xf[i] + wb * xb[i]; ss += O[i] * O[i]; }
    ss = add_xor32(ss);
    if (hh == 0) lss[wave * 32 + r] = ss;
    __syncthreads();
    ss += lss[(wave ^ 4) * 32 + r];
    const float rs = rsqrtf(ss * (1.0f / 64.0f) + 1e-6f);
    const bf16_t* grow = F.Z + (size_t)(row0 + cq) * NINP + ZC_RG + h * 64;
    bf16_t* yrow = F.H + (size_t)(row0 + cq) * DM + 768 + h * 64;
#pragma unroll
    for (int g = 0; g < 4; ++g) { const int dv = dt * 32 + 8 * g + 4 * hh; const u32x2 gw = *(const u32x2*)(grow + dv);
        const float g0 = bflo(gw.x), g1 = bfhi(gw.x), g2 = bflo(gw.y), g3 = bfhi(gw.y);
        u32x2 w; w.x = cvt_pk(O[4 * g] * rs * siluf(g0), O[4 * g + 1] * rs * siluf(g1)); w.y = cvt_pk(O[4 * g + 2] * rs * siluf(g2), O[4 * g + 3] * rs * siluf(g3));
        *(u32x2*)(yrow + dv) = w; }
}

__device__ __forceinline__ void phase_ln1(const Params& p, const Frame& F, int l) {
    const int lane = F.lane;
    const float* g = p.ln1_g + l * DM; const float* bta = p.ln1_b + l * DM;
    LAS float* wt = (LAS float*)F.lds;
    for (int i = F.bid * 512 + F.tid; i < MAXPAN * 256; i += F.G * 512) F.gidx[i] = 0;
    __syncthreads();
    { f32x4 w[2][4];
#pragma unroll
      for (int it = 0; it < 2; ++it)
#pragma unroll
          for (int q4 = 0; q4 < 4; ++q4) w[it][q4] = ldg<f32x4>(p.router_w + (size_t)(F.tid + 512 * it) * 16 + 4 * q4);
#pragma unroll
      for (int it = 0; it < 2; ++it)
#pragma unroll
          for (int q4 = 0; q4 < 4; ++q4) asm volatile("" : "+v"(w[it][q4]));
      __builtin_amdgcn_sched_barrier(0);
#pragma unroll
      for (int it = 0; it < 2; ++it)
#pragma unroll
          for (int q4 = 0; q4 < 4; ++q4)
#pragma unroll
              for (int e = 0; e < 4; ++e) wt[(4 * q4 + e) * DM + F.tid + 512 * it] = w[it][q4][e]; }
    __syncthreads();
    LAS int* lcnt = (LAS int*)(F.lds + 65536);
    if (F.tid < 32) lcnt[F.tid] = 0;
    __syncthreads();
    float rb = p.router_b[(lane >> 2) & 15];
    const int MT = (l == DEPTH - 1) ? TL : TT;
    LAS float* pv = (LAS float*)(F.lds + 66560);
    { float t[2][8];
#pragma unroll
      for (int it = 0; it < 2; ++it) { const int c = F.tid + 512 * it; t[it][0] = ldgf(g + c); t[it][1] = ldgf(bta + c);
#pragma unroll
          for (int sg = 0; sg < 3; ++sg) { const float* md = F.mods + ((size_t)l * 3 + sg) * 6144; t[it][2 + 2 * sg] = ldgf(md + 3 * DM + c); t[it][3 + 2 * sg] = ldgf(md + 4 * DM + c); } }
#pragma unroll
      for (int it = 0; it < 2; ++it)
#pragma unroll
          for (int k = 0; k < 8; ++k) asm volatile("" : "+v"(t[it][k]));
      __builtin_amdgcn_sched_barrier(0);
#pragma unroll
      for (int it = 0; it < 2; ++it) { const int c = F.tid + 512 * it; pv[c] = t[it][0]; pv[DM + c] = t[it][1];
#pragma unroll
          for (int sg = 0; sg < 3; ++sg) { pv[(2 + 2 * sg) * DM + c] = t[it][2 + 2 * sg]; pv[(3 + 2 * sg) * DM + c] = 1.0f + t[it][3 + 2 * sg]; } } }
    __syncthreads();
    const int stride = F.G * 8;
#pragma nounroll
    for (int seg = 0; seg < 3; ++seg) {
    const int lo = seg * SEQ, hi = (seg < 2) ? lo + SEQ : TT;
    if (lo >= MT) break;
    const LAS float* psh = pv + (2 + 2 * seg) * DM; const LAS float* psc = psh + DM;
    for (int row = lo + F.bid * 8 + F.wave; row < hi; row += stride) {
        float* xr = xrow(p, F, row);
        f32x4 v[4];
#pragma unroll
        for (int j = 0; j < 4; ++j) v[j] = ldg<f32x4>(xr + j * 256 + lane * 4);
        float s = 0.f;
#pragma unroll
        for (int j = 0; j < 4; ++j) s += v[j][0] + v[j][1] + v[j][2] + v[j][3];
        const float mean = wsum(s) * (1.0f / DM); float q = 0.f;
#pragma unroll
        for (int j = 0; j < 4; ++j)
#pragma unroll
            for (int e = 0; e < 4; ++e) { const float d = v[j][e] - mean; q += d * d; }
        const float rstd = rsqrtf(wsum(q) * (1.0f / DM) + 1e-5f);
        float lg[16];
#pragma unroll
        for (int e = 0; e < 16; ++e) lg[e] = 0.f;
#pragma unroll
        for (int j = 0; j < 4; ++j) { const int c = j * 256 + lane * 4;
            f32x4 xn, hv;
            const f32x4 gv = *(const LAS f32x4*)(pv + c), bv = *(const LAS f32x4*)(pv + DM + c), shv = *(const LAS f32x4*)(psh + c), sc1 = *(const LAS f32x4*)(psc + c);
#pragma unroll
            for (int e = 0; e < 4; ++e) { xn[e] = (v[j][e] - mean) * rstd * gv[e] + bv[e]; hv[e] = xn[e] * sc1[e] + shv[e]; }
            stg<f32x4>(xr + c, xn);
            u32x2 w; w.x = cvt_pk(hv[0], hv[1]); w.y = cvt_pk(hv[2], hv[3]); stg<u32x2>(F.H + (size_t)row * DM + c, w);
#pragma unroll
            for (int e = 0; e < 16; ++e) { const f32x4 wv = *(const LAS f32x4*)(wt + e * DM + c); lg[e] += hv[0] * wv[0] + hv[1] * wv[1] + hv[2] * wv[2] + hv[3] * wv[3];
                if (e == 7) __builtin_amdgcn_sched_barrier(0); }
            __builtin_amdgcn_sched_barrier(0);
        }
#pragma unroll
        for (int e = 0; e < 8; ++e) { const auto r2 = __builtin_amdgcn_permlane32_swap(__float_as_uint(lg[e]), __float_as_uint(lg[e + 8]), false, false); lg[e] = __uint_as_float(r2[0]) + __uint_as_float(r2[1]); }
#pragma unroll
        for (int e = 0; e < 4; ++e) { const auto r2 = __builtin_amdgcn_permlane16_swap(__float_as_uint(lg[e]), __float_as_uint(lg[e + 4]), false, false); lg[e] = __uint_as_float(r2[0]) + __uint_as_float(r2[1]); }
#pragma unroll
        for (int e = 0; e < 2; ++e) { const bool up = lane & 8; const float keep = up ? lg[e + 2] : lg[e], give = up ? lg[e] : lg[e + 2]; lg[e] = keep + dppf<0x128>(give); }
        { const bool up = lane & 4; const float keep = up ? lg[1] : lg[0], give = up ? lg[0] : lg[1]; lg[0] = keep + dppf<0x141>(dppf<0x1B>(give)); }
        float lgt = lg[0]; lgt += dppf<0x4E>(lgt); lgt += dppf<0xB1>(lgt);
        const float mysc = 1.0f / (1.0f + __expf(-lgt)), mych = mysc + rb;
        float gsum;
        { const float cb = dppf<0x124>(mych), cc = dppf<0x128>(mych), cd = dppf<0x12C>(mych);
          const float h1 = fmaxf(mych, cb), l1 = fminf(mych, cb), h2 = fmaxf(cc, cd), l2 = fminf(cc, cd);
          gsum = fmaxf(h1, h2) + fmaxf(fminf(h1, h2), fmaxf(l1, l2)); }
        int bg = 0; float bgs = rdlane(gsum, 0);
        { const float g1 = rdlane(gsum, 16), g2 = rdlane(gsum, 32), g3 = rdlane(gsum, 48);
          if (g1 > bgs) { bgs = g1; bg = 1; } if (g2 > bgs) { bgs = g2; bg = 2; } if (g3 > bgs) { bgs = g3; bg = 3; } }
        bg = __builtin_amdgcn_readfirstlane(bg);
        int e0 = 0, e1 = 0; float c0 = -1e30f, c1 = -1e30f, s0 = 0.f, s1 = 0.f;
#pragma unroll
        for (int k = 0; k < 4; ++k) { const float c = rdlane(mych, bg * 16 + 4 * k), s2 = rdlane(mysc, bg * 16 + 4 * k); const int ee = bg * 4 + k;
            if (c > c0) { c1 = c0; e1 = e0; s1 = s0; c0 = c; e0 = ee; s0 = s2; } else if (c > c1) { c1 = c; e1 = ee; s1 = s2; } }
        if (lane == 0) {
            const float inv = 1.0f / (s0 + s1);
            const int p0 = __hip_atomic_fetch_add(lcnt + e0, 1, __ATOMIC_RELAXED, __HIP_MEMORY_SCOPE_WORKGROUP), p1 = __hip_atomic_fetch_add(lcnt + e1, 1, __ATOMIC_RELAXED, __HIP_MEMORY_SCOPE_WORKGROUP);
            int* rt = F.route + (size_t)row * 8; stg<u32x4>(rt, (u32x4){(unsigned)e0, (unsigned)e1, (unsigned)p0, (unsigned)p1}); stg<u32x2>(rt + 4, (u32x2){__float_as_uint(s0 * inv), __float_as_uint(s1 * inv)});
        }
    }
    }
    __syncthreads();
    if (F.tid < 16) lcnt[16 + F.tid] = atomicAdd(F.cnt + l * 16 + F.tid, lcnt[F.tid]);
    asm volatile("s_waitcnt vmcnt(0)" ::: "memory");
    __syncthreads();
#pragma nounroll
    for (int seg = 0; seg < 3; ++seg) { const int lo = seg * SEQ, hi = (seg < 2) ? lo + SEQ : TT; if (lo >= MT) break;
        for (int row = lo + F.bid * 8 + F.wave + lane * stride; row < hi; row += 64 * stride) { int* rt = F.route + (size_t)row * 8;
            const u32x4 r = ldg<u32x4>(rt); stg<u32x2>(rt + 2, (u32x2){r.z + (unsigned)lcnt[16 + r.x], r.w + (unsigned)lcnt[16 + r.y]}); } }
    __syncthreads();
}
__device__ __forceinline__ void phase_perm(const Params& p, const Frame& F, int l) {
    LAS int* off = (LAS int*)F.lds; LAS int* cn = off + 32;
    __syncthreads();
    if (F.tid < 16) cn[F.tid] = ldg<int>(F.cnt + l * 16 + F.tid);
    __syncthreads();
    if (F.tid == 0) { int a = 0; for (int e = 0; e < 16; ++e) { off[e] = a; a += (cn[e] + 255) & ~255; } off[16] = a;
        if (F.bid == 0) { F.misc[0] = a >> 8; for (int e = 0; e < 16; ++e) for (int q = off[e] >> 8; q < (off[e + 1 < 17 ? e + 1 : 16] >> 8); ++q) F.misc[16 + q] = e; } }
    __syncthreads();
    const int MT = (l == DEPTH - 1) ? TL : TT;
    for (int row = (F.bid * 8 + F.wave) * 64 + F.lane; row < MT; row += F.G * 8 * 64) {
        int* rt = F.route + (size_t)row * 8;
        const u32x4 r = ldg<u32x4>(rt);
        const int d0 = off[r.x] + (int)r.z, d1 = off[r.y] + (int)r.w;
        stg<u32x2>(rt + 6, (u32x2){(unsigned)d0, (unsigned)d1});
        stg<int>(F.gidx + d0, row); stg<int>(F.gidx + d1, row);
    }
}
__device__ __forceinline__ void phase_ln2(const Params& p, const Frame& F, int l) {
    const int lane = F.lane;
    const float* g = p.ln2_g + l * DM; const float* bta = p.ln2_b + l * DM;
    const int MT = (l == DEPTH - 1) ? TL : TT;
    const bool hasn = (l + 1 < DEPTH);
    f32x4 gv[4], bv[4];
#pragma unroll
    for (int j = 0; j < 4; ++j) { gv[j] = ldg<f32x4>(g + j * 256 + lane * 4); bv[j] = ldg<f32x4>(bta + j * 256 + lane * 4); }
    const int stride = F.G * 8;
#define LN2_LOADROW(rw, rt_, X, A_, B_) do { const float* xs_ = xrow(p, F, (rw)); \
        const bf16_t* f0_ = F.Fs + (size_t)__builtin_amdgcn_readfirstlane((int)(rt_)[2]) * DM; const bf16_t* f1_ = F.Fs + (size_t)__builtin_amdgcn_readfirstlane((int)(rt_)[3]) * DM; \
        _Pragma("unroll") for (int j_ = 0; j_ < 4; ++j_) { const int c_ = j_ * 256 + lane * 4; X[j_] = ldg<f32x4>(xs_ + c_); A_[j_] = ldg<u32x2>(f0_ + c_); B_[j_] = ldg<u32x2>(f1_ + c_); } } while (0)
#pragma nounroll
    for (int seg = 0; seg < 3; ++seg) {
    const int lo = seg * SEQ, hi = (seg < 2) ? lo + SEQ : TT;
    if (lo >= MT) break;
    const float* md = F.mods + ((size_t)l * 3 + seg) * 6144;
    const float* mdn = F.mods + ((size_t)(hasn ? l + 1 : l) * 3 + seg) * 6144;
    f32x4 gt[4], nsh[4], nsc1[4];
#pragma unroll
    for (int j = 0; j < 4; ++j) { const int c = j * 256 + lane * 4; gt[j] = ldg<f32x4>(md + 5 * DM + c); nsh[j] = ldg<f32x4>(mdn + c); nsc1[j] = ldg<f32x4>(mdn + DM + c) + 1.0f; }
    int row = lo + F.bid * 8 + F.wave;
    u32x4 rc = (u32x4){0u, 0u, 0u, 0u}, rn = rc;
    f32x4 xv[4]; u32x2 fa[4], fb[4];
#pragma unroll
    for (int j = 0; j < 4; ++j) { xv[j] = (f32x4){0.f, 0.f, 0.f, 0.f}; fa[j] = (u32x2){0u, 0u}; fb[j] = fa[j]; }
    if (row < hi) { rc = ldg<u32x4>(F.route + (size_t)row * 8 + 4); LN2_LOADROW(row, rc, xv, fa, fb); }
    if (row + stride < hi) rn = ldg<u32x4>(F.route + (size_t)(row + stride) * 8 + 4);
    for (; row < hi; row += stride) {
        float* xr = xrow(p, F, row);
        f32x4 xvn[4]; u32x2 fan[4], fbn[4]; u32x4 rn2 = rn;
#pragma unroll
        for (int j = 0; j < 4; ++j) { xvn[j] = xv[j]; fan[j] = fa[j]; fbn[j] = fb[j]; }
        if (row + stride < hi) { LN2_LOADROW(row + stride, rn, xvn, fan, fbn);
            if (row + 2 * stride < hi) rn2 = ldg<u32x4>(F.route + (size_t)(row + 2 * stride) * 8 + 4); }
        const float w0 = __uint_as_float(rc[0]), w1 = __uint_as_float(rc[1]);
        f32x4 v[4]; float s = 0.f;
#pragma unroll
        for (int j = 0; j < 4; ++j) { const u32x2 a = fa[j], b = fb[j];
            f32x4 f; f[0] = w0 * bflo(a.x) + w1 * bflo(b.x); f[1] = w0 * bfhi(a.x) + w1 * bfhi(b.x); f[2] = w0 * bflo(a.y) + w1 * bflo(b.y); f[3] = w0 * bfhi(a.y) + w1 * bfhi(b.y);
            v[j] = xv[j] * ALPHA + gt[j] * f; s += v[j][0] + v[j][1] + v[j][2] + v[j][3]; }
        const float mean = wsum(s) * (1.0f / DM); float q = 0.f;
#pragma unroll
        for (int j = 0; j < 4; ++j)
#pragma unroll
            for (int e = 0; e < 4; ++e) { const float d = v[j][e] - mean; q += d * d; }
        const float rstd = rsqrtf(wsum(q) * (1.0f / DM) + 1e-5f);
#pragma unroll
        for (int j = 0; j < 4; ++j) { const int c = j * 256 + lane * 4;
            f32x4 xn;
#pragma unroll
            for (int e = 0; e < 4; ++e) xn[e] = (v[j][e] - mean) * rstd * gv[j][e] + bv[j][e];
            stg<f32x4>(xr + c, xn);
            if (hasn) { u32x2 w; w.x = cvt_pk(xn[0] * nsc1[j][0] + nsh[j][0], xn[1] * nsc1[j][1] + nsh[j][1]); w.y = cvt_pk(xn[2] * nsc1[j][2] + nsh[j][2], xn[3] * nsc1[j][3] + nsh[j][3]);
                stg<u32x2>(F.H + (size_t)row * DM + c, w); }
        }
#pragma unroll
        for (int j = 0; j < 4; ++j) { xv[j] = xvn[j]; fa[j] = fan[j]; fb[j] = fbn[j]; }
        rc = rn; rn = rn2;
    }
    }
#undef LN2_LOADROW
}

__device__ __forceinline__ Frame make_frame(const Params& p, unsigned char* lds_raw, int wave_s);
__device__ __forceinline__ void phase_attn(const Params& p, const Frame& F, int l) {
    const bool last = (l == DEPTH - 1);
    float lam, post;
    { const float* lv = p.da_lambda + l * 128; const int i = F.lane & 31;
      const float a = wsum(F.lane < 32 ? lv[i] * lv[32 + i] : 0.f), b = wsum(F.lane < 32 ? lv[64 + i] * lv[96 + i] : 0.f);
      const float li = 0.8f - 0.6f * expf(-0.3f * (float)l); lam = expf(a) - expf(b) + li; post = 1.0f - li;
      lam = __uint_as_float(__builtin_amdgcn_readfirstlane(__float_as_uint(lam))); post = __uint_as_float(__builtin_amdgcn_readfirstlane(__float_as_uint(post))); }
    const int nDA = 768 + (last ? 0 : 12);
#ifndef ATT_MASK
#define ATT_MASK 7
#endif
    if (F.wave >= 4) __builtin_amdgcn_s_setprio(1);
    if (ATT_MASK & 1) for (int i = 0;; ++i) {
        const int L = i * F.G + F.bid; if (L >= nDA) break;
        int bh, qt; if (L < 768) { const int w = L & 255, xcd = w & 7; bh = (L >> 8) * 4 + (xcd >> 1); qt = (xcd & 1) * 32 + (w >> 3); } else { bh = L - 768; qt = 64; }
        const int b = bh / 6, h = bh - b * 6;
        AttnArgs A;
        { const size_t o = (size_t)(b * 12 + h * 2) * SK; A.qr0 = F.QRDA + o * 32; A.qf0 = F.QFDA + o * 32; A.k0 = F.KDA + o * 32; A.qn0 = F.qn_da + o;
          A.qr1 = A.qr0 + (size_t)SK * 32; A.qf1 = A.qf0 + (size_t)SK * 32; A.k1 = A.k0 + (size_t)SK * 32; A.qn1 = A.qn0 + SK;
          A.kmax0 = sqrtf(__uint_as_float(F.kmax_da[l * 24 + b * 12 + h * 2])); A.kmax1 = sqrtf(__uint_as_float(F.kmax_da[l * 24 + b * 12 + h * 2 + 1])); }
        A.qpe = nullptr; A.vt = F.VTDA + (size_t)(b * 6 + h) * 64 * SK;
        if (qt < 64) { A.q0 = qt * 256; A.t0 = 0; A.t1 = 130; A.yrow0 = b * SEQ + qt * 256; } else { A.q0 = SEQ; A.t0 = 128; A.t1 = 130; A.yrow0 = TL + b * CTXL; }
        A.y = F.H + h * 64; A.lam = lam; A.post = post; A.subg = p.da_subln + l * 64;
        attn_item_da2(F, A);
    }
    if (ATT_MASK & 2) for (int i = 0;; ++i) {
        const int L = i * F.G + F.bid; if (L >= nDA) break;
        int bh, qt; if (L < 768) { const int w = L & 255, xcd = w & 7; bh = (L >> 8) * 4 + (xcd >> 1); qt = (xcd & 1) * 32 + (w >> 3); } else { bh = L - 768; qt = 64; }
        const int b = bh / 6, h = bh - b * 6;
        AttnArgs A; const size_t o = (size_t)(b * 6 + h) * SK;
        A.qr0 = F.QRMLA + o * 96; A.qr1 = A.qr0; A.qf0 = A.qr0; A.qf1 = A.qr0; A.qpe = F.QPE + o * 32; A.k0 = F.KMLA + o * 96; A.k1 = A.k0; A.qn0 = F.qn_mla + o; A.qn1 = A.qn0;
        A.kmax0 = sqrtf(__uint_as_float(F.kmax_mla[l * 12 + b * 6 + h])); A.kmax1 = A.kmax0;
        A.vt = F.VTMLA + o * 64;
        if (qt < 64) { A.q0 = qt * 256; A.t0 = 0; A.t1 = 130; A.yrow0 = b * SEQ + qt * 256; } else { A.q0 = SEQ; A.t0 = 128; A.t1 = 130; A.yrow0 = TL + b * CTXL; }
        A.y = F.H + 384 + h * 64; A.lam = 0.f; A.post = 1.f; A.subg = nullptr;
        attn_item<96, false>(F, A);
    }
    __builtin_amdgcn_s_setprio(0);
    LAS int* qs = (LAS int*)(F.lds + LDS_MAIN + 64);
    int* qctr = F.cnt + 192 + l * 2;
    if (ATT_MASK & 4) for (;;) {
        __syncthreads();
        if (F.tid == 0) *qs = atomicAdd(qctr, 1);
        __syncthreads();
        const int it = __builtin_amdgcn_readfirstlane(*qs);
        if (it >= NB * 4 * NCH) break;
        if (last && (it % NCH) < 2) continue;
        const Frame F2 = make_frame(p, (unsigned char*)F.lds, F.wave); ret_out_item(p, F2, l, it);
    }
    for (;;) {
        __syncthreads();
        if (F.tid == 0) *qs = atomicAdd(qctr + 1, 1);
        __syncthreads();
        const int c = __builtin_amdgcn_readfirstlane(*qs);
        if (c >= CVT_TILES / 8) break;
        { const Frame F2 = make_frame(p, (unsigned char*)F.lds, F.wave); convert_expert_chunk(p, F2, l, c); }
    }
}

__device__ __forceinline__ int sig_plain(int r) { return 16 * ((r >> 2) & 1) + 4 * (r >> 3) + (r & 3); }
__device__ __forceinline__ int sig_swiglu(int r) { return 8 * ((r >> 4) + 2 * ((r >> 2) & 1)) + 4 * ((r >> 3) & 1) + (r & 3); }
template <int MR>
__device__ __forceinline__ void small_mma(const bf16_t* wp, const bf16_t* const (&ap)[MR], int nk16, f32x16 (&acc)[MR]) {
    bf16x8 wc[4], ac[MR][4];
#pragma unroll
    for (int j = 0; j < 4; ++j) { wc[j] = __builtin_bit_cast(bf16x8, ldg16(wp + 16 * j));
#pragma unroll
        for (int m = 0; m < MR; ++m) ac[m][j] = __builtin_bit_cast(bf16x8, ldg16(ap[m] + 16 * j)); }
#pragma nounroll
    for (int ks = 0; ks < nk16; ks += 4) {
        bf16x8 wn[4], an[MR][4];
#pragma unroll
        for (int j = 0; j < 4; ++j) { wn[j] = wc[j];
#pragma unroll
            for (int m = 0; m < MR; ++m) an[m][j] = ac[m][j]; }
        if (ks + 4 < nk16) {
#pragma unroll
            for (int j = 0; j < 4; ++j) { wn[j] = __builtin_bit_cast(bf16x8, ldg16(wp + 16 * (ks + 4 + j)));
#pragma unroll
                for (int m = 0; m < MR; ++m) an[m][j] = __builtin_bit_cast(bf16x8, ldg16(ap[m] + 16 * (ks + 4 + j))); } }
#pragma unroll
        for (int j = 0; j < 4; ++j)
#pragma unroll
            for (int m = 0; m < MR; ++m) acc[m] = MFMA32(wc[j], ac[m][j], acc[m]);
#pragma unroll
        for (int j = 0; j < 4; ++j) { wc[j] = wn[j];
#pragma unroll
            for (int m = 0; m < MR; ++m) ac[m][j] = an[m][j]; }
    }
}
__device__ __forceinline__ void small_store16(bf16_t* o, const f32x16& a) {
    stg<u32x4>(o, (u32x4){cvt_pk(a[0], a[1]), cvt_pk(a[2], a[3]), cvt_pk(a[4], a[5]), cvt_pk(a[6], a[7])});
    stg<u32x4>(o + 8, (u32x4){cvt_pk(a[8], a[9]), cvt_pk(a[10], a[11]), cvt_pk(a[12], a[13]), cvt_pk(a[14], a[15])});
}
#define SMALL_ZERO(acc, MR_) do { _Pragma("unroll") for (int m_ = 0; m_ < (MR_); ++m_) _Pragma("unroll") for (int i_ = 0; i_ < 16; ++i_) acc[m_][i_] = 0.f; } while (0)
__device__ __forceinline__ void small_g1(const Frame& F) {
    const int r = F.lane & 31, hh = F.lane >> 5, sg = sig_plain(r), nw = F.G * 8;
    for (int u = F.wave * F.G + F.bid; u < 512 + 8 * 81; u += nw) {
        int n0, row0;
        if (u < 512) { n0 = 2560; row0 = u * 64; } else { const int v = u - 512; n0 = (v % 81) * 32; row0 = TL + (v / 81) * 64; }
        const bf16_t* wp = F.WinT + (size_t)(n0 + sg) * DM + 8 * hh;
        const bf16_t* const ap[2] = { F.H + (size_t)(row0 + r) * DM + 8 * hh, F.H + (size_t)(row0 + 32 + r) * DM + 8 * hh };
        f32x16 acc[2]; SMALL_ZERO(acc, 2);
        small_mma<2>(wp, ap, DM / 16, acc);
#pragma unroll
        for (int m = 0; m < 2; ++m) small_store16(F.Z + (size_t)(row0 + 32 * m + r) * NINP + n0 + 16 * hh, acc[m]);
    }
}
__device__ __forceinline__ void small_g2(const Frame& F) {
    const int r = F.lane & 31, hh = F.lane >> 5, sg = sig_plain(r), nw = F.G * 8;
    for (int u = F.wave * F.G + F.bid; u < 8 * 42; u += nw) {
        const int nb = u % 42, n0 = (nb < 18 ? nb : nb + 6) * 32, row0 = TL + (u / 42) * 64;
        const int koff = n0 < KVC0 ? 0 : 256, nk16 = n0 < KVC0 ? 16 : 8;
        const bf16_t* wp = F.W2m + (size_t)(n0 + sg) * K2 + koff + 8 * hh;
        const bf16_t* const ap[2] = { F.Z + ZC_CQ + (size_t)(row0 + r) * NINP + koff + 8 * hh, F.Z + ZC_CQ + (size_t)(row0 + 32 + r) * NINP + koff + 8 * hh };
        f32x16 acc[2]; SMALL_ZERO(acc, 2);
        small_mma<2>(wp, ap, nk16, acc);
#pragma unroll
        for (int m = 0; m < 2; ++m) small_store16(F.Z2 + (size_t)(row0 + 32 * m + r) * N2P + n0 + 16 * hh, acc[m]);
    }
}
__device__ __forceinline__ void small_g3(const Frame& F, int l) {
    const int r = F.lane & 31, hh = F.lane >> 5, sg = sig_plain(r), nw = F.G * 8;
    const float* gate = F.mods + ((size_t)l * 3 + 2) * 6144 + 2 * DM;
    for (int u = F.wave * F.G + F.bid; u < 16 * 32; u += nw) {
        const int n0 = (u & 31) * 32, row0 = (u >> 5) * 32;
        const bf16_t* wp = F.WoutT + (size_t)(n0 + sg) * DM + 8 * hh;
        const bf16_t* const ap[1] = { F.H + (size_t)(TL + row0 + r) * DM + 8 * hh };
        f32x16 acc[1]; SMALL_ZERO(acc, 1);
        small_mma<1>(wp, ap, DM / 16, acc);
        float* xp = F.xc + (size_t)(row0 + r) * DM + n0 + 16 * hh; const float* gp = gate + n0 + 16 * hh;
#pragma unroll
        for (int q = 0; q < 4; ++q) { const f32x4 gv = ldg<f32x4>(gp + 4 * q), xv = ldg<f32x4>(xp + 4 * q);
            f32x4 a; a[0] = acc[0][4 * q]; a[1] = acc[0][4 * q + 1]; a[2] = acc[0][4 * q + 2]; a[3] = acc[0][4 * q + 3];
            stg<f32x4>(xp + 4 * q, xv * ALPHA + gv * a); }
    }
}
constexpr int PBIG = 256;
__device__ __forceinline__ void small_g4(const Frame& F, int npan) {
    const int r = F.lane & 31, hh = F.lane >> 5, sg = sig_swiglu(r), nw = F.G * 8;
    for (int u = F.wave * F.G + F.bid; u < (npan - PBIG) * 128; u += nw) {
        const int pm = PBIG + (u >> 7), v = u & 127, n0 = (v & 31) * 32, row0 = pm * 256 + (v >> 5) * 64;
        const int e = F.misc[16 + pm];
        const bf16_t* wp = F.W13 + (size_t)e * 1024 * 1024 + (size_t)(n0 + sg) * DM + 8 * hh;
        const bf16_t* const ap[2] = { F.H + (size_t)ldg<int>(F.gidx + row0 + r) * DM + 8 * hh, F.H + (size_t)ldg<int>(F.gidx + row0 + 32 + r) * DM + 8 * hh };
        f32x16 acc[2]; SMALL_ZERO(acc, 2);
        small_mma<2>(wp, ap, DM / 16, acc);
#pragma unroll
        for (int m = 0; m < 2; ++m) { float h[8];
#pragma unroll
            for (int t = 0; t < 8; ++t) { const float a = acc[m][8 * (t >> 2) + (t & 3)], b = acc[m][8 * (t >> 2) + 4 + (t & 3)]; h[t] = a / (1.0f + __expf(-a)) * b; }
            stg<u32x4>(F.Uact + (size_t)(row0 + 32 * m + r) * DEXP + (n0 >> 1) + 8 * hh, (u32x4){cvt_pk(h[0], h[1]), cvt_pk(h[2], h[3]), cvt_pk(h[4], h[5]), cvt_pk(h[6], h[7])}); }
    }
}
__device__ __forceinline__ void small_g5(const Frame& F, int npan) {
    const int r = F.lane & 31, hh = F.lane >> 5, sg = sig_plain(r), nw = F.G * 8;
    for (int u = F.wave * F.G + F.bid; u < (npan - PBIG) * 128; u += nw) {
        const int pm = PBIG + (u >> 7), v = u & 127, n0 = (v & 31) * 32, row0 = pm * 256 + (v >> 5) * 64;
        const int e = F.misc[16 + pm];
        const bf16_t* wp = F.W2e + (size_t)e * 1024 * 512 + (size_t)(n0 + sg) * DEXP + 8 * hh;
        const bf16_t* const ap[2] = { F.Uact + (size_t)(row0 + r) * DEXP + 8 * hh, F.Uact + (size_t)(row0 + 32 + r) * DEXP + 8 * hh };
        f32x16 acc[2]; SMALL_ZERO(acc, 2);
        small_mma<2>(wp, ap, DEXP / 16, acc);
#pragma unroll
        for (int m = 0; m < 2; ++m) small_store16(F.Fs + (size_t)(row0 + 32 * m + r) * DM + n0 + 16 * hh, acc[m]);
    }
}

typedef const __attribute__((address_space(4))) Params* KParams;
__device__ __forceinline__ Params load_params() {
    Params r;
#if defined(__HIP_DEVICE_COMPILE__)
    static_assert(sizeof(Params) == 28 * 8, "Params layout");
    const __attribute__((address_space(4))) unsigned long long* kp = (const __attribute__((address_space(4))) unsigned long long*)__builtin_amdgcn_kernarg_segment_ptr();
    asm volatile("" : "+s"(kp));
    unsigned long long* d = (unsigned long long*)&r;
#pragma unroll
    for (int i = 0; i < 28; ++i) d[i] = kp[i];
#endif
    return r;
}
__device__ __forceinline__ int lane_id() { int l; asm volatile("v_mbcnt_lo_u32_b32 %0, -1, 0\n\tv_mbcnt_hi_u32_b32 %0, -1, %0" : "=v"(l)); return l; }
__device__ __forceinline__ Frame make_frame(const Params& p, unsigned char* lds_raw, int wave_s) {
    int tid = wave_s * 64 + lane_id(); asm volatile("" : "+v"(tid));
    Frame F;
    int G = gridDim.x, bid = blockIdx.x; asm volatile("" : "+s"(G), "+s"(bid));
    F.lds = (LAS unsigned char*)lds_raw; F.tid = tid; F.lane = F.tid & 63; F.wave = __builtin_amdgcn_readfirstlane(F.tid >> 6); F.G = G; F.bid = bid;
    unsigned char* ws = p.ws; asm volatile("" : "+s"(ws)); F.ws = ws;
    F.cnt = (int*)(ws + WS_CTL); F.kmax_da = (unsigned*)(ws + WS_CTL + 256); F.kmax_mla = (unsigned*)(ws + WS_CTL + 1024); F.misc = (int*)(ws + WS_MISC);
    F.modp = (float*)(ws + WS_MODP); F.mods = (float*)(ws + WS_MODS); F.rope = (float*)(ws + WS_ROPE); F.xc = (float*)(ws + WS_XC); F.route = (int*)(ws + WS_ROUTE); F.gidx = (int*)(ws + WS_GIDX);
    F.qn_da = (float*)(ws + WS_QN); F.qn_mla = F.qn_da + (size_t)NB * 12 * SK;
    F.WinT = (bf16_t*)(ws + WS_WIN); F.W2m = (bf16_t*)(ws + WS_W2M); F.WoutT = (bf16_t*)(ws + WS_WOUT); F.H = (bf16_t*)(ws + WS_H);
    F.retq = (bf16_t*)(ws + WS_RETQ); F.retk = (bf16_t*)(ws + WS_RETK); F.ust = (float*)(ws + WS_UST);
    F.Z = (bf16_t*)(ws + WS_A); F.Hs = F.Z; F.Z2 = (bf16_t*)(ws + WS_B); F.Uact = F.Z2;
    unsigned char* rc = ws + WS_C;
    F.QRDA = (bf16_t*)(rc + WC_QRDA); F.QFDA = (bf16_t*)(rc + WC_QFDA); F.KDA = (bf16_t*)(rc + WC_KDA); F.VTDA = (bf16_t*)(rc + WC_VTDA);
    F.QRMLA = (bf16_t*)(rc + WC_QRMLA); F.QPE = (bf16_t*)(rc + WC_QPE); F.KMLA = (bf16_t*)(rc + WC_KMLA); F.VTMLA = (bf16_t*)(rc + WC_VTMLA);
    F.Fs = (bf16_t*)(rc + WC_FS); F.W13 = (bf16_t*)(ws + WS_W13); F.W2e = (bf16_t*)(ws + WS_W2E);

    return F;
}
constexpr int PH_PER_LAYER = 12, PH_PRE = 3, NPH = PH_PRE + DEPTH * PH_PER_LAYER;
__global__ void __launch_bounds__(512, 2) mk_fwd(Params p_arg) {
    extern __shared__ __attribute__((aligned(16))) unsigned char lds_raw[];
    const LAS unsigned char* const lds_c = (const LAS unsigned char*)lds_raw; (void)lds_c;
    unsigned char* ws = p_arg.ws;
    const int wave_s = __builtin_amdgcn_readfirstlane((int)threadIdx.x >> 6);
#define IS_T0 (wave_s == 0 && lane_id() == 0)
    volatile LAS unsigned* xbw = (volatile LAS unsigned*)((LAS unsigned char*)lds_raw + LDS_MAIN);
    if (threadIdx.x < 4) xbw[threadIdx.x] = 0u;
    __syncthreads();
    const int lo = p_arg.ph_lo, hi = p_arg.ph_hi;
    XcdBarrier bar; bar.bar = (unsigned*)(ws + WS_BAR); bar.x = 0; bar.st = xbw;
    if (hi - lo > 1) bar = xcd_barrier_post((unsigned*)(ws + WS_BAR), xbw, IS_T0);
#ifndef PH_MASK
#define PH_MASK 0xFFF
#endif
#ifndef PRE_MASK
#define PRE_MASK 7
#endif
#define IN(k) (lo <= (k) && (k) < hi)
#define INP(k) (((PRE_MASK >> (k)) & 1) && IN(k))
#define INL(j) (((PH_MASK >> (j)) & 1) && IN(pb + (j)))
#ifndef REP_MASK
#define REP_MASK 0
#endif
#define REPS(j) ((((REP_MASK) >> (j)) & 1) ? 2 : 1)
#define SEAM(k) do { if (IN(k) && IN((k) + 1)) xcd_barrier(bar, IS_T0); } while (0)

    if (INP(0)) { const Params p = load_params(); const Frame F = make_frame(p, lds_raw, wave_s); phase_prologue(p, F); } SEAM(0);
    if (INP(1)) { const Params p = load_params(); const Frame F = make_frame(p, lds_raw, wave_s); phase_mods(p, F); } SEAM(1);
    if (INP(2)) { const Params p = load_params(); const Frame F = make_frame(p, lds_raw, wave_s); phase_modulate(p, F, 0, 0); } SEAM(2);
    for (int l = 0; l < DEPTH; ++l) {
        const int pb = PH_PRE + l * PH_PER_LAYER;
        if (INL(0)) for (int rep_ = 0; rep_ < REPS(0); ++rep_) { const Params p = load_params(); const Frame F = make_frame(p, lds_raw, wave_s);
            pg8::Gemm g{F.H, F.WinT, TL, 2560, DM, DM, DM, nullptr, 0, -1, 0, 0, 0, 0, nullptr}; pg8::StaticOrder S; S.init(TL, 2560, F.G, F.bid);
            pg8::EpiStoreBf16 E{F.Z, NINP}; pg8::gemm_phase(F.lds, F.tid, g, S, E); small_g1(F); }
        SEAM(pb + 0);
        if (INL(1)) for (int rep_ = 0; rep_ < REPS(1); ++rep_) { const Params p = load_params(); const Frame F = make_frame(p, lds_raw, wave_s); phase_post1(p, F, l); } SEAM(pb + 1);
        if (INL(2)) for (int rep_ = 0; rep_ < REPS(2); ++rep_) { const Params p = load_params(); const Frame F = make_frame(p, lds_raw, wave_s);
            pg8::Gemm g{F.Z + ZC_CQ, F.W2m, TT, N2P, K2, NINP, K2, nullptr, 0, 3, 0, 4, 256, 2, nullptr};
            pg8::StaticOrder S; S.init(TL, N2P, F.G, F.bid);
            pg8::EpiStoreBf16 E{F.Z2, N2P}; pg8::gemm_phase(F.lds, F.tid, g, S, E); small_g2(F); }
        SEAM(pb + 2);
        if (INL(3)) for (int rep_ = 0; rep_ < REPS(3); ++rep_) { const Params p = load_params(); const Frame F = make_frame(p, lds_raw, wave_s); phase_post2(p, F, l); phase_ret_chunk_states(p, F, l); } SEAM(pb + 3);
        if (INL(4)) for (int rep_ = 0; rep_ < REPS(4); ++rep_) { const Params p = load_params(); const Frame F = make_frame(p, lds_raw, wave_s); phase_ret_scan(p, F, l); } SEAM(pb + 4);
        if (INL(5)) for (int rep_ = 0; rep_ < REPS(5); ++rep_) { const Params p = load_params(); const Frame F = make_frame(p, lds_raw, wave_s); phase_attn(p, F, l); } SEAM(pb + 5);
        if (INL(6)) for (int rep_ = 0; rep_ < REPS(6); ++rep_) { const Params p = load_params(); const Frame F = make_frame(p, lds_raw, wave_s);
            pg8::Gemm g{F.H, F.WoutT, TL, DM, DM, DM, DM, nullptr, 0, -1, 0, 0, 0, 0, nullptr}; pg8::StaticOrder S; S.init(TL, DM, F.G, F.bid);
            pg8::EpiResGate E{p.out, F.xc, F.mods + (size_t)l * 3 * 6144 + 2 * DM}; pg8::gemm_phase(F.lds, F.tid, g, S, E);
            if (l != DEPTH - 1) small_g3(F, l); }
        SEAM(pb + 6);
        if (INL(7)) for (int rep_ = 0; rep_ < REPS(7); ++rep_) { const Params p = load_params(); const Frame F = make_frame(p, lds_raw, wave_s); phase_ln1(p, F, l);
        } SEAM(pb + 7);
        if (INL(8)) for (int rep_ = 0; rep_ < REPS(8); ++rep_) { const Params p = load_params(); const Frame F = make_frame(p, lds_raw, wave_s); phase_perm(p, F, l); } SEAM(pb + 8);
        if (INL(9)) for (int rep_ = 0; rep_ < REPS(9); ++rep_) { const Params p = load_params(); const Frame F = make_frame(p, lds_raw, wave_s);
            const int npan = F.misc[0];
            const int nbig = npan < PBIG ? npan : PBIG;
            pg8::Gemm g{F.H, F.W13, nbig * 256, DM, DM, DM, DM, F.misc + 16, (size_t)1024 * 1024, -1, 0, 0, 0, 0, F.gidx}; pg8::MoeOrder S; S.init(nbig * 256, F.G, F.bid);
            pg8::EpiSwiGLU E{F.Uact}; pg8::gemm_phase<pg8::EpiSwiGLU, pg8::MoeOrder, true>(F.lds, F.tid, g, S, E); small_g4(F, npan); }
        SEAM(pb + 9);
        if (INL(10)) for (int rep_ = 0; rep_ < REPS(10); ++rep_) { const Params p = load_params(); const Frame F = make_frame(p, lds_raw, wave_s);
            const int npan = F.misc[0];
            const int nbig = npan < PBIG ? npan : PBIG;
            pg8::Gemm g{F.Uact, F.W2e, nbig * 256, DM, DEXP, DEXP, DEXP, F.misc + 16, (size_t)1024 * 512, -1, 0, 0, 0, 0, nullptr}; pg8::MoeOrder S; S.init(nbig * 256, F.G, F.bid);
            pg8::EpiStoreBf16 E{F.Fs, DM}; pg8::gemm_phase(F.lds, F.tid, g, S, E); small_g5(F, npan); }
        SEAM(pb + 10);
        if (INL(11)) for (int rep_ = 0; rep_ < REPS(11); ++rep_) { const Params p = load_params(); const Frame F = make_frame(p, lds_raw, wave_s); phase_ln2(p, F, l); if (l + 1 < DEPTH) convert_small_weights(p, F, l + 1); }
        SEAM(pb + 11);
    }
}

extern "C" void kernel_launch(void* const* d_in, const int* in_sizes, int n_in, void* d_out, int out_size, void* d_ws, size_t ws_size, hipStream_t stream) {
    static int grid = 0;
    if (grid == 0) {
        if (n_in != 25 || out_size != TL * DM || ws_size < WS_END) { fprintf(stderr, "kernel_launch: unexpected shapes / workspace (%d inputs, out %d, ws %zu < %zu)\n", n_in, out_size, ws_size, (size_t)WS_END); grid = -1; return; }
        int dev = 0, cus = 0;
        if (hipGetDevice(&dev) != hipSuccess || hipDeviceGetAttribute(&cus, hipDeviceAttributeMultiprocessorCount, dev) != hipSuccess) { grid = -1; return; }
        if (hipFuncSetAttribute((const void*)mk_fwd, hipFuncAttributeMaxDynamicSharedMemorySize, LDS_BYTES) != hipSuccess) { fprintf(stderr, "kernel_launch: hipFuncSetAttribute failed\n"); grid = -1; return; }
        int per_cu = 0;
        if (hipOccupancyMaxActiveBlocksPerMultiprocessor(&per_cu, (const void*)mk_fwd, 512, LDS_BYTES) != hipSuccess || per_cu < 1) { fprintf(stderr, "kernel_launch: occupancy query says %d\n", per_cu); }
        (void)hipGetLastError();
        grid = cus;
    }
    if (grid < 0) return;
    (void)hipMemsetAsync(d_ws, 0, WS_ZERO_BYTES, stream);
    Params p{};
    const float** pin = (const float**)&p;
    for (int i = 0; i < 25; ++i) pin[i] = (const float*)d_in[i];
    p.out = (float*)d_out; p.ws = (unsigned char*)d_ws;
#if MK_ONE_LAUNCH
    p.ph_lo = 0; p.ph_hi = NPH;
    hipLaunchKernelGGL(mk_fwd, dim3(grid), dim3(512), LDS_BYTES, stream, p);
#else
#ifndef PROBE_NPH
#define PROBE_NPH NPH
#endif
    for (int ph = 0; ph < PROBE_NPH; ++ph) { p.ph_lo = ph; p.ph_hi = ph + 1; hipLaunchKernelGGL(mk_fwd, dim3(grid), dim3(512), LDS_BYTES, stream, p); }
#endif
}
```
